# Optimizing an MI355X kernel written in HIP

```python
import math
import jax
import jax.numpy as jnp
from jax import lax
import numpy as np

D_MODEL = 2048
BATCH = 2
SEQ = 4096
DEPTH = 4

HEAD_DIM = 128
N_HEADS_A = 4
N_HEADS_B = 4
N_HEADS_C = 4
N_HEADS_D = 4
N_HEADS = N_HEADS_A + N_HEADS_B + N_HEADS_C + N_HEADS_D
MIX_WIDTH = N_HEADS * HEAD_DIM
ROPE_THETA = 500000.0
ROPE_FRACTION = 4
Q_BLOCK = 128

CMP_LEN = 32
CMP_STRIDE = 16
CMP_HIDDEN = 256
SLC_LEN = 64
SLC_TOPK = 16
WIN_LEN = 512
FORCE_BONUS = 1000.0

DILATED_PATTERNS = ((128, 1), (512, 4), (2048, 16))

DIFF_QK_DIM = HEAD_DIM // 2

PEER_HEADS = 8
PEER_NKEYS = 128
PEER_EXPERTS = PEER_NKEYS * PEER_NKEYS
PEER_QDIM = 256
PEER_TOPK = 16
PEER_CHUNK = 128

LN_EPS = 1e-5
RMS_EPS = 1e-6
TINY = 1e-30
DEEPNORM_ALPHA = (2 * DEPTH) ** 0.25
DEEPNORM_BETA = (8 * DEPTH) ** -0.25

IN_WIDTHS = (
    N_HEADS_A * HEAD_DIM, HEAD_DIM, HEAD_DIM, HEAD_DIM, HEAD_DIM, HEAD_DIM, HEAD_DIM, 3 * N_HEADS_A,
    N_HEADS_B * HEAD_DIM, N_HEADS_B * HEAD_DIM, N_HEADS_B * HEAD_DIM,
    2 * N_HEADS_C * DIFF_QK_DIM, 2 * N_HEADS_C * DIFF_QK_DIM, N_HEADS_C * HEAD_DIM,
    N_HEADS_D * HEAD_DIM, N_HEADS_D * HEAD_DIM, N_HEADS_D * HEAD_DIM,
)
IN_WIDTH = sum(IN_WIDTHS)

kernel_name = 'hybrid_nsa_dilated_diff_stickbreak_peer'


def layer_norm(x, g, b):
    xf = x.astype(jnp.float32)
    mu = jnp.mean(xf, -1, keepdims=True)
    var = jnp.mean(jnp.square(xf - mu), -1, keepdims=True)
    y = (xf - mu) * lax.rsqrt(var + LN_EPS) * g.astype(jnp.float32) + b.astype(jnp.float32)
    return y.astype(x.dtype)


def split_cols(t, widths):
    parts, start = [], 0
    for w in widths:
        parts.append(t[..., start:start + w])
        start += w
    return parts


def split_heads(t, n_heads):
    b, s, _ = t.shape
    return t.reshape(b, s, n_heads, -1).transpose(0, 2, 1, 3)


def partial_rope(x):
    s, dh = x.shape[2], x.shape[3]
    rot = dh // ROPE_FRACTION
    half = rot // 2
    inv_freq = ROPE_THETA ** (-jnp.arange(half, dtype=jnp.float32) / half)
    ang = jnp.arange(s, dtype=jnp.float32)[:, None] * inv_freq[None, :]
    cos = jnp.cos(ang).astype(x.dtype)
    sin = jnp.sin(ang).astype(x.dtype)
    x1, x2 = x[..., :half], x[..., half:rot]
    return jnp.concatenate([x1 * cos - x2 * sin, x1 * sin + x2 * cos, x[..., rot:]], axis=-1)


def rope_single(t):
    return partial_rope(t[:, None])[:, 0]


def to_query_blocks(q):
    b, h, s, d = q.shape
    return q.reshape(b, h, s // Q_BLOCK, Q_BLOCK, d).transpose(2, 0, 1, 3, 4)


def from_query_blocks(o):
    nq, b, h, qb, d = o.shape
    return o.transpose(1, 2, 0, 3, 4).reshape(b, h, nq * qb, d)


def banded_attention(q, k, v, max_dist):
    b, h, l, dh = q.shape
    blk = Q_BLOCK
    lp = -(-l // blk) * blk
    pad = ((0, 0), (0, 0), (0, lp - l), (0, 0))
    q, k, v = jnp.pad(q, pad), jnp.pad(k, pad), jnp.pad(v, pad)
    nb = lp // blk
    n_prev = -(-max_dist // blk)
    qb = q.reshape(b, h, nb, blk, dh)

    def context(a):
        ab = a.reshape(b, h, nb, blk, dh)
        ab = jnp.pad(ab, ((0, 0), (0, 0), (n_prev, 0), (0, 0), (0, 0)))
        return jnp.concatenate([ab[:, :, j:j + nb] for j in range(n_prev + 1)], axis=3)

    kc, vc = context(k), context(v)
    sc = jnp.einsum('bhnqd,bhnkd->bhnqk', qb, kc).astype(jnp.float32) * dh ** -0.5
    q_pos = jnp.arange(nb)[:, None, None] * blk + jnp.arange(blk)[None, :, None]
    k_pos = (jnp.arange(nb)[:, None, None] - n_prev) * blk + jnp.arange((n_prev + 1) * blk)[None, None, :]
    dist = q_pos - k_pos
    mask = (dist >= 0) & (dist <= max_dist) & (k_pos >= 0)
    sc = jnp.where(mask, sc, -jnp.inf)
    m = jnp.max(sc, -1, keepdims=True)
    p = jnp.exp(sc - m)
    den = jnp.sum(p, -1, keepdims=True)
    out = jnp.einsum('bhnqk,bhnkd->bhnqd', (p / den).astype(v.dtype), vc)
    lse = (m + jnp.log(den))[..., 0]
    return out.reshape(b, h, lp, dh)[:, :, :l], lse.reshape(b, h, lp)[:, :, :l]


def compress_tokens(t, pe, w1, w2):
    b, s, dh = t.shape
    n_c = (s - CMP_LEN) // CMP_STRIDE + 1
    idx = jnp.arange(n_c)[:, None] * CMP_STRIDE + jnp.arange(CMP_LEN)[None, :]
    blocks = t[:, idx] + pe
    hid = jax.nn.gelu(blocks.reshape(b, n_c, CMP_LEN * dh) @ w1)
    return hid @ w2


def nsa_attention(q, k_cmp, v_cmp, k_slc, v_slc, k_win, v_win, gate_logits, cmp_pe, cmp_w1, cmp_w2):
    b, h, s, dh = q.shape
    scale = dh ** -0.5
    t_pos = jnp.arange(s)
    kc = compress_tokens(k_cmp, cmp_pe[0], cmp_w1[0], cmp_w2[0])
    vc = compress_tokens(v_cmp, cmp_pe[1], cmp_w1[1], cmp_w2[1])
    n_c = kc.shape[1]
    sc = jnp.einsum('bhtd,bcd->bhtc', q, kc).astype(jnp.float32) * scale
    c_end = jnp.arange(n_c) * CMP_STRIDE + CMP_LEN - 1
    sc = jnp.where(c_end[None, :] <= t_pos[:, None], sc, -jnp.inf)
    m = jnp.max(sc, -1, keepdims=True)
    m = jnp.where(jnp.isfinite(m), m, 0.0)
    e = jnp.exp(sc - m)
    p_cmp = e / jnp.maximum(jnp.sum(e, -1, keepdims=True), TINY)
    o_cmp = jnp.einsum('bhtc,bcd->bhtd', p_cmp.astype(vc.dtype), vc)

    n_s = s // SLC_LEN
    k_top = min(SLC_TOPK, n_s)
    c_start = jnp.arange(n_c) * CMP_STRIDE
    j_start = jnp.arange(n_s) * SLC_LEN
    overlap = ((c_start[:, None] < j_start[None, :] + SLC_LEN)
               & (c_start[:, None] + CMP_LEN > j_start[None, :])).astype(jnp.float32)
    imp = jnp.einsum('bhtc,cj->btj', p_cmp, overlap)
    t_blk = t_pos // SLC_LEN
    j_idx = jnp.arange(n_s)
    forced = (j_idx[None] == 0) | (j_idx[None] == t_blk[:, None]) | (j_idx[None] == t_blk[:, None] - 1)
    imp = jnp.where(forced, imp + FORCE_BONUS, imp)
    imp = jnp.where(j_idx[None] <= t_blk[:, None], imp, -jnp.inf)
    _, sel = lax.top_k(imp, k_top)

    ks_blocks = k_slc.reshape(b, n_s, SLC_LEN, dh)
    vs_blocks = v_slc.reshape(b, n_s, SLC_LEN, dh)
    gather = jax.vmap(lambda blocks, ix: blocks[ix])
    nq = s // Q_BLOCK
    sel_c = sel.reshape(b, nq, Q_BLOCK, k_top).transpose(1, 0, 2, 3)

    def sel_block(args):
        qc, selc, bi = args
        kg = gather(ks_blocks, selc)
        vg = gather(vs_blocks, selc)
        scs = jnp.einsum('bhqd,bqnld->bhqnl', qc, kg).astype(jnp.float32) * scale
        q_pos = bi * Q_BLOCK + jnp.arange(Q_BLOCK)
        k_pos = selc[..., None] * SLC_LEN + jnp.arange(SLC_LEN)
        scs = jnp.where((k_pos <= q_pos[None, :, None, None])[:, None], scs, -jnp.inf)
        pr = jax.nn.softmax(scs.reshape(b, h, Q_BLOCK, k_top * SLC_LEN), axis=-1).reshape(scs.shape)
        return jnp.einsum('bhqnl,bqnld->bhqd', pr.astype(vg.dtype), vg)

    o_slc = from_query_blocks(lax.map(sel_block, (to_query_blocks(q), sel_c, jnp.arange(nq))))

    kw = jnp.broadcast_to(k_win[:, None], (b, h, s, dh))
    vw = jnp.broadcast_to(v_win[:, None], (b, h, s, dh))
    o_win, _ = banded_attention(q, kw, vw, WIN_LEN - 1)

    g = jax.nn.sigmoid(gate_logits.astype(jnp.float32)).reshape(b, s, 3, h).transpose(2, 0, 3, 1)[..., None]
    g = g.astype(q.dtype)
    return g[0] * o_cmp + g[1] * o_slc + g[2] * o_win


def dilated_attention(q, k, v):
    b, h, s, dh = q.shape
    outs, lses = [], []
    for window, dil in DILATED_PATTERNS:
        ls = s // dil

        def to_sub(a):
            return a.reshape(b, h, ls, dil, dh).transpose(0, 1, 3, 2, 4).reshape(b, h * dil, ls, dh)

        o, lse = banded_attention(to_sub(q), to_sub(k), to_sub(v), window // dil)
        outs.append(o.reshape(b, h, dil, ls, dh).transpose(0, 1, 3, 2, 4).reshape(b, h, s, dh))
        lses.append(lse.reshape(b, h, dil, ls).transpose(0, 1, 3, 2).reshape(b, h, s))
    w = jax.nn.softmax(jnp.stack(lses, 0), axis=0)
    return jnp.einsum('pbhs,pbhsd->bhsd', w.astype(q.dtype), jnp.stack(outs, 0))


def diff_attention(q, k, v, lam_params, norm_g, lam_init):
    b, h2, s, dq = q.shape
    h = h2 // 2
    lp = lam_params.astype(jnp.float32)
    lam = jnp.exp(jnp.sum(lp[0] * lp[1])) - jnp.exp(jnp.sum(lp[2] * lp[3])) + lam_init
    key_pos = jnp.arange(s)

    def block(args):
        qc, bi = args
        sc = jnp.einsum('bmqd,bmkd->bmqk', qc, k).astype(jnp.float32) * dq ** -0.5
        q_pos = bi * Q_BLOCK + jnp.arange(Q_BLOCK)
        sc = jnp.where(key_pos[None, :] <= q_pos[:, None], sc, -jnp.inf)
        a = jax.nn.softmax(sc, axis=-1).reshape(b, h, 2, Q_BLOCK, s)
        w = a[:, :, 0] - lam * a[:, :, 1]
        return jnp.einsum('bhqk,bhkd->bhqd', w.astype(v.dtype), v)

    o = from_query_blocks(lax.map(block, (to_query_blocks(q), jnp.arange(s // Q_BLOCK))))
    of = o.astype(jnp.float32)
    of = of * lax.rsqrt(jnp.mean(jnp.square(of), -1, keepdims=True) + RMS_EPS) * norm_g.astype(jnp.float32)
    return (of * (1.0 - lam_init)).astype(v.dtype)


def stick_breaking_attention(q, k, v):
    b, h, s, dh = q.shape
    key_pos = jnp.arange(s)

    def block(args):
        qc, bi = args
        z = jnp.einsum('bhqd,bhkd->bhqk', qc, k).astype(jnp.float32) * dh ** -0.5
        q_pos = bi * Q_BLOCK + jnp.arange(Q_BLOCK)
        strict = key_pos[None, :] < q_pos[:, None]
        log_beta = jax.nn.log_sigmoid(z)
        log_1m = jnp.where(strict, jax.nn.log_sigmoid(-z), 0.0)
        tail = lax.cumsum(log_1m, axis=3, reverse=True) - log_1m
        a = jnp.where(strict, jnp.exp(log_beta + tail), 0.0)
        return jnp.einsum('bhqk,bhkd->bhqd', a.astype(v.dtype), v)

    return from_query_blocks(lax.map(block, (to_query_blocks(q), jnp.arange(s // Q_BLOCK))))


def mixing_sublayer(x, w_in, w_out, cmp_pe, cmp_w1, cmp_w2, lam_params, diff_g, lam_init):
    proj = jnp.einsum('bsd,dc->bsc', x, w_in)
    (a_q, a_kc, a_vc, a_ks, a_vs, a_kw, a_vw, a_g,
     b_q, b_k, b_v, c_q, c_k, c_v, d_q, d_k, d_v) = split_cols(proj, IN_WIDTHS)
    o_a = nsa_attention(partial_rope(split_heads(a_q, N_HEADS_A)), rope_single(a_kc), a_vc,
                        rope_single(a_ks), a_vs, rope_single(a_kw), a_vw, a_g, cmp_pe, cmp_w1, cmp_w2)
    o_b = dilated_attention(partial_rope(split_heads(b_q, N_HEADS_B)), partial_rope(split_heads(b_k, N_HEADS_B)),
                            split_heads(b_v, N_HEADS_B))
    o_c = diff_attention(partial_rope(split_heads(c_q, 2 * N_HEADS_C)), partial_rope(split_heads(c_k, 2 * N_HEADS_C)),
                         split_heads(c_v, N_HEADS_C), lam_params, diff_g, lam_init)
    o_d = stick_breaking_attention(split_heads(d_q, N_HEADS_D), split_heads(d_k, N_HEADS_D),
                                   split_heads(d_v, N_HEADS_D))
    o = jnp.concatenate([o_a, o_b, o_c, o_d], axis=1)
    b, h, s, dh = o.shape
    return o.transpose(0, 2, 1, 3).reshape(b, s, h * dh) @ w_out


def peer_ffn(x, w_q, sub_keys, u_tab, v_tab):
    b, s, d = x.shape
    t = b * s
    xt = x.reshape(t, d)
    q = (xt @ w_q).reshape(t, PEER_HEADS, 2, PEER_QDIM // 2)
    sc = jnp.einsum('thpc,hpnc->thpn', q, sub_keys).astype(jnp.float32)
    s1, i1 = lax.top_k(sc[:, :, 0], PEER_TOPK)
    s2, i2 = lax.top_k(sc[:, :, 1], PEER_TOPK)
    cand = (s1[..., :, None] + s2[..., None, :]).reshape(t, PEER_HEADS, PEER_TOPK * PEER_TOPK)
    cidx = (i1[..., :, None] * PEER_NKEYS + i2[..., None, :]).reshape(t, PEER_HEADS, PEER_TOPK * PEER_TOPK)
    top_s, pos = lax.top_k(cand, PEER_TOPK)
    eidx = jnp.take_along_axis(cidx, pos, axis=-1)
    gate = jax.nn.softmax(top_s, axis=-1).astype(x.dtype)
    nch = t // PEER_CHUNK

    def chunk(args):
        xc, ec, gc = args
        u = u_tab[ec]
        act = jax.nn.gelu(jnp.einsum('cd,chkd->chk', xc, u))
        vv = v_tab[ec]
        return jnp.einsum('chk,chkd->cd', gc * act, vv)

    out = lax.map(chunk, (xt.reshape(nch, PEER_CHUNK, d),
                          eidx.reshape(nch, PEER_CHUNK, PEER_HEADS, PEER_TOPK),
                          gate.reshape(nch, PEER_CHUNK, PEER_HEADS, PEER_TOPK)))
    return out.reshape(b, s, d)


def setup_inputs(seed: int = 0) -> dict:
    key = jax.random.key(seed)
    ks = jax.random.split(key, 16)

    def nrm(k, shape, scale):
        return jax.random.normal(k, shape, jnp.float32) * scale

    return {
        'x': nrm(ks[0], (BATCH, SEQ, D_MODEL), 1.0),
        'w_in': nrm(ks[1], (DEPTH, D_MODEL, IN_WIDTH), D_MODEL ** -0.5),
        'w_out': nrm(ks[2], (DEPTH, MIX_WIDTH, D_MODEL), DEEPNORM_BETA * MIX_WIDTH ** -0.5),
        'nsa_cmp_pe': nrm(ks[3], (DEPTH, 2, CMP_LEN, HEAD_DIM), 0.02),
        'nsa_cmp_w1': nrm(ks[4], (DEPTH, 2, CMP_LEN * HEAD_DIM, CMP_HIDDEN), (CMP_LEN * HEAD_DIM) ** -0.5),
        'nsa_cmp_w2': nrm(ks[5], (DEPTH, 2, CMP_HIDDEN, HEAD_DIM), CMP_HIDDEN ** -0.5),
        'diff_lambda': nrm(ks[6], (DEPTH, 4, DIFF_QK_DIM), 0.1),
        'diff_norm_g': 1.0 + nrm(ks[7], (DEPTH, HEAD_DIM), 0.02),
        'ln1_g': 1.0 + nrm(ks[8], (DEPTH, D_MODEL), 0.02),
        'ln1_b': nrm(ks[9], (DEPTH, D_MODEL), 0.02),
        'peer_wq': nrm(ks[10], (DEPTH, D_MODEL, PEER_HEADS * PEER_QDIM), D_MODEL ** -0.5),
        'peer_subkeys': nrm(ks[11], (DEPTH, PEER_HEADS, 2, PEER_NKEYS, PEER_QDIM // 2), (PEER_QDIM // 2) ** -0.5),
        'peer_u': nrm(ks[12], (DEPTH, PEER_EXPERTS, D_MODEL), D_MODEL ** -0.5),
        'peer_v': nrm(ks[13], (DEPTH, PEER_EXPERTS, D_MODEL), DEEPNORM_BETA * PEER_HEADS ** -0.5),
        'ln2_g': 1.0 + nrm(ks[14], (DEPTH, D_MODEL), 0.02),
        'ln2_b': nrm(ks[15], (DEPTH, D_MODEL), 0.02),
    }


def reference(x, w_in, w_out, nsa_cmp_pe, nsa_cmp_w1, nsa_cmp_w2, diff_lambda, diff_norm_g,
              ln1_g, ln1_b, peer_wq, peer_subkeys, peer_u, peer_v, ln2_g, ln2_b):
    for l in range(DEPTH):
        lam_init = 0.8 - 0.6 * math.exp(-0.3 * l)
        mix = mixing_sublayer(x, w_in[l], w_out[l], nsa_cmp_pe[l], nsa_cmp_w1[l], nsa_cmp_w2[l],
                              diff_lambda[l], diff_norm_g[l], lam_init)
        x = layer_norm(DEEPNORM_ALPHA * x + mix, ln1_g[l], ln1_b[l])
        ffn = peer_ffn(x, peer_wq[l], peer_subkeys[l], peer_u[l], peer_v[l])
        x = layer_norm(DEEPNORM_ALPHA * x + ffn, ln2_g[l], ln2_b[l])
    return x
```

```cpp
#include <hip/hip_runtime.h>
#include <stdint.h>
#include <stdio.h>

typedef unsigned short bf16_t;
typedef unsigned long long u64;
#define DEV __device__ __forceinline__

constexpr int NB = 2, SEQ = 4096, TT = NB * SEQ, DM = 2048, PW = 6144, NL = 4, INW = 5900;
constexpr int C_AQ = 0, C_AKC = 512, C_AVC = 640, C_AKS = 768, C_AVS = 896, C_AKW = 1024, C_AVW = 1152,
              C_BQ = 1280, C_BK = 1792, C_BV = 2304, C_CQ = 2816, C_CK = 3328, C_CV = 3840,
              C_DQ = 4352, C_DK = 4864, C_DV = 5376, C_AG = 5888;
constexpr float ALPHA = 1.681792830507429f;
constexpr float NEG_INF = -__builtin_inff();

struct Params {
    const float *x, *w_in, *w_out, *cmp_pe, *cmp_w1, *cmp_w2, *diff_lambda, *diff_g, *ln1_g, *ln1_b,
                *peer_wq, *subkeys, *peer_u, *peer_v, *ln2_g, *ln2_b;
    float* out;
    unsigned* bar;
    float *XF, *Y, *Q2, *OACC, *KC, *VC, *ROPE, *SKT, *GATE;
    bf16_t *XB, *P, *OCAT, *WINT, *WOUTT, *WQT, *UB, *VB;
    int* EIDX;
    u64* SEL;
};

DEV float bf2f(bf16_t b) { return __uint_as_float(((unsigned)b) << 16); }
DEV float bflo(unsigned w) { return __uint_as_float(w << 16); }
DEV float bfhi(unsigned w) { return __uint_as_float(w & 0xffff0000u); }
DEV bf16_t f2bf(float f) { unsigned u = __float_as_uint(f); u += 0x7FFFu + ((u >> 16) & 1u); return (bf16_t)(u >> 16); }
DEV unsigned pack2(float a, float b) { return (unsigned)f2bf(a) | ((unsigned)f2bf(b) << 16); }
DEV float wave_sum(float v) {
#pragma unroll
    for (int o = 32; o > 0; o >>= 1) v += __shfl_xor(v, o);
    return v;
}
DEV float wave_max(float v) {
#pragma unroll
    for (int o = 32; o > 0; o >>= 1) v = fmaxf(v, __shfl_xor(v, o));
    return v;
}
DEV float gelu_tanh(float x) {
    const float u = 0.7978845608028654f * (x + 0.044715f * x * x * x);
    const float t = 1.f - 2.f / (__expf(2.f * u) + 1.f);
    return 0.5f * x * (1.f + t);
}
DEV float sigmoidf_(float x) { return 1.f / (1.f + __expf(-x)); }
DEV int srccol_in(int np) { return np < 1280 ? np : (np < 5888 ? np + 12 : (np < 5900 ? 1280 + (np - 5888) : -1)); }

namespace pg8 {
#define PG8_LAS __attribute__((address_space(3)))
typedef unsigned short bf16_t;
typedef short bf16x8 __attribute__((ext_vector_type(8)));
typedef float f32x4 __attribute__((ext_vector_type(4)));
typedef unsigned u32x4 __attribute__((ext_vector_type(4)));
constexpr int BM = 256, BK = 64, HALF = 128, HTB = HALF * BK * 2  , STAGE_BYTES = 8 * HTB, NXCD = 8, WGM = 8;

__host__ __device__ __forceinline__ int lds_byte(int r, int c) { const int st = (r >> 4) * 2 + (c >> 5), rr = r & 15, cc = c & 31, ob = rr * 64 + cc * 2; return st * 1024 + (ob ^ (((ob >> 9) & 1) << 5)); }
__host__ __device__ __forceinline__ void stage_rc(int b, int& R, int& C) { const int st = b / 1024, sb = b % 1024, swz = sb ^ (((sb >> 9) & 1) << 5); R = (st >> 1) * 16 + swz / 64; C = (st & 1) * 32 + (swz % 64) / 2; }
__host__ __device__ __forceinline__ int perm32(int rho) { const int n = rho >> 4, i = rho & 15; return 8 * (i >> 2) + 4 * n + (i & 3); }

struct Unit { int pm, pn; };
struct Gemm { const bf16_t* A; const bf16_t* Bt; int M, N, K; };

struct StaticOrder {
    int nM, nN, nwg, G, c;
    __host__ __device__ void init(int M, int N, int G_, int c_) { nM = M / BM; nN = N / BM; nwg = nM * nN; G = G_; c = c_; }
    __host__ __device__ bool next(int i, Unit& u) const {
        const long L = (long)i * G + c; if (L >= nwg) return false;
        int wgid = (int)L; { const int q = nwg / NXCD, r = nwg % NXCD, xcd = wgid % NXCD, off = wgid / NXCD; wgid = (xcd < r ? xcd * (q + 1) : r * (q + 1) + (xcd - r) * q) + off; }
        const int nig = WGM * nN, gid = wgid / nig, fm = gid * WGM, gsz = (nM - fm) < WGM ? (nM - fm) : WGM;
        u.pm = fm + ((wgid % nig) % gsz); u.pn = (wgid % nig) / gsz; return true;
    }
    __device__ __forceinline__ void a_ready(const Unit&) const {}
    __device__ __forceinline__ void done(const Unit&) const {}
};
__device__ __forceinline__ unsigned cvt_pk_bf16(float lo, float hi) { unsigned r; asm volatile("v_cvt_pk_bf16_f32 %0, %1, %2" : "=v"(r) : "v"(lo), "v"(hi)); return r; }
typedef float f32x2 __attribute__((ext_vector_type(2)));
__device__ __forceinline__ f32x2 gelu_pk(f32x2 v) {
    const f32x2 av = __builtin_elementwise_abs(v), d = av * 0.2316418882f + 1.0f;
    f32x2 t; t.x = __builtin_amdgcn_rcpf(d.x); t.y = __builtin_amdgcn_rcpf(d.y);
    f32x2 q = t * 0.5307027145f + (-0.7265760135f); q = q * t + 0.7107068705f; q = q * t + (-0.142248368f); q = q * t + 0.127414796f; q = q * t;
    const f32x2 s = (v * v) * (-0.72134752044f);
    f32x2 e; e.x = __builtin_amdgcn_exp2f(s.x); e.y = __builtin_amdgcn_exp2f(s.y);
    const f32x2 m = v * (q * e), r = v - m;
    f32x2 o; o.x = v.x < 0.f ? m.x : r.x; o.y = v.y < 0.f ? m.y : r.y; return o;
}

struct EpiF32 {
    static constexpr bool PERM = false, AFTER_DRAIN = false;
    float* C; int ldc; const float* bias;
    __device__ __forceinline__ void operator()(const f32x4 (&acc)[2][2][4][2], const Unit& u, int wr, int wc, int fr, int fq) const {
        const int row0 = u.pm * BM + wr * 64 + fr, col0 = u.pn * BM + wc * 32 + 4 * fq;
        f32x4 bv[2][2];
#pragma unroll
        for (int bj = 0; bj < 2; ++bj)
#pragma unroll
            for (int n = 0; n < 2; ++n) bv[bj][n] = bias ? *(const f32x4*)(bias + col0 + bj * HALF + n * 16) : (f32x4){0.f, 0.f, 0.f, 0.f};
#pragma unroll
        for (int ai = 0; ai < 2; ++ai)
#pragma unroll
            for (int m = 0; m < 4; ++m) { float* rowp = C + (size_t)(row0 + ai * HALF + m * 16) * ldc + col0;
#pragma unroll
                for (int bj = 0; bj < 2; ++bj)
#pragma unroll
                    for (int n = 0; n < 2; ++n) *(f32x4*)(rowp + bj * HALF + n * 16) = acc[ai][bj][m][n] + bv[bj][n]; }
    }
};
template <int ACT  > struct EpiBf16 {
    static constexpr bool PERM = true, AFTER_DRAIN = false;
    bf16_t* O; int ldc; const float* bias; int split_cols; size_t split_stride;
    __device__ __forceinline__ void operator()(const f32x4 (&acc)[2][2][4][2], const Unit& u, int wr, int wc, int fr, int fq) const {
        const int row0 = u.pm * BM + wr * 64 + fr; int colt = u.pn * BM; bf16_t* base = O;
        if (split_cols) { const int t = colt / split_cols; base += (size_t)t * split_stride; colt -= t * split_cols; }
        const int col0 = colt + wc * 32 + 8 * fq, bcol0 = u.pn * BM + wc * 32 + 8 * fq;
        f32x4 bv[2][2];
#pragma unroll
        for (int bj = 0; bj < 2; ++bj)
#pragma unroll
            for (int n = 0; n < 2; ++n) bv[bj][n] = bias ? *(const f32x4*)(bias + bcol0 + bj * HALF + 4 * n) : (f32x4){0.f, 0.f, 0.f, 0.f};
#pragma unroll
        for (int ai = 0; ai < 2; ++ai)
#pragma unroll
            for (int m = 0; m < 4; ++m) { bf16_t* rowp = base + (size_t)(row0 + ai * HALF + m * 16) * ldc + col0;
#pragma unroll
                for (int bj = 0; bj < 2; ++bj) { f32x4 v0 = acc[ai][bj][m][0] + bv[bj][0], v1 = acc[ai][bj][m][1] + bv[bj][1];
                    if (ACT == 1) { f32x2 a = gelu_pk((f32x2){v0[0], v0[1]}), b = gelu_pk((f32x2){v0[2], v0[3]}), c = gelu_pk((f32x2){v1[0], v1[1]}), d = gelu_pk((f32x2){v1[2], v1[3]});
                        v0 = (f32x4){a.x, a.y, b.x, b.y}; v1 = (f32x4){c.x, c.y, d.x, d.y}; }
                    if (ACT == 2) {
#pragma unroll
                        for (int j = 0; j < 4; ++j) { v0[j] = 0.5f * v0[j] * (1.0f + erff(v0[j] * 0.70710678f)); v1[j] = 0.5f * v1[j] * (1.0f + erff(v1[j] * 0.70710678f)); } }
                    u32x4 w; w.x = cvt_pk_bf16(v0[0], v0[1]); w.y = cvt_pk_bf16(v0[2], v0[3]); w.z = cvt_pk_bf16(v1[0], v1[1]); w.w = cvt_pk_bf16(v1[2], v1[3]);
                    *(u32x4*)(rowp + bj * HALF) = w; } }
    }
};
template <class Epi, class Sched, bool STAMP = false>
__device__ __forceinline__ void gemm_phase(PG8_LAS unsigned char* lds, const Gemm g, const Sched& S, const Epi& E, unsigned long long* stamps) {
    const int tid = threadIdx.x, wid = __builtin_amdgcn_readfirstlane(tid >> 6), lane = tid & 63, wr = wid >> 2, wc = wid & 3, fr = lane & 15, fq = lane >> 4;
    const int K = g.K, nt = K / BK;
    int ts_lo = 0, ts_hi = 0, nts = 0; const unsigned long long rt_entry = STAMP ? (unsigned long long)wall_clock64() : 0ull;
#define PG8_STAMP() do { if (STAMP && wid == 0 && nts < 64) { const unsigned long long _c = (unsigned long long)clock64(); \
        ts_lo = (lane == nts) ? (int)(unsigned)_c : ts_lo; ts_hi = (lane == nts) ? (int)(unsigned)(_c >> 32) : ts_hi; ++nts; } } while (0)
    PG8_STAMP();
    unsigned voffA[2], voffB[2];
#pragma unroll
    for (int i = 0; i < 2; ++i) { int R, C; stage_rc(tid * 16 + i * 8192, R, C); const int Rb = Epi::PERM ? ((R & ~31) + perm32(R & 31)) : R;
        voffA[i] = (unsigned)(R * K + C) * 2u; voffB[i] = (unsigned)(Rb * K + C) * 2u; }
    const size_t kstep = (size_t)(BK * 2);
    const size_t hstep = (size_t)HALF * K * 2;
    const size_t tstep = 2 * hstep;
    const unsigned ldsw = (unsigned)wid * 1024u;
    const int aoff = lds_byte(wr * 64 + fr, fq * 8), boff = lds_byte(wc * 32 + fr, fq * 8);
#define PG8_SA(b, h) (((b) * 2 + (h)) * HTB)
#define PG8_SB(b, h) ((4 + (b) * 2 + (h)) * HTB)
#define PG8_STAGE(bufoff, gbase, voff) do { _Pragma("unroll") for (int _i = 0; _i < 2; ++_i) \
        __builtin_amdgcn_global_load_lds((const unsigned*)((const char*)(gbase) + (voff)[_i]), (PG8_LAS unsigned*)(lds + (bufoff) + ldsw + _i * 8192), 16, 0, 0); } while (0)
#define PG8_LDA(dst, b, h) do { _Pragma("unroll") for (int m = 0; m < 4; ++m) _Pragma("unroll") for (int k = 0; k < 2; ++k) dst[m][k] = *(const PG8_LAS bf16x8*)(lds + PG8_SA(b, h) + aoff + m * 2048 + k * 1024); } while (0)
#define PG8_LDB(dst, b, h) do { _Pragma("unroll") for (int n = 0; n < 2; ++n) _Pragma("unroll") for (int k = 0; k < 2; ++k) dst[n][k] = *(const PG8_LAS bf16x8*)(lds + PG8_SB(b, h) + boff + n * 2048 + k * 1024); } while (0)
#define PG8_MMA(ai, bj, At, Bt) do { __builtin_amdgcn_s_setprio(1); _Pragma("unroll") for (int m = 0; m < 4; ++m) _Pragma("unroll") for (int n = 0; n < 2; ++n) _Pragma("unroll") for (int k = 0; k < 2; ++k) \
        acc[ai][bj][m][n] = __builtin_amdgcn_mfma_f32_16x16x32_bf16(Bt[n][k], At[m][k], acc[ai][bj][m][n], 0, 0, 0); __builtin_amdgcn_s_setprio(0); } while (0)
#define PG8_WAIT_V(n) asm volatile("s_waitcnt vmcnt(" #n ")" ::: "memory")
#define PG8_WAIT_L(n) asm volatile("s_waitcnt lgkmcnt(" #n ")" ::: "memory")
#define PG8_BAR __builtin_amdgcn_s_barrier()
#define PG8_SCHED __builtin_amdgcn_sched_barrier(0)
    Unit cur, nxt; int ui = 0;
    if (!S.next(0, cur)) return;
    f32x4 acc[2][2][4][2];
#pragma unroll
    for (int a = 0; a < 2; ++a)
#pragma unroll
        for (int b = 0; b < 2; ++b)
#pragma unroll
            for (int m = 0; m < 4; ++m)
#pragma unroll
                for (int n = 0; n < 2; ++n) acc[a][b][m][n] = (f32x4){0.f, 0.f, 0.f, 0.f};
    bf16x8 At[4][2], B0[2][2], B1[2][2];
    const char* cA = (const char*)g.A + (size_t)cur.pm * tstep; const char* cB = (const char*)g.Bt + (size_t)cur.pn * tstep;
    S.a_ready(cur);
    PG8_STAGE(PG8_SB(0, 0), cB, voffB); PG8_STAGE(PG8_SA(0, 0), cA, voffA); PG8_STAGE(PG8_SB(0, 1), cB + hstep, voffB); PG8_STAGE(PG8_SA(0, 1), cA + hstep, voffA);
    if (wr == 1) PG8_BAR;
    PG8_WAIT_V(4); PG8_BAR;
    PG8_STAGE(PG8_SB(1, 0), cB + kstep, voffB); PG8_STAGE(PG8_SA(1, 0), cA + kstep, voffA); PG8_STAGE(PG8_SB(1, 1), cB + hstep + kstep, voffB);
    PG8_WAIT_V(6); PG8_BAR;
    PG8_STAMP();
    for (;;) {
        const bool has_next = S.next(ui + 1, nxt);
        const char* nA = has_next ? (const char*)g.A + (size_t)nxt.pm * tstep : cA; const char* nB = has_next ? (const char*)g.Bt + (size_t)nxt.pn * tstep : cB;
        for (int t = 0; t < nt; t += 2) {
            const bool last = (t == nt - 2);
            const char* a1 = cA + (size_t)(t + 1) * kstep;
            const char* a2 = last ? nA : cA + (size_t)(t + 2) * kstep; const char* b2 = last ? nB : cB + (size_t)(t + 2) * kstep;
            const char* a3 = a2 + kstep; const char* b3 = b2 + kstep;
            if (last && has_next) S.a_ready(nxt);
            PG8_LDB(B0, 0, 0); PG8_SCHED; PG8_LDA(At, 0, 0); PG8_STAGE(PG8_SA(1, 1), a1 + hstep, voffA);
            PG8_WAIT_L(8); PG8_BAR; PG8_WAIT_L(0); PG8_MMA(0, 0, At, B0); PG8_BAR; PG8_SCHED;
            PG8_LDB(B1, 0, 1); PG8_STAGE(PG8_SB(0, 0), b2, voffB);
            PG8_BAR; PG8_WAIT_L(0); PG8_MMA(0, 1, At, B1); PG8_BAR;
            PG8_LDA(At, 0, 1); PG8_STAGE(PG8_SA(0, 0), a2, voffA);
            PG8_BAR; PG8_WAIT_L(0); PG8_MMA(1, 0, At, B0); PG8_BAR; PG8_SCHED;
            PG8_STAGE(PG8_SB(0, 1), b2 + hstep, voffB);
            PG8_WAIT_V(6); PG8_BAR; PG8_MMA(1, 1, At, B1); PG8_BAR;
            PG8_LDB(B0, 1, 0); PG8_SCHED; PG8_LDA(At, 1, 0); PG8_STAGE(PG8_SA(0, 1), a2 + hstep, voffA);
            PG8_WAIT_L(8); PG8_BAR; PG8_WAIT_L(0); PG8_MMA(0, 0, At, B0); PG8_BAR; PG8_SCHED;
            PG8_LDB(B1, 1, 1); PG8_STAGE(PG8_SB(1, 0), b3, voffB);
            PG8_BAR; PG8_WAIT_L(0); PG8_MMA(0, 1, At, B1); PG8_BAR;
            PG8_LDA(At, 1, 1); PG8_STAGE(PG8_SA(1, 0), a3, voffA);
            PG8_BAR; PG8_WAIT_L(0); PG8_MMA(1, 0, At, B0); PG8_BAR; PG8_SCHED;
            PG8_STAGE(PG8_SB(1, 1), b3 + hstep, voffB);
            PG8_WAIT_V(6); PG8_BAR; PG8_MMA(1, 1, At, B1); PG8_BAR;
        }
        PG8_STAMP();
        if constexpr (!Epi::AFTER_DRAIN) { E(acc, cur, wr, wc, fr, fq); S.done(cur); }
        PG8_STAMP();
        if (!has_next) break;
#pragma unroll
        for (int a = 0; a < 2; ++a)
#pragma unroll
            for (int b = 0; b < 2; ++b)
#pragma unroll
                for (int m = 0; m < 4; ++m)
#pragma unroll
                    for (int n = 0; n < 2; ++n) acc[a][b][m][n] = (f32x4){0.f, 0.f, 0.f, 0.f};
        cur = nxt; cA = nA; cB = nB; ++ui;
    }
    PG8_WAIT_V(0);
    if (wr == 0) PG8_BAR;
    PG8_BAR;
    if constexpr (Epi::AFTER_DRAIN) { E.fused(acc, cur, wr, wc, fr, fq, lds, wid, lane); S.done(cur); }
    PG8_STAMP();
    if (STAMP && wid == 0) { stamps[lane] = lane < nts ? (((unsigned long long)(unsigned)ts_hi << 32) | (unsigned)ts_lo) : 0ull;
        if (lane == 62) stamps[62] = rt_entry; if (lane == 63) stamps[63] = (unsigned long long)wall_clock64(); }
#undef PG8_STAMP
#undef PG8_SA
#undef PG8_SB
#undef PG8_STAGE
#undef PG8_LDA
#undef PG8_LDB
#undef PG8_MMA
#undef PG8_WAIT_V
#undef PG8_WAIT_L
#undef PG8_BAR
#undef PG8_SCHED
}
}


template <int MODE>
DEV void ph_transpose(const float* __restrict__ src, bf16_t* __restrict__ dst, int N, int NP, float* lds, int wg, int nwg) {
    const int tid = threadIdx.x;
    const int ntk = 2048 / 64, ntiles = (NP / 64) * ntk;
    for (int tile = wg; tile < ntiles; tile += nwg) {
        const int n0 = (tile / ntk) * 64, k0 = (tile % ntk) * 64;
        __syncthreads();
        {
            const int nl = tid & 63, np = n0 + nl;
            const int sc = MODE == 1 ? srccol_in(np) : (np < N ? np : -1);
#pragma unroll
            for (int i = 0; i < 8; ++i) { const int kl = (tid >> 6) + 8 * i; lds[kl * 65 + nl] = sc >= 0 ? src[(size_t)(k0 + kl) * N + sc] : 0.f; }
        }
        __syncthreads();
        {
            const int kl = 2 * (tid & 31);
#pragma unroll
            for (int i = 0; i < 4; ++i) { const int nl = (tid >> 5) + 16 * i;
                *(unsigned*)(dst + (size_t)(n0 + nl) * 2048 + k0 + kl) = pack2(lds[kl * 65 + nl], lds[(kl + 1) * 65 + nl]); }
        }
    }
}
DEV void ph_cvt(const float* __restrict__ src, bf16_t* __restrict__ dst, size_t n, int wg, int nwg) {
    const size_t n8 = n / 8;
    for (size_t i = (size_t)wg * 512 + threadIdx.x; i < n8; i += (size_t)nwg * 512) {
        const float4 a = ((const float4*)src)[2 * i], b = ((const float4*)src)[2 * i + 1];
        uint4 w; w.x = pack2(a.x, a.y); w.y = pack2(a.z, a.w); w.z = pack2(b.x, b.y); w.w = pack2(b.z, b.w);
        ((uint4*)dst)[i] = w;
    }
}
DEV void ph_ropetab(float* ROPE, int wg, int nwg) {
    for (int i = wg * 512 + threadIdx.x; i < SEQ * 24; i += nwg * 512) {
        const int pos = i / 24, j = i % 24;
        const float ex = j < 16 ? (float)j / 16.f : (float)(j - 16) / 8.f;
        const float inv = exp2f(-ex * 18.931568569324174f);
        const float ang = (float)pos * inv;
        const double a = (double)ang, k = rint(a * 0.15915494309189535), r = a - k * 6.283185307179586;
        const float rf = (float)r;
        const float s = sinf(rf), c = cosf(rf);
        const int co = j < 16 ? j : 32 + (j - 16), so = j < 16 ? 16 + j : 40 + (j - 16);
        ROPE[pos * 48 + co] = c; ROPE[pos * 48 + so] = s;
    }
}
DEV void ph_skt(const float* __restrict__ sk, float* __restrict__ skt, int wg, int nwg) {
    for (size_t i = (size_t)wg * 512 + threadIdx.x; i < (size_t)NL * 16 * 16384; i += (size_t)nwg * 512) {
        const size_t m = i >> 14; const int r = (int)(i & 16383), c = r >> 7, n = r & 127;
        skt[i] = sk[(m << 14) + (size_t)n * 128 + c];
    }
}

DEV void ph_ln(const float* __restrict__ Y, const float* __restrict__ g, const float* __restrict__ bt, float* XFo, bf16_t* XBo, int wg, int nwg) {
    const int wave = threadIdx.x >> 6, lane = threadIdx.x & 63;
    for (int row = wg * 8 + wave; row < TT; row += nwg * 8) {
        const float4* yr = (const float4*)(Y + (size_t)row * DM);
        float4 v[8]; float s = 0.f;
#pragma unroll
        for (int i = 0; i < 8; ++i) { v[i] = yr[i * 64 + lane]; s += (v[i].x + v[i].y) + (v[i].z + v[i].w); }
        s = wave_sum(s); const float mu = s * (1.f / 2048.f);
        float q = 0.f;
#pragma unroll
        for (int i = 0; i < 8; ++i) { const float a = v[i].x - mu, b = v[i].y - mu, c = v[i].z - mu, d = v[i].w - mu; q += (a * a + b * b) + (c * c + d * d); }
        q = wave_sum(q); const float rstd = rsqrtf(q * (1.f / 2048.f) + 1e-5f);
#pragma unroll
        for (int i = 0; i < 8; ++i) {
            const float4 g4 = ((const float4*)g)[i * 64 + lane], b4 = ((const float4*)bt)[i * 64 + lane];
            float4 o; o.x = (v[i].x - mu) * rstd * g4.x + b4.x; o.y = (v[i].y - mu) * rstd * g4.y + b4.y; o.z = (v[i].z - mu) * rstd * g4.z + b4.z; o.w = (v[i].w - mu) * rstd * g4.w + b4.w;
            if (XFo) ((float4*)(XFo + (size_t)row * DM))[i * 64 + lane] = o;
            if (XBo) { uint2 w; w.x = pack2(o.x, o.y); w.y = pack2(o.z, o.w); ((uint2*)(XBo + (size_t)row * DM))[i * 64 + lane] = w; }
        }
    }
}

DEV void ph_rope(bf16_t* P, const float* __restrict__ ROPE, int wg, int nwg) {
    for (size_t i = (size_t)wg * 512 + threadIdx.x; i < (size_t)TT * 368; i += (size_t)nwg * 512) {
        const int tok = (int)(i / 368), r = (int)(i % 368), pos = tok & (SEQ - 1);
        int col1, col2; float c, s;
        if (r < 240) { const int hd = r >> 4, j = r & 15;
            const int base = hd < 4 ? C_AQ + hd * 128 : hd == 4 ? C_AKC : hd == 5 ? C_AKS : hd == 6 ? C_AKW : hd < 11 ? C_BQ + (hd - 7) * 128 : C_BK + (hd - 11) * 128;
            col1 = base + j; col2 = base + 16 + j; c = ROPE[pos * 48 + j]; s = ROPE[pos * 48 + 16 + j]; }
        else { const int r2 = r - 240, hd = r2 >> 3, j = r2 & 7;
            const int base = hd < 8 ? C_CQ + hd * 64 : C_CK + (hd - 8) * 64;
            col1 = base + j; col2 = base + 8 + j; c = ROPE[pos * 48 + 32 + j]; s = ROPE[pos * 48 + 40 + j]; }
        bf16_t* row = P + (size_t)tok * PW;
        const float x1 = bf2f(row[col1]), x2 = bf2f(row[col2]);
        row[col1] = f2bf(x1 * c - x2 * s); row[col2] = f2bf(x1 * s + x2 * c);
    }
}

DEV void ph_compress(const Params& p, int l, float* lds, int wg, int nwg) {
    float* td = lds;
    float* pe = lds + 144 * 128;
    float* hid = pe + 4096;
    const int tid = threadIdx.x;
    for (int unit = wg; unit < 128; unit += nwg) {
        const int kv = unit >> 6, b = (unit >> 5) & 1, grp = unit & 31, c0 = grp * 8, tb0 = c0 * 16;
        const int col = kv ? C_AVC : C_AKC;
        const float* w1 = p.cmp_w1 + ((size_t)l * 2 + kv) * 4096 * 256;
        const float* w2 = p.cmp_w2 + ((size_t)l * 2 + kv) * 256 * 128;
        const float* peg = p.cmp_pe + ((size_t)l * 2 + kv) * 4096;
        __syncthreads();
        for (int i = tid; i < 144 * 16; i += 512) { const int tl = i >> 4, c8 = (i & 15) * 8, tk = tb0 + tl;
            float4 a = {0.f, 0.f, 0.f, 0.f}, bb = a;
            if (tk < SEQ) { const uint4 w = *(const uint4*)(p.P + ((size_t)b * SEQ + tk) * PW + col + c8);
                a = {bflo(w.x), bfhi(w.x), bflo(w.y), bfhi(w.y)}; bb = {bflo(w.z), bfhi(w.z), bflo(w.w), bfhi(w.w)}; }
            *(float4*)(td + tl * 128 + c8) = a; *(float4*)(td + tl * 128 + c8 + 4) = bb; }
        for (int i = tid; i < 4096; i += 512) pe[i] = peg[i];
        __syncthreads();
        {
            const int j = tid & 255, rg = tid >> 8;
            float acc0 = 0.f, acc1 = 0.f, acc2 = 0.f, acc3 = 0.f, bias = 0.f;
            const float* t0 = td + (rg * 4 + 0) * 2048; const float* t1 = td + (rg * 4 + 1) * 2048; const float* t2 = td + (rg * 4 + 2) * 2048; const float* t3 = td + (rg * 4 + 3) * 2048;
            for (int i = 0; i < 4096; i += 4) {
                const float wa = w1[(size_t)(i + 0) * 256 + j], wb = w1[(size_t)(i + 1) * 256 + j], wc = w1[(size_t)(i + 2) * 256 + j], wd = w1[(size_t)(i + 3) * 256 + j];
                const float4 pp = *(const float4*)(pe + i);
                bias += pp.x * wa + pp.y * wb + pp.z * wc + pp.w * wd;
                float4 x = *(const float4*)(t0 + i); acc0 += x.x * wa + x.y * wb + x.z * wc + x.w * wd;
                x = *(const float4*)(t1 + i); acc1 += x.x * wa + x.y * wb + x.z * wc + x.w * wd;
                x = *(const float4*)(t2 + i); acc2 += x.x * wa + x.y * wb + x.z * wc + x.w * wd;
                x = *(const float4*)(t3 + i); acc3 += x.x * wa + x.y * wb + x.z * wc + x.w * wd;
            }
            hid[(rg * 4 + 0) * 256 + j] = gelu_tanh(acc0 + bias); hid[(rg * 4 + 1) * 256 + j] = gelu_tanh(acc1 + bias);
            hid[(rg * 4 + 2) * 256 + j] = gelu_tanh(acc2 + bias); hid[(rg * 4 + 3) * 256 + j] = gelu_tanh(acc3 + bias);
        }
        __syncthreads();
        {
            const int n = tid & 127, r0 = (tid >> 7) * 2;
            float a0 = 0.f, a1 = 0.f;
            for (int j = 0; j < 256; ++j) { const float w = w2[j * 128 + n]; a0 += hid[r0 * 256 + j] * w; a1 += hid[(r0 + 1) * 256 + j] * w; }
            float* dst = (kv ? p.VC : p.KC) + ((size_t)b * 256 + c0) * 128;
            dst[(r0 + 0) * 128 + n] = (c0 + r0 + 0 < 255) ? a0 : 0.f;
            dst[(r0 + 1) * 128 + n] = (c0 + r0 + 1 < 255) ? a1 : 0.f;
        }
    }
}

DEV void ph_nsa_cmp(const Params& p, int l, float* lds, int wg, int nwg) {
    float* qs = lds;
    float* sc = lds + 64 * 128;
    float* imp = sc + 64 * 256;
    const int tid = threadIdx.x, lane = tid & 63, wave = tid >> 6;
    for (int unit = wg; unit < TT / 16; unit += nwg) {
        const int tok0 = unit * 16, b = tok0 >> 12, pos0 = tok0 & (SEQ - 1);
        __syncthreads();
        { const int row = tid >> 3, ch = (tid & 7) * 16, tl = row >> 2, h = row & 3;
          const bf16_t* src = p.P + (size_t)(tok0 + tl) * PW + C_AQ + h * 128 + ch;
          const uint4 w0 = *(const uint4*)src, w1 = *(const uint4*)(src + 8);
          float* d = qs + row * 128 + ch;
          *(float4*)(d + 0) = {bflo(w0.x), bfhi(w0.x), bflo(w0.y), bfhi(w0.y)}; *(float4*)(d + 4) = {bflo(w0.z), bfhi(w0.z), bflo(w0.w), bfhi(w0.w)};
          *(float4*)(d + 8) = {bflo(w1.x), bfhi(w1.x), bflo(w1.y), bfhi(w1.y)}; *(float4*)(d + 12) = {bflo(w1.z), bfhi(w1.z), bflo(w1.w), bfhi(w1.w)}; }
        __syncthreads();
        {
            const int c = tid & 255, rg = tid >> 8;
            float acc[32];
#pragma unroll
            for (int r = 0; r < 32; ++r) acc[r] = 0.f;
            const float4* kr = (const float4*)(p.KC + ((size_t)b * 256 + c) * 128);
            for (int d4 = 0; d4 < 32; ++d4) { const float4 kv = kr[d4];
#pragma unroll
                for (int r = 0; r < 32; ++r) { const float4 q = *(const float4*)(qs + (rg * 32 + r) * 128 + d4 * 4); acc[r] += q.x * kv.x + q.y * kv.y + q.z * kv.z + q.w * kv.w; } }
#pragma unroll
            for (int r = 0; r < 32; ++r) { const int row = rg * 32 + r, pos = pos0 + (row >> 2);
                sc[row * 256 + c] = (16 * c + 31 <= pos) ? acc[r] * 0.08838834764831845f : NEG_INF; }
        }
        __syncthreads();
        for (int rr = 0; rr < 8; ++rr) {
            float* r = sc + (wave * 8 + rr) * 256;
            float v0 = r[lane], v1 = r[lane + 64], v2 = r[lane + 128], v3 = r[lane + 192];
            float m = wave_max(fmaxf(fmaxf(v0, v1), fmaxf(v2, v3)));
            if (m == NEG_INF) m = 0.f;
            v0 = __expf(v0 - m); v1 = __expf(v1 - m); v2 = __expf(v2 - m); v3 = __expf(v3 - m);
            const float s = wave_sum((v0 + v1) + (v2 + v3)), inv = 1.f / fmaxf(s, 1e-30f);
            r[lane] = v0 * inv; r[lane + 64] = v1 * inv; r[lane + 128] = v2 * inv; r[lane + 192] = v3 * inv;
        }
        __syncthreads();
        {
            const int d = tid & 127, rgp = tid >> 7;
            float acc[16];
#pragma unroll
            for (int r = 0; r < 16; ++r) acc[r] = 0.f;
            const float* vcb = p.VC + (size_t)b * 256 * 128 + d;
            for (int c = 0; c < 256; c += 4) { const float va = vcb[(c + 0) * 128], vb = vcb[(c + 1) * 128], vc = vcb[(c + 2) * 128], vd = vcb[(c + 3) * 128];
#pragma unroll
                for (int r = 0; r < 16; ++r) { const float4 pp = *(const float4*)(sc + (rgp * 16 + r) * 256 + c); acc[r] += pp.x * va + pp.y * vb + pp.z * vc + pp.w * vd; } }
#pragma unroll
            for (int r = 0; r < 16; ++r) { const int row = rgp * 16 + r, tl = row >> 2, h = row & 3; const size_t tok = (size_t)tok0 + tl;
                const float g = sigmoidf_(bf2f(p.P[tok * PW + C_AG + h]));
                p.OACC[tok * DM + h * 128 + d] = g * acc[r]; }
        }
        {
            const int tl = tid >> 5, tb = (pos0 + tl) >> 6;
#pragma unroll
            for (int q = 0; q < 2; ++q) { const int j = (tid & 31) + 32 * q; float v = 0.f;
                const int clo = (4 * j - 1) < 0 ? 0 : 4 * j - 1, chi = (4 * j + 3) > 254 ? 254 : 4 * j + 3;
                for (int h = 0; h < 4; ++h) for (int c = clo; c <= chi; ++c) v += sc[(tl * 4 + h) * 256 + c];
                if (j == 0 || j == tb || j == tb - 1) v += 1000.f;
                imp[tl * 64 + j] = (j <= tb) ? v : NEG_INF; }
        }
        __syncthreads();
        for (int q = 0; q < 2; ++q) {
            const int tl = wave + 8 * q; const float v = imp[tl * 64 + lane];
            int rank = 0;
            for (int jp = 0; jp < 64; ++jp) { const float o = __shfl(v, jp); rank += (o > v || (o == v && jp < lane)) ? 1 : 0; }
            const u64 m = __ballot(v != NEG_INF && rank < 16);
            if (lane == 0) p.SEL[tok0 + tl] = m;
        }
    }
}

enum { V_SLC = 0, V_WIN = 1, V_DIL = 2, V_DIFF = 3, V_STICK = 4 };
template <int VAR> DEV int attn_units() { return VAR == V_DIFF ? 256 : 128; }

template <int VAR>
DEV void attn_naive_unit(const Params& p, int l, int unit, float* lds) {
    constexpr int NQ4 = (VAR == V_DIFF) ? 8 : 16;
    float* Ks = lds; float* Vs = lds + 64 * 128;
    const int tid = threadIdx.x, row = tid >> 1, hf = tid & 1;
    int b, h, tq, qcol, kcol, vcol, koff = 0, tile_lo, tile_hi;
    if (VAR == V_SLC || VAR == V_WIN) { b = unit >> 6; const int qb = unit & 63; h = row & 3; tq = qb * 64 + (row >> 2); qcol = C_AQ + h * 128;
        kcol = VAR == V_SLC ? C_AKS : C_AKW; vcol = VAR == V_SLC ? C_AVS : C_AVW; tile_hi = qb; tile_lo = VAR == V_SLC ? 0 : (qb - 8 < 0 ? 0 : qb - 8); }
    else if (VAR == V_DIL) { b = unit >> 6; h = (unit >> 4) & 3; const int qb = unit & 15; tq = qb * 256 + row; qcol = C_BQ + h * 128; kcol = C_BK + h * 128; vcol = C_BV + h * 128;
        tile_hi = qb * 4 + 3; tile_lo = qb * 4 - 32 < 0 ? 0 : qb * 4 - 32; }
    else if (VAR == V_DIFF) { b = unit >> 7; h = (unit >> 5) & 3; const int qb = unit & 31, map = row & 1; tq = qb * 128 + (row >> 1); qcol = C_CQ + (2 * h + map) * 64;
        kcol = C_CK + h * 128; koff = map * 64; vcol = C_CV + h * 128; tile_lo = 0; tile_hi = qb * 2 + 1; }
    else { b = unit >> 6; h = (unit >> 4) & 3; const int qb = unit & 15; tq = qb * 256 + row; qcol = C_DQ + h * 128; kcol = C_DK + h * 128; vcol = C_DV + h * 128; tile_lo = 0; tile_hi = qb * 4 + 3; }
    const size_t tokq = (size_t)b * SEQ + tq;
    const bf16_t* Pb = p.P;
    float4 q4[NQ4];
#pragma unroll
    for (int i = 0; i < NQ4; ++i) { const uint2 w = *(const uint2*)(Pb + tokq * PW + qcol + (2 * i + hf) * 4); q4[i] = {bflo(w.x), bfhi(w.x), bflo(w.y), bfhi(w.y)}; }
    float o[64];
#pragma unroll
    for (int i = 0; i < 64; ++i) o[i] = 0.f;
    float m = NEG_INF, lsum = 0.f, run = 0.f;
    u64 sel = 0; if (VAR == V_SLC) sel = p.SEL[tokq];
    const float scale = VAR == V_DIFF ? 0.125f : 0.08838834764831845f;
    const int ntiles = tile_hi - tile_lo + 1;
    for (int it = 0; it < ntiles; ++it) {
        const int tile = VAR == V_STICK ? tile_hi - it : tile_lo + it;
        __syncthreads();
#pragma unroll
        for (int ps = 0; ps < 2; ++ps) { const int key = (tid >> 4) + 32 * ps, c8 = (tid & 15) * 8; const size_t base = ((size_t)b * SEQ + tile * 64 + key) * PW;
            const uint4 kw = *(const uint4*)(Pb + base + kcol + c8), vw = *(const uint4*)(Pb + base + vcol + c8);
            *(float4*)(Ks + key * 128 + c8) = {bflo(kw.x), bfhi(kw.x), bflo(kw.y), bfhi(kw.y)}; *(float4*)(Ks + key * 128 + c8 + 4) = {bflo(kw.z), bfhi(kw.z), bflo(kw.w), bfhi(kw.w)};
            *(float4*)(Vs + key * 128 + c8) = {bflo(vw.x), bfhi(vw.x), bflo(vw.y), bfhi(vw.y)}; *(float4*)(Vs + key * 128 + c8 + 4) = {bflo(vw.z), bfhi(vw.z), bflo(vw.w), bfhi(vw.w)}; }
        __syncthreads();
        for (int jj = 0; jj < 64; ++jj) {
            const int j = VAR == V_STICK ? 63 - jj : jj, kpos = tile * 64 + j;
            const float4* kr = (const float4*)(Ks + j * 128 + koff);
            float s = 0.f;
#pragma unroll
            for (int i = 0; i < NQ4; ++i) { const float4 kv = kr[2 * i + hf]; s += q4[i].x * kv.x + q4[i].y * kv.y + q4[i].z * kv.z + q4[i].w * kv.w; }
            s += __shfl_xor(s, 1); s *= scale;
            const float4* vr = (const float4*)(Vs + j * 128);
            if (VAR == V_STICK) {
                if (kpos < tq) { const float ls = fminf(s, 0.f) - log1pf(__expf(-fabsf(s))); const float a = __expf(ls + run); run += ls - s;
#pragma unroll
                    for (int i = 0; i < 16; ++i) { const float4 vv = vr[2 * i + hf]; o[4 * i] += a * vv.x; o[4 * i + 1] += a * vv.y; o[4 * i + 2] += a * vv.z; o[4 * i + 3] += a * vv.w; } }
            } else {
                float w;
                const int dist = tq - kpos;
                if (VAR == V_SLC) w = (dist >= 0 && ((sel >> (kpos >> 6)) & 1ull)) ? 1.f : 0.f;
                else if (VAR == V_WIN) w = (dist >= 0 && dist <= 511) ? 1.f : 0.f;
                else if (VAR == V_DIL) w = dist < 0 ? 0.f : (float)((dist <= 128 ? 1 : 0) + (((dist & 3) == 0 && dist <= 512) ? 1 : 0) + (((dist & 15) == 0 && dist <= 2048) ? 1 : 0));
                else w = dist >= 0 ? 1.f : 0.f;
                if (w > 0.f) {
                    if (s > m) { const float cs = __expf(m - s); lsum *= cs;
#pragma unroll
                        for (int i = 0; i < 64; ++i) o[i] *= cs;
                        m = s; }
                    const float pz = w * __expf(s - m); lsum += pz;
#pragma unroll
                    for (int i = 0; i < 16; ++i) { const float4 vv = vr[2 * i + hf]; o[4 * i] += pz * vv.x; o[4 * i + 1] += pz * vv.y; o[4 * i + 2] += pz * vv.z; o[4 * i + 3] += pz * vv.w; }
                }
            }
        }
        if (VAR == V_STICK) { if (__syncthreads_and(run < -110.f)) break; }
    }
    if (VAR == V_SLC || VAR == V_WIN) {
        const int br = VAR == V_SLC ? 1 : 2; const float g = sigmoidf_(bf2f(Pb[tokq * PW + C_AG + br * 4 + h])), f = g / lsum;
        float* dst = p.OACC + tokq * DM + h * 128;
#pragma unroll
        for (int i = 0; i < 16; ++i) { float4* d4 = (float4*)(dst + (2 * i + hf) * 4); float4 cur = *d4; cur.x += f * o[4 * i]; cur.y += f * o[4 * i + 1]; cur.z += f * o[4 * i + 2]; cur.w += f * o[4 * i + 3]; *d4 = cur; }
    } else if (VAR == V_DIL || VAR == V_STICK) {
        const float f = VAR == V_DIL ? 1.f / lsum : 1.f;
        float* dst = p.OACC + tokq * DM + (VAR == V_DIL ? 512 : 1536) + h * 128;
#pragma unroll
        for (int i = 0; i < 16; ++i) { float4 r = {f * o[4 * i], f * o[4 * i + 1], f * o[4 * i + 2], f * o[4 * i + 3]}; *(float4*)(dst + (2 * i + hf) * 4) = r; }
    } else {
        const float* lp = p.diff_lambda + (size_t)l * 256;
        float d01 = 0.f, d23 = 0.f;
        for (int i = 0; i < 64; ++i) { d01 += lp[i] * lp[64 + i]; d23 += lp[128 + i] * lp[192 + i]; }
        const float lam_init = 0.8f - 0.6f * expf(-0.3f * (float)l), lam = expf(d01) - expf(d23) + lam_init;
        const float inv = 1.f / lsum; float ss = 0.f;
#pragma unroll
        for (int i = 0; i < 64; ++i) { const float v = o[i] * inv, ot = __shfl_xor(v, 2); o[i] = v - lam * ot; ss += o[i] * o[i]; }
        ss += __shfl_xor(ss, 1);
        const float rs = rsqrtf(ss * (1.f / 128.f) + 1e-6f) * (1.f - lam_init);
        if ((row & 1) == 0) { const float* gg = p.diff_g + (size_t)l * 128; float* dst = p.OACC + tokq * DM + 1024 + h * 128;
#pragma unroll
            for (int i = 0; i < 16; ++i) { const int d0 = (2 * i + hf) * 4; const float4 g4 = *(const float4*)(gg + d0);
                float4 r = {o[4 * i] * rs * g4.x, o[4 * i + 1] * rs * g4.y, o[4 * i + 2] * rs * g4.z, o[4 * i + 3] * rs * g4.w}; *(float4*)(dst + d0) = r; } }
    }
}
template <int VAR>
DEV void ph_attn_naive(const Params& p, int l, float* lds, int wg, int nwg) {
    for (int unit = wg; unit < attn_units<VAR>(); unit += nwg) attn_naive_unit<VAR>(p, l, unit, lds);
}

DEV void ph_peer_select(const Params& p, int l, float* lds, int wg, int nwg) {
    float* qs = lds;
    float* scs = lds + 8 * 2048;
    const int tid = threadIdx.x, lane = tid & 63, h = tid >> 6;
    for (int unit = wg; unit < TT / 8; unit += nwg) {
        const int tok0 = unit * 8;
        __syncthreads();
#pragma unroll
        for (int i = 0; i < 8; ++i) ((float4*)qs)[i * 512 + tid] = ((const float4*)(p.Q2 + (size_t)tok0 * DM))[i * 512 + tid];
        __syncthreads();
        {
            float acc[8][4];
#pragma unroll
            for (int t = 0; t < 8; ++t) { acc[t][0] = 0.f; acc[t][1] = 0.f; acc[t][2] = 0.f; acc[t][3] = 0.f; }
            const float* s0 = p.SKT + (((size_t)l * 8 + h) * 2 + 0) * 16384, * s1 = s0 + 16384;
            for (int c = 0; c < 128; c += 4) {
                float wa[4], wb[4], wc[4], wd[4];
#pragma unroll
                for (int k = 0; k < 4; ++k) { wa[k] = s0[(c + k) * 128 + lane]; wb[k] = s0[(c + k) * 128 + 64 + lane]; wc[k] = s1[(c + k) * 128 + lane]; wd[k] = s1[(c + k) * 128 + 64 + lane]; }
#pragma unroll
                for (int t = 0; t < 8; ++t) { const float4 q0 = *(const float4*)(qs + t * 2048 + h * 256 + c), q1 = *(const float4*)(qs + t * 2048 + h * 256 + 128 + c);
                    acc[t][0] += q0.x * wa[0] + q0.y * wa[1] + q0.z * wa[2] + q0.w * wa[3]; acc[t][1] += q0.x * wb[0] + q0.y * wb[1] + q0.z * wb[2] + q0.w * wb[3];
                    acc[t][2] += q1.x * wc[0] + q1.y * wc[1] + q1.z * wc[2] + q1.w * wc[3]; acc[t][3] += q1.x * wd[0] + q1.y * wd[1] + q1.z * wd[2] + q1.w * wd[3]; }
            }
#pragma unroll
            for (int t = 0; t < 8; ++t) { float* d = scs + (t * 8 + h) * 256; d[lane] = acc[t][0]; d[64 + lane] = acc[t][1]; d[128 + lane] = acc[t][2]; d[192 + lane] = acc[t][3]; }
        }
        __builtin_amdgcn_s_waitcnt(0);
        for (int t = 0; t < 8; ++t) {
            const float* d = scs + (t * 8 + h) * 256;
            float a = d[lane], bq = d[64 + lane], c2 = d[128 + lane], d2 = d[192 + lane];
            float ts1 = NEG_INF, ts2 = NEG_INF; int ti1 = 0, ti2 = 0;
            for (int k = 0; k < 16; ++k) {
                { const float mx = wave_max(fmaxf(a, bq)); const u64 ba = __ballot(a == mx), bb = __ballot(bq == mx); int n;
                  if (ba) { const int ln = __ffsll((long long)ba) - 1; n = ln; if (lane == ln) a = NEG_INF; } else { const int ln = __ffsll((long long)bb) - 1; n = ln + 64; if (lane == ln) bq = NEG_INF; }
                  if (lane == k) { ts1 = mx; ti1 = n; } }
                { const float mx = wave_max(fmaxf(c2, d2)); const u64 ba = __ballot(c2 == mx), bb = __ballot(d2 == mx); int n;
                  if (ba) { const int ln = __ffsll((long long)ba) - 1; n = ln; if (lane == ln) c2 = NEG_INF; } else { const int ln = __ffsll((long long)bb) - 1; n = ln + 64; if (lane == ln) d2 = NEG_INF; }
                  if (lane == k) { ts2 = mx; ti2 = n; } }
            }
            const float s1i = __shfl(ts1, lane >> 2); const int jb = (lane & 3) * 4;
            float c0 = s1i + __shfl(ts2, jb), c1 = s1i + __shfl(ts2, jb + 1), c2b = s1i + __shfl(ts2, jb + 2), c3 = s1i + __shfl(ts2, jb + 3);
            float fs = NEG_INF; int fe = 0;
            for (int k = 0; k < 16; ++k) {
                const float lm = fmaxf(fmaxf(c0, c1), fmaxf(c2b, c3)), mx = wave_max(lm);
                const u64 bal = __ballot(lm == mx); const int ln = __ffsll((long long)bal) - 1;
                int jj = 0;
                if (lane == ln) { if (c0 == mx) { jj = 0; c0 = NEG_INF; } else if (c1 == mx) { jj = 1; c1 = NEG_INF; } else if (c2b == mx) { jj = 2; c2b = NEG_INF; } else { jj = 3; c3 = NEG_INF; } }
                jj = __shfl(jj, ln);
                const int pos = ln * 4 + jj;
                const int i1 = __shfl(ti1, pos >> 4), i2 = __shfl(ti2, pos & 15);
                if (lane == k) { fs = mx; fe = i1 * 128 + i2; }
            }
            const float mx = __shfl(fs, 0); const float e = lane < 16 ? __expf(fs - mx) : 0.f; const float sm = wave_sum(e);
            if (lane < 16) { const size_t o = (size_t)(tok0 + t) * 128 + h * 16 + lane; p.EIDX[o] = fe; p.GATE[o] = e / sm; }
        }
    }
}

DEV void ph_peer_apply(const Params& p, int l, const float* __restrict__ xin, int wg, int nwg) {
    const int wave = threadIdx.x >> 6, lane = threadIdx.x & 63;
    const bf16_t* UBl = p.UB + (size_t)l * 16384 * 2048; const bf16_t* VBl = p.VB + (size_t)l * 16384 * 2048;
    for (int tok = wg * 8 + wave; tok < TT; tok += nwg * 8) {
        float xv[32], acc[32];
#pragma unroll
        for (int i = 0; i < 4; ++i) { const float4 a = *(const float4*)(xin + (size_t)tok * DM + i * 512 + lane * 8), bb = *(const float4*)(xin + (size_t)tok * DM + i * 512 + lane * 8 + 4);
            xv[i * 8 + 0] = a.x; xv[i * 8 + 1] = a.y; xv[i * 8 + 2] = a.z; xv[i * 8 + 3] = a.w; xv[i * 8 + 4] = bb.x; xv[i * 8 + 5] = bb.y; xv[i * 8 + 6] = bb.z; xv[i * 8 + 7] = bb.w; }
#pragma unroll
        for (int i = 0; i < 32; ++i) acc[i] = 0.f;
        for (int k0 = 0; k0 < 128; k0 += 2) {
            const int e0 = p.EIDX[(size_t)tok * 128 + k0], e1 = p.EIDX[(size_t)tok * 128 + k0 + 1];
            const float g0 = p.GATE[(size_t)tok * 128 + k0], g1 = p.GATE[(size_t)tok * 128 + k0 + 1];
            const uint4* u0 = (const uint4*)(UBl + (size_t)e0 * 2048); const uint4* u1 = (const uint4*)(UBl + (size_t)e1 * 2048);
            float d0 = 0.f, d1 = 0.f;
#pragma unroll
            for (int i = 0; i < 4; ++i) { const uint4 w0 = u0[i * 64 + lane], w1 = u1[i * 64 + lane];
                d0 += xv[i * 8 + 0] * bflo(w0.x) + xv[i * 8 + 1] * bfhi(w0.x) + xv[i * 8 + 2] * bflo(w0.y) + xv[i * 8 + 3] * bfhi(w0.y) + xv[i * 8 + 4] * bflo(w0.z) + xv[i * 8 + 5] * bfhi(w0.z) + xv[i * 8 + 6] * bflo(w0.w) + xv[i * 8 + 7] * bfhi(w0.w);
                d1 += xv[i * 8 + 0] * bflo(w1.x) + xv[i * 8 + 1] * bfhi(w1.x) + xv[i * 8 + 2] * bflo(w1.y) + xv[i * 8 + 3] * bfhi(w1.y) + xv[i * 8 + 4] * bflo(w1.z) + xv[i * 8 + 5] * bfhi(w1.z) + xv[i * 8 + 6] * bflo(w1.w) + xv[i * 8 + 7] * bfhi(w1.w); }
            d0 = wave_sum(d0); d1 = wave_sum(d1);
            const float h0 = g0 * gelu_tanh(d0), h1 = g1 * gelu_tanh(d1);
            const uint4* v0 = (const uint4*)(VBl + (size_t)e0 * 2048); const uint4* v1 = (const uint4*)(VBl + (size_t)e1 * 2048);
#pragma unroll
            for (int i = 0; i < 4; ++i) { const uint4 w0 = v0[i * 64 + lane], w1 = v1[i * 64 + lane];
                acc[i * 8 + 0] += h0 * bflo(w0.x) + h1 * bflo(w1.x); acc[i * 8 + 1] += h0 * bfhi(w0.x) + h1 * bfhi(w1.x);
                acc[i * 8 + 2] += h0 * bflo(w0.y) + h1 * bflo(w1.y); acc[i * 8 + 3] += h0 * bfhi(w0.y) + h1 * bfhi(w1.y);
                acc[i * 8 + 4] += h0 * bflo(w0.z) + h1 * bflo(w1.z); acc[i * 8 + 5] += h0 * bfhi(w0.z) + h1 * bfhi(w1.z);
                acc[i * 8 + 6] += h0 * bflo(w0.w) + h1 * bflo(w1.w); acc[i * 8 + 7] += h0 * bfhi(w0.w) + h1 * bfhi(w1.w); }
        }
#pragma unroll
        for (int i = 0; i < 4; ++i) { float* d = p.Y + (size_t)tok * DM + i * 512 + lane * 8;
            float4 a = {ALPHA * xv[i * 8 + 0] + acc[i * 8 + 0], ALPHA * xv[i * 8 + 1] + acc[i * 8 + 1], ALPHA * xv[i * 8 + 2] + acc[i * 8 + 2], ALPHA * xv[i * 8 + 3] + acc[i * 8 + 3]};
            float4 bb = {ALPHA * xv[i * 8 + 4] + acc[i * 8 + 4], ALPHA * xv[i * 8 + 5] + acc[i * 8 + 5], ALPHA * xv[i * 8 + 6] + acc[i * 8 + 6], ALPHA * xv[i * 8 + 7] + acc[i * 8 + 7]};
            *(float4*)d = a; *(float4*)(d + 4) = bb; }
    }
}

struct EpiResF32 {
    static constexpr bool PERM = false, AFTER_DRAIN = false;
    float* C; const float* X; float alpha;
    __device__ __forceinline__ void operator()(const pg8::f32x4 (&acc)[2][2][4][2], const pg8::Unit& u, int wr, int wc, int fr, int fq) const {
        const int row0 = u.pm * 256 + wr * 64 + fr, col0 = u.pn * 256 + wc * 32 + 4 * fq;
#pragma unroll
        for (int ai = 0; ai < 2; ++ai)
#pragma unroll
            for (int m = 0; m < 4; ++m) { const size_t off = (size_t)(row0 + ai * 128 + m * 16) * DM + col0;
#pragma unroll
                for (int bj = 0; bj < 2; ++bj)
#pragma unroll
                    for (int n = 0; n < 2; ++n) { const pg8::f32x4 xv = *(const pg8::f32x4*)(X + off + bj * 128 + n * 16); *(pg8::f32x4*)(C + off + bj * 128 + n * 16) = acc[ai][bj][m][n] + xv * alpha; } }
    }
};
DEV void ph_gemm_in(const Params& p, int l, unsigned char* smem, int wg, int nwg) {
    pg8::Gemm g{p.XB, p.WINT + (size_t)l * PW * DM, TT, PW, DM};
    pg8::StaticOrder S; S.init(TT, PW, nwg, wg);
    pg8::EpiBf16<0> E{p.P, PW, nullptr, 0, 0};
    pg8::gemm_phase<pg8::EpiBf16<0>, pg8::StaticOrder, false>((PG8_LAS unsigned char*)smem, g, S, E, nullptr);
}
DEV void ph_gemm_out(const Params& p, int l, const float* xres, unsigned char* smem, int wg, int nwg) {
    pg8::Gemm g{p.OCAT, p.WOUTT + (size_t)l * DM * DM, TT, DM, DM};
    pg8::StaticOrder S; S.init(TT, DM, nwg, wg);
    EpiResF32 E{p.Y, xres, ALPHA};
    pg8::gemm_phase<EpiResF32, pg8::StaticOrder, false>((PG8_LAS unsigned char*)smem, g, S, E, nullptr);
}
DEV void ph_gemm_q(const Params& p, int l, unsigned char* smem, int wg, int nwg) {
    pg8::Gemm g{p.XB, p.WQT + (size_t)l * DM * DM, TT, DM, DM};
    pg8::StaticOrder S; S.init(TT, DM, nwg, wg);
    pg8::EpiF32 E{p.Q2, DM, nullptr};
    pg8::gemm_phase<pg8::EpiF32, pg8::StaticOrder, false>((PG8_LAS unsigned char*)smem, g, S, E, nullptr);
}

enum { PH_PRO = 0, PH_GEMM_IN, PH_ROPE, PH_COMPRESS, PH_NSA_CMP, PH_SLC, PH_WIN, PH_DIL, PH_DIFF, PH_STICK, PH_OCVT, PH_GEMM_OUT, PH_LN1, PH_GEMM_Q, PH_PSEL, PH_PAPPLY, PH_LN2, PH_COUNT };

template <int PH>
DEV void run_phase(const Params& p, int l, unsigned char* smem, int wg, int nwg) {
    float* lds = (float*)smem;
    const float* xin = l == 0 ? p.x : p.XF;
    if constexpr (PH == PH_PRO) {
        for (int ll = 0; ll < NL; ++ll) {
            ph_transpose<1>(p.w_in + (size_t)ll * DM * INW, p.WINT + (size_t)ll * PW * DM, INW, PW, lds, wg, nwg);
            ph_transpose<0>(p.w_out + (size_t)ll * DM * DM, p.WOUTT + (size_t)ll * DM * DM, DM, DM, lds, wg, nwg);
            ph_transpose<0>(p.peer_wq + (size_t)ll * DM * DM, p.WQT + (size_t)ll * DM * DM, DM, DM, lds, wg, nwg);
        }
        ph_cvt(p.peer_u, p.UB, (size_t)NL * 16384 * 2048, wg, nwg);
        ph_cvt(p.peer_v, p.VB, (size_t)NL * 16384 * 2048, wg, nwg);
        ph_cvt(p.x, p.XB, (size_t)TT * DM, wg, nwg);
        ph_ropetab(p.ROPE, wg, nwg);
        ph_skt(p.subkeys, p.SKT, wg, nwg);
    }
    else if constexpr (PH == PH_GEMM_IN) ph_gemm_in(p, l, smem, wg, nwg);
    else if constexpr (PH == PH_ROPE) ph_rope(p.P, p.ROPE, wg, nwg);
    else if constexpr (PH == PH_COMPRESS) ph_compress(p, l, lds, wg, nwg);
    else if constexpr (PH == PH_NSA_CMP) ph_nsa_cmp(p, l, lds, wg, nwg);
    else if constexpr (PH == PH_SLC) ph_attn_naive<V_SLC>(p, l, lds, wg, nwg);
    else if constexpr (PH == PH_WIN) ph_attn_naive<V_WIN>(p, l, lds, wg, nwg);
    else if constexpr (PH == PH_DIL) ph_attn_naive<V_DIL>(p, l, lds, wg, nwg);
    else if constexpr (PH == PH_DIFF) ph_attn_naive<V_DIFF>(p, l, lds, wg, nwg);
    else if constexpr (PH == PH_STICK) ph_attn_naive<V_STICK>(p, l, lds, wg, nwg);
    else if constexpr (PH == PH_OCVT) ph_cvt(p.OACC, p.OCAT, (size_t)TT * DM, wg, nwg);
    else if constexpr (PH == PH_GEMM_OUT) ph_gemm_out(p, l, xin, smem, wg, nwg);
    else if constexpr (PH == PH_LN1) ph_ln(p.Y, p.ln1_g + (size_t)l * DM, p.ln1_b + (size_t)l * DM, p.XF, p.XB, wg, nwg);
    else if constexpr (PH == PH_GEMM_Q) ph_gemm_q(p, l, smem, wg, nwg);
    else if constexpr (PH == PH_PSEL) ph_peer_select(p, l, lds, wg, nwg);
    else if constexpr (PH == PH_PAPPLY) ph_peer_apply(p, l, p.XF, wg, nwg);
    else if constexpr (PH == PH_LN2) ph_ln(p.Y, p.ln2_g + (size_t)l * DM, p.ln2_b + (size_t)l * DM, l == NL - 1 ? p.out : p.XF, l == NL - 1 ? nullptr : p.XB, wg, nwg);
}

constexpr int LDS_BYTES = 132 * 1024;

template <int PH> __global__ __launch_bounds__(512, 2) void k_ph(Params p, int l) {
    extern __shared__ __attribute__((aligned(16))) unsigned char smem[];
    run_phase<PH>(p, l, smem, (int)blockIdx.x, (int)gridDim.x);
}

template <int PH> static void launch_ph(const Params& p, int l, hipStream_t st) {
    static bool attr = false;
    if (!attr) { hipFuncSetAttribute((const void*)k_ph<PH>, hipFuncAttributeMaxDynamicSharedMemorySize, LDS_BYTES); attr = true; }
    k_ph<PH><<<dim3(256), dim3(512), LDS_BYTES, st>>>(p, l);
}

static size_t carve(size_t& off, size_t bytes) { const size_t o = off; off = (off + bytes + 255) & ~(size_t)255; return o; }

extern "C" void kernel_launch(void* const* d_in, const int* in_sizes, int n_in, void* d_out, int out_size, void* d_ws, size_t ws_size, hipStream_t stream) {
    (void)in_sizes; (void)n_in; (void)out_size; (void)ws_size;
    Params p{};
    p.x = (const float*)d_in[0]; p.w_in = (const float*)d_in[1]; p.w_out = (const float*)d_in[2]; p.cmp_pe = (const float*)d_in[3]; p.cmp_w1 = (const float*)d_in[4];
    p.cmp_w2 = (const float*)d_in[5]; p.diff_lambda = (const float*)d_in[6]; p.diff_g = (const float*)d_in[7]; p.ln1_g = (const float*)d_in[8]; p.ln1_b = (const float*)d_in[9];
    p.peer_wq = (const float*)d_in[10]; p.subkeys = (const float*)d_in[11]; p.peer_u = (const float*)d_in[12]; p.peer_v = (const float*)d_in[13]; p.ln2_g = (const float*)d_in[14]; p.ln2_b = (const float*)d_in[15];
    p.out = (float*)d_out;
    char* ws = (char*)d_ws; size_t off = 0;
    p.bar = (unsigned*)(ws + carve(off, 65536));
    p.XF = (float*)(ws + carve(off, (size_t)TT * DM * 4)); p.Y = (float*)(ws + carve(off, (size_t)TT * DM * 4));
    p.Q2 = (float*)(ws + carve(off, (size_t)TT * DM * 4)); p.OACC = (float*)(ws + carve(off, (size_t)TT * DM * 4));
    p.KC = (float*)(ws + carve(off, (size_t)NB * 256 * 128 * 4)); p.VC = (float*)(ws + carve(off, (size_t)NB * 256 * 128 * 4));
    p.ROPE = (float*)(ws + carve(off, (size_t)SEQ * 48 * 4)); p.SKT = (float*)(ws + carve(off, (size_t)NL * 16 * 16384 * 4));
    p.GATE = (float*)(ws + carve(off, (size_t)TT * 128 * 4)); p.EIDX = (int*)(ws + carve(off, (size_t)TT * 128 * 4)); p.SEL = (u64*)(ws + carve(off, (size_t)TT * 8));
    p.XB = (bf16_t*)(ws + carve(off, (size_t)TT * DM * 2)); p.OCAT = (bf16_t*)(ws + carve(off, (size_t)TT * DM * 2)); p.P = (bf16_t*)(ws + carve(off, (size_t)TT * PW * 2));
    p.WINT = (bf16_t*)(ws + carve(off, (size_t)NL * PW * DM * 2)); p.WOUTT = (bf16_t*)(ws + carve(off, (size_t)NL * DM * DM * 2)); p.WQT = (bf16_t*)(ws + carve(off, (size_t)NL * DM * DM * 2));
    p.UB = (bf16_t*)(ws + carve(off, (size_t)NL * 16384 * 2048 * 2)); p.VB = (bf16_t*)(ws + carve(off, (size_t)NL * 16384 * 2048 * 2));
    launch_ph<PH_PRO>(p, 0, stream);
    for (int l = 0; l < NL; ++l) {
        launch_ph<PH_GEMM_IN>(p, l, stream); launch_ph<PH_ROPE>(p, l, stream); launch_ph<PH_COMPRESS>(p, l, stream); launch_ph<PH_NSA_CMP>(p, l, stream);
        launch_ph<PH_SLC>(p, l, stream); launch_ph<PH_WIN>(p, l, stream); launch_ph<PH_DIL>(p, l, stream); launch_ph<PH_DIFF>(p, l, stream); launch_ph<PH_STICK>(p, l, stream);
        launch_ph<PH_OCVT>(p, l, stream); launch_ph<PH_GEMM_OUT>(p, l, stream); launch_ph<PH_LN1>(p, l, stream); launch_ph<PH_GEMM_Q>(p, l, stream);
        launch_ph<PH_PSEL>(p, l, stream); launch_ph<PH_PAPPLY>(p, l, stream); launch_ph<PH_LN2>(p, l, stream);
    }
}
```

```cpp
#include <hip/hip_runtime.h>
#include <stdint.h>
#include <stdio.h>

typedef unsigned short bf16_t;
typedef unsigned long long u64;
#define DEV __device__ __forceinline__

constexpr int NB = 2, SEQ = 4096, TT = NB * SEQ, DM = 2048, PW = 6144, NL = 4, INW = 5900;
constexpr int C_AQ = 0, C_AKC = 512, C_AVC = 640, C_AKS = 768, C_AVS = 896, C_AKW = 1024, C_AVW = 1152,
              C_BQ = 1280, C_BK = 1792, C_BV = 2304, C_CQ = 2816, C_CK = 3328, C_CV = 3840,
              C_DQ = 4352, C_DK = 4864, C_DV = 5376, C_AG = 5888;
constexpr float ALPHA = 1.681792830507429f;
constexpr int LDS_BYTES = 158 * 1024, LDS_FLAGS_OFF = LDS_BYTES - 256, LDS_SLOT_OFF = LDS_BYTES - 64;
constexpr float NEG_INF = -__builtin_inff();

struct Params {
    const float *x, *w_in, *w_out, *cmp_pe, *cmp_w1, *cmp_w2, *diff_lambda, *diff_g, *ln1_g, *ln1_b,
                *peer_wq, *subkeys, *peer_u, *peer_v, *ln2_g, *ln2_b;
    float* out;
    unsigned* bar;
    float *XF, *Y, *Q2, *OACC, *KC, *VC, *ROPE, *SKT, *GATE;
    bf16_t *XB, *P, *OCAT, *WINT, *WOUTT, *WQT, *UB, *VB;
    int* EIDX;
    u64* SEL;
    u64* LNX;
    bf16_t *KCB, *VCB;
    float *DILO, *DILL, *DIFO;
    unsigned char *U8, *V8;
    unsigned* WPK;
    bf16_t *W1T, *W2T;
    float* CB;
    float* NSAO;
};

DEV float bf2f(bf16_t b) { return __uint_as_float(((unsigned)b) << 16); }
DEV float bflo(unsigned w) { return __uint_as_float(w << 16); }
DEV float bfhi(unsigned w) { return __uint_as_float(w & 0xffff0000u); }
DEV bf16_t f2bf(float f) { unsigned u = __float_as_uint(f); u += 0x7FFFu + ((u >> 16) & 1u); return (bf16_t)(u >> 16); }
DEV unsigned pack2(float a, float b) { unsigned r; asm("v_cvt_pk_bf16_f32 %0, %1, %2" : "=v"(r) : "v"(a), "v"(b)); return r; }
DEV float wave_sum(float v) {
#pragma unroll
    for (int o = 32; o > 0; o >>= 1) v += __shfl_xor(v, o);
    return v;
}
DEV float wave_max(float v) {
#pragma unroll
    for (int o = 32; o > 0; o >>= 1) v = fmaxf(v, __shfl_xor(v, o));
    return v;
}
DEV float gelu_tanh(float x) {
    const float u = 0.7978845608028654f * (x + 0.044715f * x * x * x);
    const float t = 1.f - 2.f / (__expf(2.f * u) + 1.f);
    return 0.5f * x * (1.f + t);
}
DEV float sigmoidf_(float x) { return 1.f / (1.f + __expf(-x)); }
DEV int srccol_in(int np) { return np < 1280 ? np : (np < 5888 ? np + 12 : (np < 5900 ? 1280 + (np - 5888) : -1)); }

DEV int tid_opq() { int t = (int)threadIdx.x; asm volatile("" : "+v"(t)); return t; }

namespace pg8 {
#define PG8_LAS __attribute__((address_space(3)))
typedef unsigned short bf16_t;
typedef short bf16x8 __attribute__((ext_vector_type(8)));
typedef float f32x4 __attribute__((ext_vector_type(4)));
typedef unsigned u32x4 __attribute__((ext_vector_type(4)));
constexpr int BM = 256, BK = 64, HALF = 128, HTB = HALF * BK * 2  , STAGE_BYTES = 8 * HTB, NXCD = 8, WGM = 8;

__host__ __device__ __forceinline__ int lds_byte(int r, int c) { const int st = (r >> 4) * 2 + (c >> 5), rr = r & 15, cc = c & 31, ob = rr * 64 + cc * 2; return st * 1024 + (ob ^ (((ob >> 9) & 1) << 5)); }
__host__ __device__ __forceinline__ void stage_rc(int b, int& R, int& C) { const int st = b / 1024, sb = b % 1024, swz = sb ^ (((sb >> 9) & 1) << 5); R = (st >> 1) * 16 + swz / 64; C = (st & 1) * 32 + (swz % 64) / 2; }
__host__ __device__ __forceinline__ int perm32(int rho) { const int n = rho >> 4, i = rho & 15; return 8 * (i >> 2) + 4 * n + (i & 3); }

struct Unit { int pm, pn; };
struct Gemm { const bf16_t* A; const bf16_t* Bt; int M, N, K; };

struct StaticOrder {
    int nM, nN, nwg, G, c;
    __host__ __device__ void init(int M, int N, int G_, int c_) { nM = M / BM; nN = N / BM; nwg = nM * nN; G = G_; c = c_; }
    __host__ __device__ bool next(int i, Unit& u) const {
        const long L = (long)i * G + c; if (L >= nwg) return false;
        int wgid = (int)L; { const int q = nwg / NXCD, r = nwg % NXCD, xcd = wgid % NXCD, off = wgid / NXCD; wgid = (xcd < r ? xcd * (q + 1) : r * (q + 1) + (xcd - r) * q) + off; }
        const int nig = WGM * nN, gid = wgid / nig, fm = gid * WGM, gsz = (nM - fm) < WGM ? (nM - fm) : WGM;
        u.pm = fm + ((wgid % nig) % gsz); u.pn = (wgid % nig) / gsz; return true;
    }
    __device__ __forceinline__ void a_ready(const Unit&) const {}
    __device__ __forceinline__ void done(const Unit&) const {}
};
__device__ __forceinline__ unsigned cvt_pk_bf16(float lo, float hi) { unsigned r; asm volatile("v_cvt_pk_bf16_f32 %0, %1, %2" : "=v"(r) : "v"(lo), "v"(hi)); return r; }
typedef float f32x2 __attribute__((ext_vector_type(2)));
__device__ __forceinline__ f32x2 gelu_pk(f32x2 v) {
    const f32x2 av = __builtin_elementwise_abs(v), d = av * 0.2316418882f + 1.0f;
    f32x2 t; t.x = __builtin_amdgcn_rcpf(d.x); t.y = __builtin_amdgcn_rcpf(d.y);
    f32x2 q = t * 0.5307027145f + (-0.7265760135f); q = q * t + 0.7107068705f; q = q * t + (-0.142248368f); q = q * t + 0.127414796f; q = q * t;
    const f32x2 s = (v * v) * (-0.72134752044f);
    f32x2 e; e.x = __builtin_amdgcn_exp2f(s.x); e.y = __builtin_amdgcn_exp2f(s.y);
    const f32x2 m = v * (q * e), r = v - m;
    f32x2 o; o.x = v.x < 0.f ? m.x : r.x; o.y = v.y < 0.f ? m.y : r.y; return o;
}

struct EpiF32 {
    static constexpr bool PERM = false, AFTER_DRAIN = false;
    float* C; int ldc; const float* bias;
    __device__ __forceinline__ void operator()(const f32x4 (&acc)[2][2][4][2], const Unit& u, int wr, int wc, int fr, int fq) const {
        const int row0 = u.pm * BM + wr * 64 + fr, col0 = u.pn * BM + wc * 32 + 4 * fq;
        f32x4 bv[2][2];
#pragma unroll
        for (int bj = 0; bj < 2; ++bj)
#pragma unroll
            for (int n = 0; n < 2; ++n) bv[bj][n] = bias ? *(const f32x4*)(bias + col0 + bj * HALF + n * 16) : (f32x4){0.f, 0.f, 0.f, 0.f};
#pragma unroll
        for (int ai = 0; ai < 2; ++ai)
#pragma unroll
            for (int m = 0; m < 4; ++m) { float* rowp = C + (size_t)(row0 + ai * HALF + m * 16) * ldc + col0;
#pragma unroll
                for (int bj = 0; bj < 2; ++bj)
#pragma unroll
                    for (int n = 0; n < 2; ++n) *(f32x4*)(rowp + bj * HALF + n * 16) = acc[ai][bj][m][n] + bv[bj][n]; }
    }
};
template <int ACT  > struct EpiBf16 {
    static constexpr bool PERM = true, AFTER_DRAIN = false;
    bf16_t* O; int ldc; const float* bias; int split_cols; size_t split_stride;
    __device__ __forceinline__ void operator()(const f32x4 (&acc)[2][2][4][2], const Unit& u, int wr, int wc, int fr, int fq) const {
        const int row0 = u.pm * BM + wr * 64 + fr; int colt = u.pn * BM; bf16_t* base = O;
        if (split_cols) { const int t = colt / split_cols; base += (size_t)t * split_stride; colt -= t * split_cols; }
        const int col0 = colt + wc * 32 + 8 * fq, bcol0 = u.pn * BM + wc * 32 + 8 * fq;
        f32x4 bv[2][2];
#pragma unroll
        for (int bj = 0; bj < 2; ++bj)
#pragma unroll
            for (int n = 0; n < 2; ++n) bv[bj][n] = bias ? *(const f32x4*)(bias + bcol0 + bj * HALF + 4 * n) : (f32x4){0.f, 0.f, 0.f, 0.f};
#pragma unroll
        for (int ai = 0; ai < 2; ++ai)
#pragma unroll
            for (int m = 0; m < 4; ++m) { bf16_t* rowp = base + (size_t)(row0 + ai * HALF + m * 16) * ldc + col0;
#pragma unroll
                for (int bj = 0; bj < 2; ++bj) { f32x4 v0 = acc[ai][bj][m][0] + bv[bj][0], v1 = acc[ai][bj][m][1] + bv[bj][1];
                    if (ACT == 1) { f32x2 a = gelu_pk((f32x2){v0[0], v0[1]}), b = gelu_pk((f32x2){v0[2], v0[3]}), c = gelu_pk((f32x2){v1[0], v1[1]}), d = gelu_pk((f32x2){v1[2], v1[3]});
                        v0 = (f32x4){a.x, a.y, b.x, b.y}; v1 = (f32x4){c.x, c.y, d.x, d.y}; }
                    if (ACT == 2) {
#pragma unroll
                        for (int j = 0; j < 4; ++j) { v0[j] = 0.5f * v0[j] * (1.0f + erff(v0[j] * 0.70710678f)); v1[j] = 0.5f * v1[j] * (1.0f + erff(v1[j] * 0.70710678f)); } }
                    u32x4 w; w.x = cvt_pk_bf16(v0[0], v0[1]); w.y = cvt_pk_bf16(v0[2], v0[3]); w.z = cvt_pk_bf16(v1[0], v1[1]); w.w = cvt_pk_bf16(v1[2], v1[3]);
                    *(u32x4*)(rowp + bj * HALF) = w; } }
    }
};
template <class Epi, class Sched, bool STAMP = false>
__device__ __forceinline__ void gemm_phase(PG8_LAS unsigned char* lds, const Gemm g, const Sched& S, const Epi& E, unsigned long long* stamps) {
    const int tid = tid_opq(), wid = __builtin_amdgcn_readfirstlane(tid >> 6), lane = tid & 63, wr = wid >> 2, wc = wid & 3, fr = lane & 15, fq = lane >> 4;
    const int K = g.K, nt = K / BK;
    int ts_lo = 0, ts_hi = 0, nts = 0; const unsigned long long rt_entry = STAMP ? (unsigned long long)wall_clock64() : 0ull;
#define PG8_STAMP() do { if (STAMP && wid == 0 && nts < 64) { const unsigned long long _c = (unsigned long long)clock64(); \
        ts_lo = (lane == nts) ? (int)(unsigned)_c : ts_lo; ts_hi = (lane == nts) ? (int)(unsigned)(_c >> 32) : ts_hi; ++nts; } } while (0)
    PG8_STAMP();
    unsigned voffA[2], voffB[2];
#pragma unroll
    for (int i = 0; i < 2; ++i) { int R, C; stage_rc(tid * 16 + i * 8192, R, C); const int Rb = Epi::PERM ? ((R & ~31) + perm32(R & 31)) : R;
        voffA[i] = (unsigned)(R * K + C) * 2u; voffB[i] = (unsigned)(Rb * K + C) * 2u; }
    const size_t kstep = (size_t)(BK * 2);
    const size_t hstep = (size_t)HALF * K * 2;
    const size_t tstep = 2 * hstep;
    const unsigned ldsw = (unsigned)wid * 1024u;
    const int aoff = lds_byte(wr * 64 + fr, fq * 8), boff = lds_byte(wc * 32 + fr, fq * 8);
#define PG8_SA(b, h) (((b) * 2 + (h)) * HTB)
#define PG8_SB(b, h) ((4 + (b) * 2 + (h)) * HTB)
#define PG8_STAGE(bufoff, gbase, voff) do { _Pragma("unroll") for (int _i = 0; _i < 2; ++_i) \
        __builtin_amdgcn_global_load_lds((const unsigned*)((const char*)(gbase) + (voff)[_i]), (PG8_LAS unsigned*)(lds + (bufoff) + ldsw + _i * 8192), 16, 0, 0); } while (0)
#define PG8_LDA(dst, b, h) do { _Pragma("unroll") for (int m = 0; m < 4; ++m) _Pragma("unroll") for (int k = 0; k < 2; ++k) dst[m][k] = *(const PG8_LAS bf16x8*)(lds + PG8_SA(b, h) + aoff + m * 2048 + k * 1024); } while (0)
#define PG8_LDB(dst, b, h) do { _Pragma("unroll") for (int n = 0; n < 2; ++n) _Pragma("unroll") for (int k = 0; k < 2; ++k) dst[n][k] = *(const PG8_LAS bf16x8*)(lds + PG8_SB(b, h) + boff + n * 2048 + k * 1024); } while (0)
#define PG8_MMA(ai, bj, At, Bt) do { __builtin_amdgcn_s_setprio(1); _Pragma("unroll") for (int m = 0; m < 4; ++m) _Pragma("unroll") for (int n = 0; n < 2; ++n) _Pragma("unroll") for (int k = 0; k < 2; ++k) \
        acc[ai][bj][m][n] = __builtin_amdgcn_mfma_f32_16x16x32_bf16(Bt[n][k], At[m][k], acc[ai][bj][m][n], 0, 0, 0); __builtin_amdgcn_s_setprio(0); } while (0)
#define PG8_WAIT_V(n) asm volatile("s_waitcnt vmcnt(" #n ")" ::: "memory")
#define PG8_WAIT_L(n) asm volatile("s_waitcnt lgkmcnt(" #n ")" ::: "memory")
#define PG8_BAR __builtin_amdgcn_s_barrier()
#define PG8_SCHED __builtin_amdgcn_sched_barrier(0)
    Unit cur, nxt; int ui = 0;
    if (!S.next(0, cur)) return;
    f32x4 acc[2][2][4][2];
#pragma unroll
    for (int a = 0; a < 2; ++a)
#pragma unroll
        for (int b = 0; b < 2; ++b)
#pragma unroll
            for (int m = 0; m < 4; ++m)
#pragma unroll
                for (int n = 0; n < 2; ++n) acc[a][b][m][n] = (f32x4){0.f, 0.f, 0.f, 0.f};
    bf16x8 At[4][2], B0[2][2], B1[2][2];
    const char* cA = (const char*)g.A + (size_t)cur.pm * tstep; const char* cB = (const char*)g.Bt + (size_t)cur.pn * tstep;
    S.a_ready(cur);
    PG8_STAGE(PG8_SB(0, 0), cB, voffB); PG8_STAGE(PG8_SA(0, 0), cA, voffA); PG8_STAGE(PG8_SB(0, 1), cB + hstep, voffB); PG8_STAGE(PG8_SA(0, 1), cA + hstep, voffA);
    if (wr == 1) PG8_BAR;
    PG8_WAIT_V(4); PG8_BAR;
    PG8_STAGE(PG8_SB(1, 0), cB + kstep, voffB); PG8_STAGE(PG8_SA(1, 0), cA + kstep, voffA); PG8_STAGE(PG8_SB(1, 1), cB + hstep + kstep, voffB);
    PG8_WAIT_V(6); PG8_BAR;
    PG8_STAMP();
    for (;;) {
        const bool has_next = S.next(ui + 1, nxt);
        const char* nA = has_next ? (const char*)g.A + (size_t)nxt.pm * tstep : cA; const char* nB = has_next ? (const char*)g.Bt + (size_t)nxt.pn * tstep : cB;
        for (int t = 0; t < nt; t += 2) {
            const bool last = (t == nt - 2);
            const char* a1 = cA + (size_t)(t + 1) * kstep;
            const char* a2 = last ? nA : cA + (size_t)(t + 2) * kstep; const char* b2 = last ? nB : cB + (size_t)(t + 2) * kstep;
            const char* a3 = a2 + kstep; const char* b3 = b2 + kstep;
            if (last && has_next) S.a_ready(nxt);
            PG8_LDB(B0, 0, 0); PG8_SCHED; PG8_LDA(At, 0, 0); PG8_STAGE(PG8_SA(1, 1), a1 + hstep, voffA);
            PG8_WAIT_L(8); PG8_BAR; PG8_WAIT_L(0); PG8_MMA(0, 0, At, B0); PG8_BAR; PG8_SCHED;
            PG8_LDB(B1, 0, 1); PG8_STAGE(PG8_SB(0, 0), b2, voffB);
            PG8_BAR; PG8_WAIT_L(0); PG8_MMA(0, 1, At, B1); PG8_BAR;
            PG8_LDA(At, 0, 1); PG8_STAGE(PG8_SA(0, 0), a2, voffA);
            PG8_BAR; PG8_WAIT_L(0); PG8_MMA(1, 0, At, B0); PG8_BAR; PG8_SCHED;
            PG8_STAGE(PG8_SB(0, 1), b2 + hstep, voffB);
            PG8_WAIT_V(6); PG8_BAR; PG8_MMA(1, 1, At, B1); PG8_BAR;
            PG8_LDB(B0, 1, 0); PG8_SCHED; PG8_LDA(At, 1, 0); PG8_STAGE(PG8_SA(0, 1), a2 + hstep, voffA);
            PG8_WAIT_L(8); PG8_BAR; PG8_WAIT_L(0); PG8_MMA(0, 0, At, B0); PG8_BAR; PG8_SCHED;
            PG8_LDB(B1, 1, 1); PG8_STAGE(PG8_SB(1, 0), b3, voffB);
            PG8_BAR; PG8_WAIT_L(0); PG8_MMA(0, 1, At, B1); PG8_BAR;
            PG8_LDA(At, 1, 1); PG8_STAGE(PG8_SA(1, 0), a3, voffA);
            PG8_BAR; PG8_WAIT_L(0); PG8_MMA(1, 0, At, B0); PG8_BAR; PG8_SCHED;
            PG8_STAGE(PG8_SB(1, 1), b3 + hstep, voffB);
            PG8_WAIT_V(6); PG8_BAR; PG8_MMA(1, 1, At, B1); PG8_BAR;
        }
        PG8_STAMP();
        if constexpr (!Epi::AFTER_DRAIN) { E(acc, cur, wr, wc, fr, fq); S.done(cur); }
        PG8_STAMP();
        if (!has_next) break;
#pragma unroll
        for (int a = 0; a < 2; ++a)
#pragma unroll
            for (int b = 0; b < 2; ++b)
#pragma unroll
                for (int m = 0; m < 4; ++m)
#pragma unroll
                    for (int n = 0; n < 2; ++n) acc[a][b][m][n] = (f32x4){0.f, 0.f, 0.f, 0.f};
        cur = nxt; cA = nA; cB = nB; ++ui;
    }
    PG8_WAIT_V(0);
    if (wr == 0) PG8_BAR;
    PG8_BAR;
    if constexpr (Epi::AFTER_DRAIN) { E.fused(acc, cur, wr, wc, fr, fq, lds, wid, lane); S.done(cur); }
    PG8_STAMP();
    if (STAMP && wid == 0) { stamps[lane] = lane < nts ? (((unsigned long long)(unsigned)ts_hi << 32) | (unsigned)ts_lo) : 0ull;
        if (lane == 62) stamps[62] = rt_entry; if (lane == 63) stamps[63] = (unsigned long long)wall_clock64(); }
#undef PG8_STAMP
#undef PG8_SA
#undef PG8_SB
#undef PG8_STAGE
#undef PG8_LDA
#undef PG8_LDB
#undef PG8_MMA
#undef PG8_WAIT_V
#undef PG8_WAIT_L
#undef PG8_BAR
#undef PG8_SCHED
}
}
#define XB_TMO      128
#define XB_XCNT(j)  (256  + 64 * (j))
#define XB_XSUB(j)  (1280 + 64 * (j))
#define XB_XGEN(j)  (2304 + 64 * (j))
#define XB_TOP      3328
#define XB_TOPGEN   3392
#define XCD_BAR_WORDS 3456
#define XB_SPIN_CAP (1u << 18)
#define LAS __attribute__((address_space(3)))

__device__ __forceinline__ unsigned xb_ld(unsigned* p)              { return __hip_atomic_load(p, __ATOMIC_RELAXED, __HIP_MEMORY_SCOPE_AGENT); }
__device__ __forceinline__ unsigned xb_add(unsigned* p, unsigned v) { return __hip_atomic_fetch_add(p, v, __ATOMIC_RELAXED, __HIP_MEMORY_SCOPE_AGENT); }
__device__ __forceinline__ unsigned xb_xcc_id() { return (unsigned)__builtin_amdgcn_s_getreg((3 << 11) | 20) & 0xFu; }
#define XB_SPIN(cond, bar) do { unsigned _sp = 0; while (cond) { __builtin_amdgcn_s_sleep(1); \
    if ((++_sp & 255u) == 0u) { if (xb_ld(&(bar)[XB_TMO])) break; if (_sp > XB_SPIN_CAP) { atomicAdd(&(bar)[XB_TMO], 1u); break; } } } } while (0)

struct XcdBarrier {
    unsigned* bar; unsigned x;
    volatile LAS unsigned* st;
};

__device__ __forceinline__ XcdBarrier xcd_barrier_post(unsigned* bar, volatile LAS unsigned* st) {
    XcdBarrier b; b.bar = bar; b.x = xb_xcc_id(); b.st = st;
    if (threadIdx.x == 0) (void)xb_add(&bar[XB_XCNT(b.x)], 1u);
    return b;
}
__device__ __forceinline__ void xcd_barrier_complete(unsigned* bar, unsigned x, unsigned& nloc, unsigned& nx) {
    const unsigned G = gridDim.x * gridDim.y * gridDim.z;
    unsigned sum, cnt, mine, sp = 0u;
    for (;;) {
        sum = 0u; cnt = 0u; mine = 0u;
#pragma unroll
        for (unsigned j = 0; j < 16; ++j) { const unsigned c = xb_ld(&bar[XB_XCNT(j)]); sum += c; cnt += (c > 0u) ? 1u : 0u; mine = (j == x) ? c : mine; }
        if (sum == G) break;
        __builtin_amdgcn_s_sleep(1);
        if ((++sp & 255u) == 0u) { if (xb_ld(&bar[XB_TMO])) break; if (sp > XB_SPIN_CAP) { atomicAdd(&bar[XB_TMO], 1u); break; } }
    }
    nloc = mine > 0u ? mine : 1u; nx = cnt > 0u ? cnt : 1u;
}

__device__ __forceinline__ void xcd_barrier(const XcdBarrier& b) {
    asm volatile("s_waitcnt vmcnt(0)" ::: "memory");
    __syncthreads();
    if (threadIdx.x == 0) {
        unsigned* bar = b.bar;
        __builtin_amdgcn_s_waitcnt(0);
        unsigned nloc = b.st[0], nx = b.st[1];
        if (nloc == 0u) { xcd_barrier_complete(bar, b.x, nloc, nx); b.st[0] = nloc; b.st[1] = nx; }
        const unsigned old = xb_add(&bar[XB_XSUB(b.x)], 1u);
        const unsigned gen = old / nloc;
        if (old + 1u == (gen + 1u) * nloc) {
            __builtin_amdgcn_fence(__ATOMIC_RELEASE, "agent");
            asm volatile("s_waitcnt vmcnt(0)" ::: "memory");
            const unsigned og = xb_add(&bar[XB_TOP], 1u);
            const unsigned tg = og / nx;
            if (og + 1u == (tg + 1u) * nx) xb_add(&bar[XB_TOPGEN], 1u);
            else XB_SPIN(xb_ld(&bar[XB_TOPGEN]) == tg, bar);
            __builtin_amdgcn_fence(__ATOMIC_ACQUIRE, "agent");
            xb_add(&bar[XB_XGEN(b.x)], 1u);
            asm volatile("s_waitcnt vmcnt(0)" ::: "memory");
        } else {
            XB_SPIN(xb_ld(&bar[XB_XGEN(b.x)]) == gen, bar);
            __builtin_amdgcn_fence(__ATOMIC_ACQUIRE, "agent");
            asm volatile("s_waitcnt vmcnt(0)" ::: "memory");
        }
    }
    __syncthreads();
}


template <int MODE, int KD = 2048>
DEV void ph_transpose(const float* __restrict__ src, bf16_t* __restrict__ dst, int N, int NP, float* lds, int wg, int nwg) {
    const int tid = tid_opq();
    const int ntk = KD / 64, ntiles = (NP / 64) * ntk;
    for (int tile = wg; tile < ntiles; tile += nwg) {
        const int n0 = (tile / ntk) * 64, k0 = (tile % ntk) * 64;
        __syncthreads();
        {
            const int nl = tid & 63, np = n0 + nl;
            const int sc = MODE == 1 ? srccol_in(np) : (np < N ? np : -1);
#pragma unroll
            for (int i = 0; i < 8; ++i) { const int kl = (tid >> 6) + 8 * i; lds[kl * 65 + nl] = sc >= 0 ? src[(size_t)(k0 + kl) * N + sc] : 0.f; }
        }
        __syncthreads();
        {
            const int kl = 2 * (tid & 31);
#pragma unroll
            for (int i = 0; i < 4; ++i) { const int nl = (tid >> 5) + 16 * i;
                *(unsigned*)(dst + (size_t)(n0 + nl) * KD + k0 + kl) = pack2(lds[kl * 65 + nl], lds[(kl + 1) * 65 + nl]); }
        }
    }
}
DEV void ph_cvt(const float* __restrict__ src, bf16_t* __restrict__ dst, size_t n, int wg, int nwg) {
    const size_t n4 = n / 4;
    const int tid = tid_opq(), lane = tid & 63, gw = wg * 8 + (tid >> 6), nw = nwg * 8;
    for (size_t b = (size_t)gw * 128; b < n4; b += (size_t)nw * 128) {
        const float4 a = ((const float4*)src)[b + lane], c = ((const float4*)src)[b + 64 + lane];
        uint2 w0, w1; w0.x = pack2(a.x, a.y); w0.y = pack2(a.z, a.w); w1.x = pack2(c.x, c.y); w1.y = pack2(c.z, c.w);
        ((uint2*)dst)[b + lane] = w0; ((uint2*)dst)[b + 64 + lane] = w1;
    }
}
DEV void ph_ropetab(float* ROPE, int wg, int nwg) {
    for (int i = wg * 512 + tid_opq(); i < SEQ * 24; i += nwg * 512) {
        const int pos = i / 24, j = i % 24;
        const float ex = j < 16 ? (float)j / 16.f : (float)(j - 16) / 8.f;
        const float inv = exp2f(-ex * 18.931568569324174f);
        const float ang = (float)pos * inv;
        const double a = (double)ang, k = rint(a * 0.15915494309189535), r = a - k * 6.283185307179586;
        const float rf = (float)r;
        const float s = sinf(rf), c = cosf(rf);
        const int co = j < 16 ? j : 32 + (j - 16), so = j < 16 ? 16 + j : 40 + (j - 16);
        ROPE[pos * 48 + co] = c; ROPE[pos * 48 + so] = s;
    }
}
DEV void ph_skt(const float* __restrict__ sk, float* __restrict__ skt, int wg, int nwg) {
    for (size_t i = (size_t)wg * 512 + tid_opq(); i < (size_t)NL * 16 * 16384; i += (size_t)nwg * 512) {
        const size_t m = i >> 14; const int r = (int)(i & 16383), c = r >> 7, n = r & 127;
        skt[i] = sk[(m << 14) + (size_t)n * 128 + c];
    }
}

DEV void ph_ln_bf(const bf16_t* __restrict__ Y, const float* __restrict__ g, const float* __restrict__ bt, float* XFo, bf16_t* XBo, int wg, int nwg) {
    const int wave = tid_opq() >> 6, lane = tid_opq() & 63, stride = nwg * 8;
    for (int row0 = wg * 8 + wave; row0 < TT; row0 += 4 * stride) {
        uint4 w[4][4]; float mu[4], rstd[4];
#pragma unroll
        for (int k = 0; k < 4; ++k) { const int row = row0 + k * stride < TT ? row0 + k * stride : row0;
#pragma unroll
            for (int i = 0; i < 4; ++i) w[k][i] = *(const uint4*)(Y + (size_t)row * DM + i * 512 + lane * 8); }
#pragma unroll
        for (int k = 0; k < 4; ++k) { float s = 0.f;
#pragma unroll
            for (int i = 0; i < 4; ++i) s += ((bflo(w[k][i].x) + bfhi(w[k][i].x)) + (bflo(w[k][i].y) + bfhi(w[k][i].y))) + ((bflo(w[k][i].z) + bfhi(w[k][i].z)) + (bflo(w[k][i].w) + bfhi(w[k][i].w)));
            s = wave_sum(s); const float m = s * (1.f / 2048.f); float q = 0.f;
#pragma unroll
            for (int i = 0; i < 4; ++i) { const unsigned u[4] = {w[k][i].x, w[k][i].y, w[k][i].z, w[k][i].w};
#pragma unroll
                for (int j = 0; j < 4; ++j) { const float a = bflo(u[j]) - m, b = bfhi(u[j]) - m; q += a * a + b * b; } }
            q = wave_sum(q); mu[k] = m; rstd[k] = rsqrtf(q * (1.f / 2048.f) + 1e-5f); }
#pragma unroll
        for (int i = 0; i < 4; ++i) {
            const float4 g0 = *(const float4*)(g + i * 512 + lane * 8), g1 = *(const float4*)(g + i * 512 + lane * 8 + 4), b0 = *(const float4*)(bt + i * 512 + lane * 8), b1 = *(const float4*)(bt + i * 512 + lane * 8 + 4);
#pragma unroll
            for (int k = 0; k < 4; ++k) { const int row = row0 + k * stride; if (row >= TT) continue;
                const float m = mu[k], r = rstd[k]; const uint4 x = w[k][i];
                float4 o0, o1; o0.x = (bflo(x.x) - m) * r * g0.x + b0.x; o0.y = (bfhi(x.x) - m) * r * g0.y + b0.y; o0.z = (bflo(x.y) - m) * r * g0.z + b0.z; o0.w = (bfhi(x.y) - m) * r * g0.w + b0.w;
                o1.x = (bflo(x.z) - m) * r * g1.x + b1.x; o1.y = (bfhi(x.z) - m) * r * g1.y + b1.y; o1.z = (bflo(x.w) - m) * r * g1.z + b1.z; o1.w = (bfhi(x.w) - m) * r * g1.w + b1.w;
                const size_t off = (size_t)row * DM + i * 512 + lane * 8;
                if (XFo) { *(float4*)(XFo + off) = o0; *(float4*)(XFo + off + 4) = o1; }
                if (XBo) { uint4 y; y.x = pack2(o0.x, o0.y); y.y = pack2(o0.z, o0.w); y.z = pack2(o1.x, o1.y); y.w = pack2(o1.z, o1.w); *(uint4*)(XBo + off) = y; } }
        }
    }
}
template <bool BF16IN>
DEV void ph_ln(const float* __restrict__ Y, const float* __restrict__ g, const float* __restrict__ bt, float* XFo, bf16_t* XBo, int wg, int nwg) {
    const int wave = tid_opq() >> 6, lane = tid_opq() & 63;
    for (int row = wg * 8 + wave; row < TT; row += nwg * 8) {
        float4 v[8]; float s = 0.f;
        if constexpr (BF16IN) { const uint2* yr = (const uint2*)((const bf16_t*)Y + (size_t)row * DM);
#pragma unroll
            for (int i = 0; i < 8; ++i) { const uint2 w = yr[i * 64 + lane]; v[i] = make_float4(bflo(w.x), bfhi(w.x), bflo(w.y), bfhi(w.y)); s += (v[i].x + v[i].y) + (v[i].z + v[i].w); } }
        else { const float4* yr = (const float4*)(Y + (size_t)row * DM);
#pragma unroll
            for (int i = 0; i < 8; ++i) { v[i] = yr[i * 64 + lane]; s += (v[i].x + v[i].y) + (v[i].z + v[i].w); } }
        s = wave_sum(s); const float mu = s * (1.f / 2048.f);
        float q = 0.f;
#pragma unroll
        for (int i = 0; i < 8; ++i) { const float a = v[i].x - mu, b = v[i].y - mu, c = v[i].z - mu, d = v[i].w - mu; q += (a * a + b * b) + (c * c + d * d); }
        q = wave_sum(q); const float rstd = rsqrtf(q * (1.f / 2048.f) + 1e-5f);
#pragma unroll
        for (int i = 0; i < 8; ++i) {
            const float4 g4 = ((const float4*)g)[i * 64 + lane], b4 = ((const float4*)bt)[i * 64 + lane];
            float4 o; o.x = (v[i].x - mu) * rstd * g4.x + b4.x; o.y = (v[i].y - mu) * rstd * g4.y + b4.y; o.z = (v[i].z - mu) * rstd * g4.z + b4.z; o.w = (v[i].w - mu) * rstd * g4.w + b4.w;
            if (XFo) ((float4*)(XFo + (size_t)row * DM))[i * 64 + lane] = o;
            if (XBo) { uint2 w; w.x = pack2(o.x, o.y); w.y = pack2(o.z, o.w); ((uint2*)(XBo + (size_t)row * DM))[i * 64 + lane] = w; }
        }
    }
}

DEV void ph_rope(bf16_t* P, const float* __restrict__ ROPE, int wg, int nwg) {
    for (size_t i = (size_t)wg * 512 + tid_opq(); i < (size_t)TT * 46; i += (size_t)nwg * 512) {
        const int tok = (int)(i / 46), r = (int)(i % 46), pos = tok & (SEQ - 1);
        int c1, c2, to;
        if (r < 30) { const int hd = r >> 1, j8 = (r & 1) * 8;
            const int base = hd < 4 ? C_AQ + hd * 128 : hd == 4 ? C_AKC : hd == 5 ? C_AKS : hd == 6 ? C_AKW : hd < 11 ? C_BQ + (hd - 7) * 128 : C_BK + (hd - 11) * 128;
            c1 = base + j8; c2 = base + 16 + j8; to = j8; }
        else { const int hd = r - 30; const int base = hd < 8 ? C_CQ + hd * 64 : C_CK + (hd - 8) * 64; c1 = base; c2 = base + 8; to = 32; }
        const float* ct = ROPE + pos * 48 + to; const float* stb = ct + (r < 30 ? 16 : 8);
        const float4 ca = *(const float4*)ct, cb = *(const float4*)(ct + 4), sa = *(const float4*)stb, sb = *(const float4*)(stb + 4);
        bf16_t* row = P + (size_t)tok * PW;
        const uint4 w1 = *(const uint4*)(row + c1), w2 = *(const uint4*)(row + c2);
        const float x1[8] = {bflo(w1.x), bfhi(w1.x), bflo(w1.y), bfhi(w1.y), bflo(w1.z), bfhi(w1.z), bflo(w1.w), bfhi(w1.w)};
        const float x2[8] = {bflo(w2.x), bfhi(w2.x), bflo(w2.y), bfhi(w2.y), bflo(w2.z), bfhi(w2.z), bflo(w2.w), bfhi(w2.w)};
        const float cc[8] = {ca.x, ca.y, ca.z, ca.w, cb.x, cb.y, cb.z, cb.w}, ss[8] = {sa.x, sa.y, sa.z, sa.w, sb.x, sb.y, sb.z, sb.w};
        uint4 o1, o2;
        o1.x = pack2(x1[0] * cc[0] - x2[0] * ss[0], x1[1] * cc[1] - x2[1] * ss[1]); o1.y = pack2(x1[2] * cc[2] - x2[2] * ss[2], x1[3] * cc[3] - x2[3] * ss[3]);
        o1.z = pack2(x1[4] * cc[4] - x2[4] * ss[4], x1[5] * cc[5] - x2[5] * ss[5]); o1.w = pack2(x1[6] * cc[6] - x2[6] * ss[6], x1[7] * cc[7] - x2[7] * ss[7]);
        o2.x = pack2(x1[0] * ss[0] + x2[0] * cc[0], x1[1] * ss[1] + x2[1] * cc[1]); o2.y = pack2(x1[2] * ss[2] + x2[2] * cc[2], x1[3] * ss[3] + x2[3] * cc[3]);
        o2.z = pack2(x1[4] * ss[4] + x2[4] * cc[4], x1[5] * ss[5] + x2[5] * cc[5]); o2.w = pack2(x1[6] * ss[6] + x2[6] * cc[6], x1[7] * ss[7] + x2[7] * cc[7]);
        *(uint4*)(row + c1) = o1; *(uint4*)(row + c2) = o2;
    }
}

DEV void ph_compress(const Params& p, int l, float* lds, int wg, int nwg, int only_unit = -1) {
    float* td = lds;
    float* pe = lds + 144 * 128;
    float* hid = pe + 4096;
    const int tid = tid_opq();
    for (int unit = (only_unit >= 0 ? only_unit : wg); unit < (only_unit >= 0 ? only_unit + 1 : 128); unit += nwg) {
        const int kv = unit >> 6, b = (unit >> 5) & 1, grp = unit & 31, c0 = grp * 8, tb0 = c0 * 16;
        const int col = kv ? C_AVC : C_AKC;
        const float* w1 = p.cmp_w1 + ((size_t)l * 2 + kv) * 4096 * 256;
        const float* w2 = p.cmp_w2 + ((size_t)l * 2 + kv) * 256 * 128;
        const float* peg = p.cmp_pe + ((size_t)l * 2 + kv) * 4096;
        __syncthreads();
        for (int i = tid; i < 144 * 16; i += 512) { const int tl = i >> 4, c8 = (i & 15) * 8, tk = tb0 + tl;
            float4 a = {0.f, 0.f, 0.f, 0.f}, bb = a;
            if (tk < SEQ) { const uint4 w = *(const uint4*)(p.P + ((size_t)b * SEQ + tk) * PW + col + c8);
                a = {bflo(w.x), bfhi(w.x), bflo(w.y), bfhi(w.y)}; bb = {bflo(w.z), bfhi(w.z), bflo(w.w), bfhi(w.w)}; }
            *(float4*)(td + tl * 128 + c8) = a; *(float4*)(td + tl * 128 + c8 + 4) = bb; }
        for (int i = tid; i < 4096; i += 512) pe[i] = peg[i];
        __syncthreads();
        {
            const int j = tid & 255, rg = tid >> 8;
            float acc0 = 0.f, acc1 = 0.f, acc2 = 0.f, acc3 = 0.f, bias = 0.f;
            const float* t0 = td + (rg * 4 + 0) * 2048; const float* t1 = td + (rg * 4 + 1) * 2048; const float* t2 = td + (rg * 4 + 2) * 2048; const float* t3 = td + (rg * 4 + 3) * 2048;
            for (int i = 0; i < 4096; i += 4) {
                const float wa = w1[(size_t)(i + 0) * 256 + j], wb = w1[(size_t)(i + 1) * 256 + j], wc = w1[(size_t)(i + 2) * 256 + j], wd = w1[(size_t)(i + 3) * 256 + j];
                const float4 pp = *(const float4*)(pe + i);
                bias += pp.x * wa + pp.y * wb + pp.z * wc + pp.w * wd;
                float4 x = *(const float4*)(t0 + i); acc0 += x.x * wa + x.y * wb + x.z * wc + x.w * wd;
                x = *(const float4*)(t1 + i); acc1 += x.x * wa + x.y * wb + x.z * wc + x.w * wd;
                x = *(const float4*)(t2 + i); acc2 += x.x * wa + x.y * wb + x.z * wc + x.w * wd;
                x = *(const float4*)(t3 + i); acc3 += x.x * wa + x.y * wb + x.z * wc + x.w * wd;
            }
            hid[(rg * 4 + 0) * 256 + j] = gelu_tanh(acc0 + bias); hid[(rg * 4 + 1) * 256 + j] = gelu_tanh(acc1 + bias);
            hid[(rg * 4 + 2) * 256 + j] = gelu_tanh(acc2 + bias); hid[(rg * 4 + 3) * 256 + j] = gelu_tanh(acc3 + bias);
        }
        __syncthreads();
        {
            const int n = tid & 127, r0 = (tid >> 7) * 2;
            float a0 = 0.f, a1 = 0.f;
            for (int j = 0; j < 256; ++j) { const float w = w2[j * 128 + n]; a0 += hid[r0 * 256 + j] * w; a1 += hid[(r0 + 1) * 256 + j] * w; }
            float* dst = (kv ? p.VC : p.KC) + ((size_t)b * 256 + c0) * 128;
            dst[(r0 + 0) * 128 + n] = (c0 + r0 + 0 < 255) ? a0 : 0.f;
            dst[(r0 + 1) * 128 + n] = (c0 + r0 + 1 < 255) ? a1 : 0.f;
            bf16_t* dsb = (kv ? p.VCB : p.KCB) + ((size_t)b * 256 + c0) * 128;
            dsb[(r0 + 0) * 128 + n] = f2bf((c0 + r0 + 0 < 255) ? a0 : 0.f);
            dsb[(r0 + 1) * 128 + n] = f2bf((c0 + r0 + 1 < 255) ? a1 : 0.f);
        }
    }
}

DEV void ph_nsa_cmp(const Params& p, int l, float* lds, int wg, int nwg) {
    float* qs = lds;
    float* sc = lds + 64 * 128;
    float* imp = sc + 64 * 256;
    const int tid = tid_opq(), lane = tid & 63, wave = tid >> 6;
    for (int unit = wg; unit < TT / 16; unit += nwg) {
        const int tok0 = unit * 16, b = tok0 >> 12, pos0 = tok0 & (SEQ - 1);
        __syncthreads();
        { const int row = tid >> 3, ch = (tid & 7) * 16, tl = row >> 2, h = row & 3;
          const bf16_t* src = p.P + (size_t)(tok0 + tl) * PW + C_AQ + h * 128 + ch;
          const uint4 w0 = *(const uint4*)src, w1 = *(const uint4*)(src + 8);
          float* d = qs + row * 128 + ch;
          *(float4*)(d + 0) = {bflo(w0.x), bfhi(w0.x), bflo(w0.y), bfhi(w0.y)}; *(float4*)(d + 4) = {bflo(w0.z), bfhi(w0.z), bflo(w0.w), bfhi(w0.w)};
          *(float4*)(d + 8) = {bflo(w1.x), bfhi(w1.x), bflo(w1.y), bfhi(w1.y)}; *(float4*)(d + 12) = {bflo(w1.z), bfhi(w1.z), bflo(w1.w), bfhi(w1.w)}; }
        __syncthreads();
        {
            const int c = tid & 255, rg = tid >> 8;
            float acc[32];
#pragma unroll
            for (int r = 0; r < 32; ++r) acc[r] = 0.f;
            const float4* kr = (const float4*)(p.KC + ((size_t)b * 256 + c) * 128);
            for (int d4 = 0; d4 < 32; ++d4) { const float4 kv = kr[d4];
#pragma unroll
                for (int r = 0; r < 32; ++r) { const float4 q = *(const float4*)(qs + (rg * 32 + r) * 128 + d4 * 4); acc[r] += q.x * kv.x + q.y * kv.y + q.z * kv.z + q.w * kv.w; } }
#pragma unroll
            for (int r = 0; r < 32; ++r) { const int row = rg * 32 + r, pos = pos0 + (row >> 2);
                sc[row * 256 + c] = (16 * c + 31 <= pos) ? acc[r] * 0.08838834764831845f : NEG_INF; }
        }
        __syncthreads();
        for (int rr = 0; rr < 8; ++rr) {
            float* r = sc + (wave * 8 + rr) * 256;
            float v0 = r[lane], v1 = r[lane + 64], v2 = r[lane + 128], v3 = r[lane + 192];
            float m = wave_max(fmaxf(fmaxf(v0, v1), fmaxf(v2, v3)));
            if (m == NEG_INF) m = 0.f;
            v0 = __expf(v0 - m); v1 = __expf(v1 - m); v2 = __expf(v2 - m); v3 = __expf(v3 - m);
            const float s = wave_sum((v0 + v1) + (v2 + v3)), inv = 1.f / fmaxf(s, 1e-30f);
            r[lane] = v0 * inv; r[lane + 64] = v1 * inv; r[lane + 128] = v2 * inv; r[lane + 192] = v3 * inv;
        }
        __syncthreads();
        {
            const int d = tid & 127, rgp = tid >> 7;
            float acc[16];
#pragma unroll
            for (int r = 0; r < 16; ++r) acc[r] = 0.f;
            const float* vcb = p.VC + (size_t)b * 256 * 128 + d;
            for (int c = 0; c < 256; c += 4) { const float va = vcb[(c + 0) * 128], vb = vcb[(c + 1) * 128], vc = vcb[(c + 2) * 128], vd = vcb[(c + 3) * 128];
#pragma unroll
                for (int r = 0; r < 16; ++r) { const float4 pp = *(const float4*)(sc + (rgp * 16 + r) * 256 + c); acc[r] += pp.x * va + pp.y * vb + pp.z * vc + pp.w * vd; } }
#pragma unroll
            for (int r = 0; r < 16; ++r) { const int row = rgp * 16 + r, tl = row >> 2, h = row & 3; const size_t tok = (size_t)tok0 + tl;
                const float g = sigmoidf_(bf2f(p.P[tok * PW + C_AG + h]));
                p.OACC[tok * DM + h * 128 + d] = g * acc[r]; }
        }
        {
            const int tl = tid >> 5, tb = (pos0 + tl) >> 6;
#pragma unroll
            for (int q = 0; q < 2; ++q) { const int j = (tid & 31) + 32 * q; float v = 0.f;
                const int clo = (4 * j - 1) < 0 ? 0 : 4 * j - 1, chi = (4 * j + 3) > 254 ? 254 : 4 * j + 3;
                for (int h = 0; h < 4; ++h) for (int c = clo; c <= chi; ++c) v += sc[(tl * 4 + h) * 256 + c];
                if (j == 0 || j == tb || j == tb - 1) v += 1000.f;
                imp[tl * 64 + j] = (j <= tb) ? v : NEG_INF; }
        }
        __syncthreads();
        for (int q = 0; q < 2; ++q) {
            const int tl = wave + 8 * q; const float v = imp[tl * 64 + lane];
            int rank = 0;
            for (int jp = 0; jp < 64; ++jp) { const float o = __shfl(v, jp); rank += (o > v || (o == v && jp < lane)) ? 1 : 0; }
            const u64 m = __ballot(v != NEG_INF && rank < 16);
            if (lane == 0) p.SEL[tok0 + tl] = m;
        }
    }
}

enum { V_SLC = 0, V_WIN = 1, V_DIL = 2, V_DIFF = 3, V_STICK = 4 };
template <int VAR> DEV int attn_units() { return VAR == V_DIFF ? 256 : 128; }

template <int VAR>
DEV void attn_naive_unit(const Params& p, int l, int unit, float* lds) {
    constexpr int NQ4 = (VAR == V_DIFF) ? 8 : 16;
    float* Ks = lds; float* Vs = lds + 64 * 128;
    const int tid = tid_opq(), row = tid >> 1, hf = tid & 1;
    int b, h, tq, qcol, kcol, vcol, koff = 0, tile_lo, tile_hi;
    if (VAR == V_SLC || VAR == V_WIN) { b = unit >> 6; const int qb = unit & 63; h = row & 3; tq = qb * 64 + (row >> 2); qcol = C_AQ + h * 128;
        kcol = VAR == V_SLC ? C_AKS : C_AKW; vcol = VAR == V_SLC ? C_AVS : C_AVW; tile_hi = qb; tile_lo = VAR == V_SLC ? 0 : (qb - 8 < 0 ? 0 : qb - 8); }
    else if (VAR == V_DIL) { b = unit >> 6; h = (unit >> 4) & 3; const int qb = unit & 15; tq = qb * 256 + row; qcol = C_BQ + h * 128; kcol = C_BK + h * 128; vcol = C_BV + h * 128;
        tile_hi = qb * 4 + 3; tile_lo = qb * 4 - 32 < 0 ? 0 : qb * 4 - 32; }
    else if (VAR == V_DIFF) { b = unit >> 7; h = (unit >> 5) & 3; const int qb = unit & 31, map = row & 1; tq = qb * 128 + (row >> 1); qcol = C_CQ + (2 * h + map) * 64;
        kcol = C_CK + h * 128; koff = map * 64; vcol = C_CV + h * 128; tile_lo = 0; tile_hi = qb * 2 + 1; }
    else { b = unit >> 6; h = (unit >> 4) & 3; const int qb = unit & 15; tq = qb * 256 + row; qcol = C_DQ + h * 128; kcol = C_DK + h * 128; vcol = C_DV + h * 128; tile_lo = 0; tile_hi = qb * 4 + 3; }
    const size_t tokq = (size_t)b * SEQ + tq;
    const bf16_t* Pb = p.P;
    float4 q4[NQ4];
#pragma unroll
    for (int i = 0; i < NQ4; ++i) { const uint2 w = *(const uint2*)(Pb + tokq * PW + qcol + (2 * i + hf) * 4); q4[i] = {bflo(w.x), bfhi(w.x), bflo(w.y), bfhi(w.y)}; }
    float o[64];
#pragma unroll
    for (int i = 0; i < 64; ++i) o[i] = 0.f;
    float m = NEG_INF, lsum = 0.f, run = 0.f;
    u64 sel = 0; if (VAR == V_SLC) sel = p.SEL[tokq];
    const float scale = VAR == V_DIFF ? 0.125f : 0.08838834764831845f;
    const int ntiles = tile_hi - tile_lo + 1;
    for (int it = 0; it < ntiles; ++it) {
        const int tile = VAR == V_STICK ? tile_hi - it : tile_lo + it;
        __syncthreads();
#pragma unroll
        for (int ps = 0; ps < 2; ++ps) { const int key = (tid >> 4) + 32 * ps, c8 = (tid & 15) * 8; const size_t base = ((size_t)b * SEQ + tile * 64 + key) * PW;
            const uint4 kw = *(const uint4*)(Pb + base + kcol + c8), vw = *(const uint4*)(Pb + base + vcol + c8);
            *(float4*)(Ks + key * 128 + c8) = {bflo(kw.x), bfhi(kw.x), bflo(kw.y), bfhi(kw.y)}; *(float4*)(Ks + key * 128 + c8 + 4) = {bflo(kw.z), bfhi(kw.z), bflo(kw.w), bfhi(kw.w)};
            *(float4*)(Vs + key * 128 + c8) = {bflo(vw.x), bfhi(vw.x), bflo(vw.y), bfhi(vw.y)}; *(float4*)(Vs + key * 128 + c8 + 4) = {bflo(vw.z), bfhi(vw.z), bflo(vw.w), bfhi(vw.w)}; }
        __syncthreads();
        for (int jj = 0; jj < 64; ++jj) {
            const int j = VAR == V_STICK ? 63 - jj : jj, kpos = tile * 64 + j;
            const float4* kr = (const float4*)(Ks + j * 128 + koff);
            float s = 0.f;
#pragma unroll
            for (int i = 0; i < NQ4; ++i) { const float4 kv = kr[2 * i + hf]; s += q4[i].x * kv.x + q4[i].y * kv.y + q4[i].z * kv.z + q4[i].w * kv.w; }
            s += __shfl_xor(s, 1); s *= scale;
            const float4* vr = (const float4*)(Vs + j * 128);
            if (VAR == V_STICK) {
                if (kpos < tq) { const float ls = fminf(s, 0.f) - log1pf(__expf(-fabsf(s))); const float a = __expf(ls + run); run += ls - s;
#pragma unroll
                    for (int i = 0; i < 16; ++i) { const float4 vv = vr[2 * i + hf]; o[4 * i] += a * vv.x; o[4 * i + 1] += a * vv.y; o[4 * i + 2] += a * vv.z; o[4 * i + 3] += a * vv.w; } }
            } else {
                float w;
                const int dist = tq - kpos;
                if (VAR == V_SLC) w = (dist >= 0 && ((sel >> (kpos >> 6)) & 1ull)) ? 1.f : 0.f;
                else if (VAR == V_WIN) w = (dist >= 0 && dist <= 511) ? 1.f : 0.f;
                else if (VAR == V_DIL) w = dist < 0 ? 0.f : (float)((dist <= 128 ? 1 : 0) + (((dist & 3) == 0 && dist <= 512) ? 1 : 0) + (((dist & 15) == 0 && dist <= 2048) ? 1 : 0));
                else w = dist >= 0 ? 1.f : 0.f;
                if (w > 0.f) {
                    if (s > m) { const float cs = __expf(m - s); lsum *= cs;
#pragma unroll
                        for (int i = 0; i < 64; ++i) o[i] *= cs;
                        m = s; }
                    const float pz = w * __expf(s - m); lsum += pz;
#pragma unroll
                    for (int i = 0; i < 16; ++i) { const float4 vv = vr[2 * i + hf]; o[4 * i] += pz * vv.x; o[4 * i + 1] += pz * vv.y; o[4 * i + 2] += pz * vv.z; o[4 * i + 3] += pz * vv.w; }
                }
            }
        }
        if (VAR == V_STICK) {
            int* flags = (int*)(lds + 2 * 64 * 128);
            const int wok = __all(run < -110.f) ? 1 : 0;
            if ((tid & 63) == 0) flags[tid >> 6] = wok;
            __syncthreads();
            int all_ok = 1;
#pragma unroll
            for (int w = 0; w < 8; ++w) all_ok &= flags[w];
            if (all_ok) break;
        }
    }
    if (VAR == V_SLC || VAR == V_WIN) {
        const int br = VAR == V_SLC ? 1 : 2; const float g = sigmoidf_(bf2f(Pb[tokq * PW + C_AG + br * 4 + h])), f = g / lsum;
        float* dst = p.OACC + tokq * DM + h * 128;
#pragma unroll
        for (int i = 0; i < 16; ++i) { float4* d4 = (float4*)(dst + (2 * i + hf) * 4); float4 cur = *d4; cur.x += f * o[4 * i]; cur.y += f * o[4 * i + 1]; cur.z += f * o[4 * i + 2]; cur.w += f * o[4 * i + 3]; *d4 = cur; }
    } else if (VAR == V_DIL || VAR == V_STICK) {
        const float f = VAR == V_DIL ? 1.f / lsum : 1.f;
        float* dst = p.OACC + tokq * DM + (VAR == V_DIL ? 512 : 1536) + h * 128;
#pragma unroll
        for (int i = 0; i < 16; ++i) { float4 r = {f * o[4 * i], f * o[4 * i + 1], f * o[4 * i + 2], f * o[4 * i + 3]}; *(float4*)(dst + (2 * i + hf) * 4) = r; }
    } else {
        const float* lp = p.diff_lambda + (size_t)l * 256;
        float d01 = 0.f, d23 = 0.f;
        for (int i = 0; i < 64; ++i) { d01 += lp[i] * lp[64 + i]; d23 += lp[128 + i] * lp[192 + i]; }
        const float lam_init = 0.8f - 0.6f * expf(-0.3f * (float)l), lam = expf(d01) - expf(d23) + lam_init;
        const float inv = 1.f / lsum; float ss = 0.f;
#pragma unroll
        for (int i = 0; i < 64; ++i) { const float v = o[i] * inv, ot = __shfl_xor(v, 2); o[i] = v - lam * ot; ss += o[i] * o[i]; }
        ss += __shfl_xor(ss, 1);
        const float rs = rsqrtf(ss * (1.f / 128.f) + 1e-6f) * (1.f - lam_init);
        if ((row & 1) == 0) { const float* gg = p.diff_g + (size_t)l * 128; float* dst = p.OACC + tokq * DM + 1024 + h * 128;
#pragma unroll
            for (int i = 0; i < 16; ++i) { const int d0 = (2 * i + hf) * 4; const float4 g4 = *(const float4*)(gg + d0);
                float4 r = {o[4 * i] * rs * g4.x, o[4 * i + 1] * rs * g4.y, o[4 * i + 2] * rs * g4.z, o[4 * i + 3] * rs * g4.w}; *(float4*)(dst + d0) = r; } }
    }
}
template <int VAR>
DEV void ph_attn_naive(const Params& p, int l, float* lds, int wg, int nwg) {
    for (int unit = wg; unit < attn_units<VAR>(); unit += nwg) attn_naive_unit<VAR>(p, l, unit, lds);
}

DEV void ph_peer_select(const Params& p, int l, float* lds, int wg, int nwg) {
    float* qs = lds;
    float* scs = lds + 8 * 2048;
    const int tid = tid_opq(), lane = tid & 63, h = tid >> 6;
    for (int unit = wg; unit < TT / 8; unit += nwg) {
        const int tok0 = unit * 8;
        __syncthreads();
#pragma unroll
        for (int i = 0; i < 8; ++i) ((float4*)qs)[i * 512 + tid] = ((const float4*)(p.Q2 + (size_t)tok0 * DM))[i * 512 + tid];
        __syncthreads();
        {
            float acc[8][4];
#pragma unroll
            for (int t = 0; t < 8; ++t) { acc[t][0] = 0.f; acc[t][1] = 0.f; acc[t][2] = 0.f; acc[t][3] = 0.f; }
            const float* s0 = p.SKT + (((size_t)l * 8 + h) * 2 + 0) * 16384, * s1 = s0 + 16384;
            for (int c = 0; c < 128; c += 4) {
                float wa[4], wb[4], wc[4], wd[4];
#pragma unroll
                for (int k = 0; k < 4; ++k) { wa[k] = s0[(c + k) * 128 + lane]; wb[k] = s0[(c + k) * 128 + 64 + lane]; wc[k] = s1[(c + k) * 128 + lane]; wd[k] = s1[(c + k) * 128 + 64 + lane]; }
#pragma unroll
                for (int t = 0; t < 8; ++t) { const float4 q0 = *(const float4*)(qs + t * 2048 + h * 256 + c), q1 = *(const float4*)(qs + t * 2048 + h * 256 + 128 + c);
                    acc[t][0] += q0.x * wa[0] + q0.y * wa[1] + q0.z * wa[2] + q0.w * wa[3]; acc[t][1] += q0.x * wb[0] + q0.y * wb[1] + q0.z * wb[2] + q0.w * wb[3];
                    acc[t][2] += q1.x * wc[0] + q1.y * wc[1] + q1.z * wc[2] + q1.w * wc[3]; acc[t][3] += q1.x * wd[0] + q1.y * wd[1] + q1.z * wd[2] + q1.w * wd[3]; }
            }
#pragma unroll
            for (int t = 0; t < 8; ++t) { float* d = scs + (t * 8 + h) * 256; d[lane] = acc[t][0]; d[64 + lane] = acc[t][1]; d[128 + lane] = acc[t][2]; d[192 + lane] = acc[t][3]; }
        }
        __builtin_amdgcn_s_waitcnt(0);
        for (int t = 0; t < 8; ++t) {
            const float* d = scs + (t * 8 + h) * 256;
            float a = d[lane], bq = d[64 + lane], c2 = d[128 + lane], d2 = d[192 + lane];
            float ts1 = NEG_INF, ts2 = NEG_INF; int ti1 = 0, ti2 = 0;
            for (int k = 0; k < 16; ++k) {
                { const float mx = wave_max(fmaxf(a, bq)); const u64 ba = __ballot(a == mx), bb = __ballot(bq == mx); int n;
                  if (ba) { const int ln = __ffsll((long long)ba) - 1; n = ln; if (lane == ln) a = NEG_INF; } else { const int ln = __ffsll((long long)bb) - 1; n = ln + 64; if (lane == ln) bq = NEG_INF; }
                  if (lane == k) { ts1 = mx; ti1 = n; } }
                { const float mx = wave_max(fmaxf(c2, d2)); const u64 ba = __ballot(c2 == mx), bb = __ballot(d2 == mx); int n;
                  if (ba) { const int ln = __ffsll((long long)ba) - 1; n = ln; if (lane == ln) c2 = NEG_INF; } else { const int ln = __ffsll((long long)bb) - 1; n = ln + 64; if (lane == ln) d2 = NEG_INF; }
                  if (lane == k) { ts2 = mx; ti2 = n; } }
            }
            const float s1i = __shfl(ts1, lane >> 2); const int jb = (lane & 3) * 4;
            float c0 = s1i + __shfl(ts2, jb), c1 = s1i + __shfl(ts2, jb + 1), c2b = s1i + __shfl(ts2, jb + 2), c3 = s1i + __shfl(ts2, jb + 3);
            float fs = NEG_INF; int fe = 0;
            for (int k = 0; k < 16; ++k) {
                const float lm = fmaxf(fmaxf(c0, c1), fmaxf(c2b, c3)), mx = wave_max(lm);
                const u64 bal = __ballot(lm == mx); const int ln = __ffsll((long long)bal) - 1;
                int jj = 0;
                if (lane == ln) { if (c0 == mx) { jj = 0; c0 = NEG_INF; } else if (c1 == mx) { jj = 1; c1 = NEG_INF; } else if (c2b == mx) { jj = 2; c2b = NEG_INF; } else { jj = 3; c3 = NEG_INF; } }
                jj = __shfl(jj, ln);
                const int pos = ln * 4 + jj;
                const int i1 = __shfl(ti1, pos >> 4), i2 = __shfl(ti2, pos & 15);
                if (lane == k) { fs = mx; fe = i1 * 128 + i2; }
            }
            const float mx = __shfl(fs, 0); const float e = lane < 16 ? __expf(fs - mx) : 0.f; const float sm = wave_sum(e);
            if (lane < 16) { const size_t o = (size_t)(tok0 + t) * 128 + h * 16 + lane; p.EIDX[o] = fe; p.GATE[o] = e / sm; }
        }
    }
}

DEV void ph_peer_apply(const Params& p, int l, const float* __restrict__ xin, int wg, int nwg) {
    const int wave = tid_opq() >> 6, lane = tid_opq() & 63;
    const bf16_t* UBl = p.UB + (size_t)l * 16384 * 2048; const bf16_t* VBl = p.VB + (size_t)l * 16384 * 2048;
    for (int tok = wg * 8 + wave; tok < TT; tok += nwg * 8) {
        float xv[32], acc[32];
#pragma unroll
        for (int i = 0; i < 4; ++i) { const float4 a = *(const float4*)(xin + (size_t)tok * DM + i * 512 + lane * 8), bb = *(const float4*)(xin + (size_t)tok * DM + i * 512 + lane * 8 + 4);
            xv[i * 8 + 0] = a.x; xv[i * 8 + 1] = a.y; xv[i * 8 + 2] = a.z; xv[i * 8 + 3] = a.w; xv[i * 8 + 4] = bb.x; xv[i * 8 + 5] = bb.y; xv[i * 8 + 6] = bb.z; xv[i * 8 + 7] = bb.w; }
#pragma unroll
        for (int i = 0; i < 32; ++i) acc[i] = 0.f;
        for (int k0 = 0; k0 < 128; k0 += 2) {
            const int e0 = p.EIDX[(size_t)tok * 128 + k0], e1 = p.EIDX[(size_t)tok * 128 + k0 + 1];
            const float g0 = p.GATE[(size_t)tok * 128 + k0], g1 = p.GATE[(size_t)tok * 128 + k0 + 1];
            const uint4* u0 = (const uint4*)(UBl + (size_t)e0 * 2048); const uint4* u1 = (const uint4*)(UBl + (size_t)e1 * 2048);
            float d0 = 0.f, d1 = 0.f;
#pragma unroll
            for (int i = 0; i < 4; ++i) { const uint4 w0 = u0[i * 64 + lane], w1 = u1[i * 64 + lane];
                d0 += xv[i * 8 + 0] * bflo(w0.x) + xv[i * 8 + 1] * bfhi(w0.x) + xv[i * 8 + 2] * bflo(w0.y) + xv[i * 8 + 3] * bfhi(w0.y) + xv[i * 8 + 4] * bflo(w0.z) + xv[i * 8 + 5] * bfhi(w0.z) + xv[i * 8 + 6] * bflo(w0.w) + xv[i * 8 + 7] * bfhi(w0.w);
                d1 += xv[i * 8 + 0] * bflo(w1.x) + xv[i * 8 + 1] * bfhi(w1.x) + xv[i * 8 + 2] * bflo(w1.y) + xv[i * 8 + 3] * bfhi(w1.y) + xv[i * 8 + 4] * bflo(w1.z) + xv[i * 8 + 5] * bfhi(w1.z) + xv[i * 8 + 6] * bflo(w1.w) + xv[i * 8 + 7] * bfhi(w1.w); }
            d0 = wave_sum(d0); d1 = wave_sum(d1);
            const float h0 = g0 * gelu_tanh(d0), h1 = g1 * gelu_tanh(d1);
            const uint4* v0 = (const uint4*)(VBl + (size_t)e0 * 2048); const uint4* v1 = (const uint4*)(VBl + (size_t)e1 * 2048);
#pragma unroll
            for (int i = 0; i < 4; ++i) { const uint4 w0 = v0[i * 64 + lane], w1 = v1[i * 64 + lane];
                acc[i * 8 + 0] += h0 * bflo(w0.x) + h1 * bflo(w1.x); acc[i * 8 + 1] += h0 * bfhi(w0.x) + h1 * bfhi(w1.x);
                acc[i * 8 + 2] += h0 * bflo(w0.y) + h1 * bflo(w1.y); acc[i * 8 + 3] += h0 * bfhi(w0.y) + h1 * bfhi(w1.y);
                acc[i * 8 + 4] += h0 * bflo(w0.z) + h1 * bflo(w1.z); acc[i * 8 + 5] += h0 * bfhi(w0.z) + h1 * bfhi(w1.z);
                acc[i * 8 + 6] += h0 * bflo(w0.w) + h1 * bflo(w1.w); acc[i * 8 + 7] += h0 * bfhi(w0.w) + h1 * bfhi(w1.w); }
        }
#pragma unroll
        for (int i = 0; i < 4; ++i) { float* d = p.Y + (size_t)tok * DM + i * 512 + lane * 8;
            float4 a = {ALPHA * xv[i * 8 + 0] + acc[i * 8 + 0], ALPHA * xv[i * 8 + 1] + acc[i * 8 + 1], ALPHA * xv[i * 8 + 2] + acc[i * 8 + 2], ALPHA * xv[i * 8 + 3] + acc[i * 8 + 3]};
            float4 bb = {ALPHA * xv[i * 8 + 4] + acc[i * 8 + 4], ALPHA * xv[i * 8 + 5] + acc[i * 8 + 5], ALPHA * xv[i * 8 + 6] + acc[i * 8 + 6], ALPHA * xv[i * 8 + 7] + acc[i * 8 + 7]};
            *(float4*)d = a; *(float4*)(d + 4) = bb; }
    }
}

struct EpiResF32 {
    static constexpr bool PERM = false, AFTER_DRAIN = false;
    float* C; const float* X; float alpha;
    __device__ __forceinline__ void operator()(const pg8::f32x4 (&acc)[2][2][4][2], const pg8::Unit& u, int wr, int wc, int fr, int fq) const {
        const int row0 = u.pm * 256 + wr * 64 + fr, col0 = u.pn * 256 + wc * 32 + 4 * fq;
#pragma unroll
        for (int ai = 0; ai < 2; ++ai)
#pragma unroll
            for (int m = 0; m < 4; ++m) { const size_t off = (size_t)(row0 + ai * 128 + m * 16) * DM + col0;
#pragma unroll
                for (int bj = 0; bj < 2; ++bj)
#pragma unroll
                    for (int n = 0; n < 2; ++n) { const pg8::f32x4 xv = *(const pg8::f32x4*)(X + off + bj * 128 + n * 16); *(pg8::f32x4*)(C + off + bj * 128 + n * 16) = acc[ai][bj][m][n] + xv * alpha; } }
    }
};
struct EpiResLn {
    static constexpr bool PERM = false, AFTER_DRAIN = true;
    bf16_t* XB; const float* g; const float* bt; u64* xbuf; unsigned* cnt; unsigned want;
    __device__ __forceinline__ void fused(pg8::f32x4 (&acc)[2][2][4][2], const pg8::Unit& u, int wr, int wc, int fr, int fq, PG8_LAS unsigned char* lds, int wid, int lane) const {
        typedef float f32x2v __attribute__((ext_vector_type(2)));
        using pg8::f32x4;
        PG8_LAS f32x2v* P = (PG8_LAS f32x2v*)lds;
        PG8_LAS f32x2v* S = (PG8_LAS f32x2v*)(lds + 8192);
        const int col0 = u.pn * 256 + wc * 32 + 4 * fq;
#pragma unroll
        for (int ai = 0; ai < 2; ++ai) {
#pragma unroll
            for (int m = 0; m < 4; ++m) { const size_t off = (size_t)(u.pm * 256 + ai * 128 + wr * 64 + m * 16 + fr) * DM + col0;
#pragma unroll
                for (int bj = 0; bj < 2; ++bj)
#pragma unroll
                    for (int n = 0; n < 2; ++n) { const uint2 xw = *(const uint2*)(XB + off + bj * 128 + n * 16); const f32x4 xv = {bflo(xw.x), bfhi(xw.x), bflo(xw.y), bfhi(xw.y)}; acc[ai][bj][m][n] += xv * ALPHA; }
                if (m & 1) asm volatile("" : "+v"(acc[ai][0][m][0]), "+v"(acc[ai][0][m][1]), "+v"(acc[ai][1][m][0]), "+v"(acc[ai][1][m][1]) :: "memory"); } }
#pragma unroll
        for (int ai = 0; ai < 2; ++ai)
#pragma unroll
            for (int m = 0; m < 4; ++m) {
                float sm = 0.f;
#pragma unroll
                for (int bj = 0; bj < 2; ++bj)
#pragma unroll
                    for (int n = 0; n < 2; ++n) { const f32x4 x = acc[ai][bj][m][n]; sm += (x[0] + x[1]) + (x[2] + x[3]); }
                sm += __shfl_xor(sm, 16); sm += __shfl_xor(sm, 32);
                const float mw = sm * (1.0f / 64.0f); float q = 0.f;
#pragma unroll
                for (int bj = 0; bj < 2; ++bj)
#pragma unroll
                    for (int n = 0; n < 2; ++n) { const f32x4 d = acc[ai][bj][m][n] - mw; q += (d[0] * d[0] + d[1] * d[1]) + (d[2] * d[2] + d[3] * d[3]); }
                q += __shfl_xor(q, 16); q += __shfl_xor(q, 32);
                if (fq == 0) P[(ai * 128 + wr * 64 + m * 16 + fr) * 4 + wc] = (f32x2v){mw, q};
            }
        asm volatile("s_waitcnt lgkmcnt(0)" ::: "memory"); __builtin_amdgcn_s_barrier(); asm volatile("" ::: "memory");
        const int row = wid * 32 + (lane & 31);
        if (lane < 32) {
            const f32x2v a = P[row * 4 + 0], b = P[row * 4 + 1], c = P[row * 4 + 2], d = P[row * 4 + 3];
            const float mt = (a.x + b.x + c.x + d.x) * 0.25f;
            const float da = a.x - mt, db = b.x - mt, dc = c.x - mt, dd = d.x - mt;
            const float m2 = (a.y + b.y) + (c.y + d.y) + 64.0f * ((da * da + db * db) + (dc * dc + dd * dd));
            __hip_atomic_store(xbuf + ((size_t)(u.pm * 256 + row) * 8 + u.pn), ((u64)__float_as_uint(m2) << 32) | __float_as_uint(mt), __ATOMIC_RELAXED, __HIP_MEMORY_SCOPE_AGENT);
        }
        asm volatile("s_waitcnt vmcnt(0)" ::: "memory");
        if (lane == 0) __hip_atomic_fetch_add(cnt + 64 * u.pm, 1u, __ATOMIC_RELAXED, __HIP_MEMORY_SCOPE_AGENT);
        if (wid == 0) {
            while ((unsigned)__builtin_amdgcn_readfirstlane(__hip_atomic_load(cnt + 64 * u.pm, __ATOMIC_RELAXED, __HIP_MEMORY_SCOPE_AGENT)) < want) __builtin_amdgcn_s_sleep(2);
            __builtin_amdgcn_fence(__ATOMIC_ACQUIRE, "agent");
        }
        asm volatile("s_waitcnt vmcnt(0) lgkmcnt(0)" ::: "memory"); __builtin_amdgcn_s_barrier(); asm volatile("" ::: "memory");
        if (lane < 32) {
            const u64* slot = xbuf + (size_t)(u.pm * 256 + row) * 8; float mt[8], m2[8]; float ms = 0.f;
#pragma unroll
            for (int t = 0; t < 8; ++t) { const u64 w = __hip_atomic_load(slot + t, __ATOMIC_RELAXED, __HIP_MEMORY_SCOPE_AGENT); mt[t] = __uint_as_float((unsigned)w); m2[t] = __uint_as_float((unsigned)(w >> 32)); ms += mt[t]; }
            const float mean = ms * 0.125f; float q = 0.f;
#pragma unroll
            for (int t = 0; t < 8; ++t) { const float dm = mt[t] - mean; q += m2[t] + 256.0f * dm * dm; }
            S[row] = (f32x2v){mean, rsqrtf(q * (1.f / 2048.f) + 1e-5f)};
        }
        asm volatile("s_waitcnt lgkmcnt(0)" ::: "memory"); __builtin_amdgcn_s_barrier(); asm volatile("" ::: "memory");
#pragma unroll
        for (int bj = 0; bj < 2; ++bj)
#pragma unroll
            for (int n = 0; n < 2; ++n) { const int c = col0 + bj * 128 + n * 16; const f32x4 gv = *(const f32x4*)(g + c), bv = *(const f32x4*)(bt + c);
#pragma unroll
                for (int ai = 0; ai < 2; ++ai)
#pragma unroll
                    for (int m = 0; m < 4; ++m) { const int r = ai * 128 + wr * 64 + m * 16 + fr; const f32x2v sr = S[r]; const size_t off = (size_t)(u.pm * 256 + r) * DM + c;
                        const f32x4 o = (acc[ai][bj][m][n] - sr.x) * sr.y * gv + bv;
                        uint2 w; w.x = pack2(o[0], o[1]); w.y = pack2(o[2], o[3]); *(uint2*)(XB + off) = w; } }
    }
};
struct EpiInRope {
    static constexpr bool PERM = true, AFTER_DRAIN = false;
    bf16_t* O; const float* ROPE;
    __device__ __forceinline__ void operator()(const pg8::f32x4 (&acc)[2][2][4][2], const pg8::Unit& u, int wr, int wc, int fr, int fq) const {
        const int row0 = u.pm * 256 + wr * 64 + fr, col0 = u.pn * 256 + wc * 32 + 8 * fq;
#pragma unroll
        for (int bj = 0; bj < 2; ++bj) {
            const int G = u.pn * 2 + bj;
            const bool t1 = ((0x3FD5FULL >> G) & 1ull) != 0ull && wc == 0, t2 = ((0x3FC00000ULL >> G) & 1ull) != 0ull && (wc & 1) == 0;
#pragma unroll
            for (int ai = 0; ai < 2; ++ai)
#pragma unroll
                for (int m = 0; m < 4; ++m) {
                    const int row = row0 + ai * 128 + m * 16, pos = row & (SEQ - 1);
                    pg8::f32x4 v0 = acc[ai][bj][m][0], v1 = acc[ai][bj][m][1];
                    if (t1) {
                        const float* ct = ROPE + pos * 48 + 8 * (fq & 1);
                        const pg8::f32x4 c0 = *(const pg8::f32x4*)ct, c1 = *(const pg8::f32x4*)(ct + 4), s0 = *(const pg8::f32x4*)(ct + 16), s1 = *(const pg8::f32x4*)(ct + 20);
                        pg8::f32x4 o0, o1;
#pragma unroll
                        for (int j = 0; j < 4; ++j) { o0[j] = __shfl_xor(v0[j], 32); o1[j] = __shfl_xor(v1[j], 32); }
                        if (fq < 2) { v0 = v0 * c0 - o0 * s0; v1 = v1 * c1 - o1 * s1; }
                        else { v0 = o0 * s0 + v0 * c0; v1 = o1 * s1 + v1 * c1; }
                    } else if (t2) {
                        const float* ct = ROPE + pos * 48 + 32;
                        const pg8::f32x4 c0 = *(const pg8::f32x4*)ct, c1 = *(const pg8::f32x4*)(ct + 4), s0 = *(const pg8::f32x4*)(ct + 8), s1 = *(const pg8::f32x4*)(ct + 12);
                        pg8::f32x4 o0, o1;
#pragma unroll
                        for (int j = 0; j < 4; ++j) { o0[j] = __shfl_xor(v0[j], 16); o1[j] = __shfl_xor(v1[j], 16); }
                        if (fq == 0) { v0 = v0 * c0 - o0 * s0; v1 = v1 * c1 - o1 * s1; }
                        else if (fq == 1) { v0 = o0 * s0 + v0 * c0; v1 = o1 * s1 + v1 * c1; }
                    }
                    pg8::u32x4 w; w.x = pg8::cvt_pk_bf16(v0[0], v0[1]); w.y = pg8::cvt_pk_bf16(v0[2], v0[3]); w.z = pg8::cvt_pk_bf16(v1[0], v1[1]); w.w = pg8::cvt_pk_bf16(v1[2], v1[3]);
                    *(pg8::u32x4*)(O + (size_t)row * PW + col0 + bj * 128) = w;
                }
        }
    }
};
DEV void ph_gemm_in(const Params& p, int l, unsigned char* smem, int wg, int nwg) {
    pg8::Gemm g{p.XB, p.WINT + (size_t)l * PW * DM, TT, PW, DM};
    pg8::StaticOrder S; S.init(TT, PW, nwg, wg);
    EpiInRope E{p.P, p.ROPE};
    pg8::gemm_phase<EpiInRope, pg8::StaticOrder, false>((PG8_LAS unsigned char*)smem, g, S, E, nullptr);
}
DEV void ph_gemm_out(const Params& p, int l, const float* xres, unsigned char* smem, int wg, int nwg, int epoch) {
    pg8::Gemm g{p.OCAT, p.WOUTT + (size_t)l * DM * DM, TT, DM, DM};
    pg8::StaticOrder S; S.init(TT, DM, nwg, wg);
    if (nwg == 256) {
        EpiResLn E{p.XB, p.ln1_g + (size_t)l * DM, p.ln1_b + (size_t)l * DM, p.LNX, p.bar + 12288, 64u * (unsigned)epoch};
        pg8::gemm_phase<EpiResLn, pg8::StaticOrder, false>((PG8_LAS unsigned char*)smem, g, S, E, nullptr);
    } else {
        EpiResF32 E{p.Y, xres, ALPHA};
        pg8::gemm_phase<EpiResF32, pg8::StaticOrder, false>((PG8_LAS unsigned char*)smem, g, S, E, nullptr);
    }
}
DEV void ph_gemm_q(const Params& p, int l, unsigned char* smem, int wg, int nwg) {
    pg8::Gemm g{p.XB, p.WQT + (size_t)l * DM * DM, TT, DM, DM};
    pg8::StaticOrder S; S.init(TT, DM, nwg, wg);
    pg8::EpiF32 E{p.Q2, DM, nullptr};
    pg8::gemm_phase<pg8::EpiF32, pg8::StaticOrder, false>((PG8_LAS unsigned char*)smem, g, S, E, nullptr);
}


#ifdef PROBE_STAMP
#define TIC(k) do { if (tid_opq() == 0) ((unsigned long long*)(lds + LDS_BYTES - 192))[k] -= wall_clock64(); } while (0)
#define TOC(k) do { if (tid_opq() == 0) ((unsigned long long*)(lds + LDS_BYTES - 192))[k] += wall_clock64(); } while (0)
#else
#define TIC(k) do {} while (0)
#define TOC(k) do {} while (0)
#endif
namespace fa {
typedef short bf16x8 __attribute__((ext_vector_type(8)));
typedef short s16x4 __attribute__((ext_vector_type(4)));
typedef float f32x16 __attribute__((ext_vector_type(16)));
typedef float f32x4 __attribute__((ext_vector_type(4)));
typedef unsigned u32x4 __attribute__((ext_vector_type(4)));
constexpr int SHM_T = 16384;
constexpr int OFF_V = 0, OFF_K = 2 * SHM_T, OFF_WS = 4 * SHM_T, OFF_X = OFF_WS + 8 * 64 * 4;
#define FA_KSWZ(row, colB) ((row) * 256 + ((colB) ^ (((row) & 7) << 4)))
#define FA_SBAR() __builtin_amdgcn_sched_barrier(0)
DEV int v_st(int k, int c) { const int kk = (k & ~0xC) | ((k & 4) << 1) | ((k & 8) >> 1); return ((kk >> 3) * 4 + (c >> 5)) * 512 + ((kk & 7) * 32 + (c & 31)) * 2; }
DEV int v_rd_base(int lane) { return ((lane & 3) << 3) | (((lane >> 2) & 3) << 6) | (((lane >> 4) & 1) << 5) | (((lane >> 5) & 1) << 8); }
constexpr int v_rd_off(int d0, int ks, int half) { return d0 * 512 + ks * 4096 + half * 2048; }
DEV int crow(int r, int hi) { return (r & 3) + 8 * (r >> 2) + 4 * hi; }
DEV unsigned cvtpk(float lo, float hi) { unsigned r; asm volatile("v_cvt_pk_bf16_f32 %0, %1, %2" : "=v"(r) : "v"(lo), "v"(hi)); return r; }

template <int ND0>
DEV void qkt(f32x16& p0, f32x16& p1, const char* Kb, int kdB, int r32, int hi, const bf16x8* qr) {
    p0 = f32x16{}; p1 = f32x16{};
    const char* kb[4];
#pragma unroll
    for (int dd = 0; dd < 4; ++dd) kb[dd] = Kb + kdB + FA_KSWZ(r32, (dd * 16 + hi * 8) * 2);
#pragma unroll
    for (int d0 = 0; d0 < ND0; ++d0) { const char* a = kb[d0 & 3] + (d0 >> 2) * 128;
        const bf16x8 b0 = *reinterpret_cast<const bf16x8*>(a);
        const bf16x8 b1 = *reinterpret_cast<const bf16x8*>(a + 32 * 256);
        p0 = __builtin_amdgcn_mfma_f32_32x32x16_bf16(b0, qr[d0], p0, 0, 0, 0);
        p1 = __builtin_amdgcn_mfma_f32_32x32x16_bf16(b1, qr[d0], p1, 0, 0, 0); }
}
DEV void pv_tile(f32x16* o, int vb0, bf16x8 pa0, bf16x8 pa1, bf16x8 pa2, bf16x8 pa3) {
#define FA_TRRD(dst, off) asm volatile("ds_read_b64_tr_b16 %0, %1 offset:%2" : "=&v"(dst) : "v"(vb0), "i"(off) : "memory")
#define FA_PV_D0(d0) do { s16x4 l0, l1, l2, l3, h0, h1, h2, h3; constexpr int b_ = v_rd_off(d0, 0, 0); \
        FA_TRRD(l0, b_); FA_TRRD(h0, b_ + 2048); FA_TRRD(l1, b_ + 4096); FA_TRRD(h1, b_ + 6144); FA_TRRD(l2, b_ + 8192); FA_TRRD(h2, b_ + 10240); FA_TRRD(l3, b_ + 12288); FA_TRRD(h3, b_ + 14336); \
        asm volatile("s_waitcnt lgkmcnt(0)" ::: "memory"); FA_SBAR(); \
        o[d0] = __builtin_amdgcn_mfma_f32_32x32x16_bf16(pa0, (bf16x8){l0[0], l0[1], l0[2], l0[3], h0[0], h0[1], h0[2], h0[3]}, o[d0], 0, 0, 0); \
        o[d0] = __builtin_amdgcn_mfma_f32_32x32x16_bf16(pa1, (bf16x8){l1[0], l1[1], l1[2], l1[3], h1[0], h1[1], h1[2], h1[3]}, o[d0], 0, 0, 0); \
        o[d0] = __builtin_amdgcn_mfma_f32_32x32x16_bf16(pa2, (bf16x8){l2[0], l2[1], l2[2], l2[3], h2[0], h2[1], h2[2], h2[3]}, o[d0], 0, 0, 0); \
        o[d0] = __builtin_amdgcn_mfma_f32_32x32x16_bf16(pa3, (bf16x8){l3[0], l3[1], l3[2], l3[3], h3[0], h3[1], h3[2], h3[3]}, o[d0], 0, 0, 0); } while (0)
    FA_PV_D0(0); FA_PV_D0(1); FA_PV_D0(2); FA_PV_D0(3);
#undef FA_PV_D0
#undef FA_TRRD
}
DEV void pack_p(const f32x16& p0, const f32x16& p1, bf16x8& pa0, bf16x8& pa1, bf16x8& pa2, bf16x8& pa3) {
#define FA_PK4(P, B_, OUT) do { unsigned a0 = cvtpk(P[B_ + 0], P[B_ + 1]), a1 = cvtpk(P[B_ + 2], P[B_ + 3]); \
        unsigned b0 = cvtpk(P[B_ + 4], P[B_ + 5]), b1 = cvtpk(P[B_ + 6], P[B_ + 7]); \
        auto r0 = __builtin_amdgcn_permlane32_swap(a0, b0, false, false); auto r1 = __builtin_amdgcn_permlane32_swap(a1, b1, false, false); \
        u32x4 w = {r0[0], r1[0], r0[1], r1[1]}; OUT = *reinterpret_cast<bf16x8*>(&w); } while (0)
    FA_PK4(p0, 0, pa0); FA_PK4(p0, 8, pa1); FA_PK4(p1, 0, pa2); FA_PK4(p1, 8, pa3);
#undef FA_PK4
}
DEV float xhalf_max(float v) { auto rr = __builtin_amdgcn_permlane32_swap(__float_as_uint(v), __float_as_uint(v), false, false); return fmaxf(__uint_as_float(rr[0]), __uint_as_float(rr[1])); }
DEV float xhalf_sum(float v) { auto rr = __builtin_amdgcn_permlane32_swap(__float_as_uint(v), __float_as_uint(v), false, false); return __uint_as_float(rr[0]) + __uint_as_float(rr[1]); }

DEV void mask_tile(f32x16& p0, f32x16& p1, int dq  , unsigned W, bool en) {
#pragma unroll
    for (int r = 0; r < 16; ++r) { const int c = (r & 3) + 8 * (r >> 2);
        if (!en || (unsigned)(dq - c) >= W) p0[r] = NEG_INF;
        if (!en || (unsigned)(dq - c - 32) >= W) p1[r] = NEG_INF; }
}
DEV void softmax_tile(f32x16& p0, f32x16& p1, float& m_reg, float& l_reg, float C2, float& alpha) {
    float pmax = p0[0];
#pragma unroll
    for (int r = 1; r < 16; ++r) pmax = fmaxf(pmax, p0[r]);
#pragma unroll
    for (int r = 0; r < 16; ++r) pmax = fmaxf(pmax, p1[r]);
    pmax = xhalf_max(pmax);
    float mn;
    if (__builtin_expect(__all((pmax - m_reg) * C2 <= 11.5f), 1)) { mn = m_reg; alpha = 1.f; }
    else { mn = fmaxf(m_reg, pmax); alpha = __builtin_amdgcn_exp2f((m_reg - mn) * C2); m_reg = mn; }
    const float mnL = -mn * C2; float ps = 0.f;
#pragma unroll
    for (int r = 0; r < 16; ++r) { p0[r] = __builtin_amdgcn_exp2f(fmaf(p0[r], C2, mnL)); ps += p0[r]; }
#pragma unroll
    for (int r = 0; r < 16; ++r) { p1[r] = __builtin_amdgcn_exp2f(fmaf(p1[r], C2, mnL)); ps += p1[r]; }
    ps = xhalf_sum(ps);
    l_reg = l_reg * alpha + ps;
}
DEV void scale_rows(f32x16* o, float fac, float* wsl, int r32, int hi) {
    if (hi == 0) wsl[r32] = fac;
    asm volatile("s_waitcnt lgkmcnt(0)" ::: "memory");
#pragma unroll
    for (int r = 0; r < 16; ++r) { const float f = wsl[crow(r, hi)];
#pragma unroll
        for (int d = 0; d < 4; ++d) o[d][r] *= f; }
    asm volatile("s_waitcnt lgkmcnt(0)" ::: "memory");
}

struct KV { const bf16_t* K; const bf16_t* V; size_t stride; };

struct Stage { bf16x8 k0, k1, v0, v1; };
DEV void stage_load(Stage& s, const KV& kv, int j0, int sr, int sc) {
    const bf16_t* kp = kv.K + (size_t)(j0 + sr) * kv.stride + sc; const bf16_t* vp = kv.V + (size_t)(j0 + sr) * kv.stride + sc;
    s.v0 = *(const bf16x8*)vp; s.v1 = *(const bf16x8*)(vp + 32 * kv.stride);
    s.k0 = *(const bf16x8*)kp; s.k1 = *(const bf16x8*)(kp + 32 * kv.stride);
}
DEV void stage_write(const Stage& s, char* lds, int buf, int sr, int sc) {
    const int kws = FA_KSWZ(sr, sc * 2);
    *(bf16x8*)(lds + OFF_K + buf * SHM_T + kws) = s.k0; *(bf16x8*)(lds + OFF_K + buf * SHM_T + kws + 32 * 256) = s.k1;
    *(bf16x8*)(lds + OFF_V + buf * SHM_T + v_st(sr, sc)) = s.v0; *(bf16x8*)(lds + OFF_V + buf * SHM_T + v_st(32 + sr, sc)) = s.v1;
}

template <int ND0, bool USE_SEL>
DEV void softmax_pass(char* lds, const KV& kv, int j_lo, int j_hi, const bf16x8* qr, int kdB, int qi, int qlo, int qhi, unsigned W, u64 selbits, float C2,
                      f32x16* o, float& m_reg, float& l_reg) {
    const int tid = tid_opq(), lane = tid & 63, wid = __builtin_amdgcn_readfirstlane(tid >> 6), r32 = lane & 31, hi = lane >> 5;
    const int sr = tid >> 4, sc = (tid & 15) * 8;
    float* wsl = (float*)(lds + OFF_WS) + wid * 64;
    const int vrb = v_rd_base(lane);
    Stage st;
    __syncthreads();
    stage_load(st, kv, j_lo * 64, sr, sc); stage_write(st, lds, 0, sr, sc);
    __syncthreads();
    for (int t = j_lo; t < j_hi; ++t) {
        const int buf = (t - j_lo) & 1;
        stage_load(st, kv, (t + 1 < j_hi ? t + 1 : j_hi - 1) * 64, sr, sc);
        const int kb = t * 64;
        const bool act = (kb <= qhi) && ((unsigned)(qlo - (kb + 63)) < W || qlo - (kb + 63) < 0);
        if (act) {
            f32x16 p0, p1;
            qkt<ND0>(p0, p1, lds + OFF_K + buf * SHM_T, kdB, r32, hi, qr);
            const bool en = USE_SEL ? (((selbits >> t) & 1ull) != 0ull) : true;
            const bool full = (qlo - kb - 63 >= 0) && ((unsigned)(qhi - kb) < W);
            if (!full || (USE_SEL && __any(!en))) mask_tile(p0, p1, qi - kb - 4 * hi, W, en);
            float alpha;
            softmax_tile(p0, p1, m_reg, l_reg, C2, alpha);
            if (__any(alpha < 1.f)) scale_rows(o, alpha, wsl, r32, hi);
            bf16x8 pa0, pa1, pa2, pa3;
            pack_p(p0, p1, pa0, pa1, pa2, pa3);
            pv_tile(o, (int)(uintptr_t)(lds + OFF_V + buf * SHM_T) + vrb, pa0, pa1, pa2, pa3);
        }
        stage_write(st, lds, buf ^ 1, sr, sc);
        __syncthreads();
    }
}

template <int ND0>
DEV void load_q(bf16x8* qr, const bf16_t* qrow, int hi) {
#pragma unroll
    for (int d0 = 0; d0 < ND0; ++d0) qr[d0] = *(const bf16x8*)(qrow + d0 * 16 + hi * 8);
    __builtin_amdgcn_s_waitcnt(0x0F70);
}
template <bool ACCUM>
DEV void store_rows(f32x16* o, float fac, float* wsl, float* dst, size_t row0, size_t rstride, int ld, int r32, int hi) {
    scale_rows(o, fac, wsl, r32, hi);
#pragma unroll
    for (int r = 0; r < 16; ++r) { float* rp = dst + (row0 + rstride * (size_t)crow(r, hi)) * (size_t)ld + r32;
#pragma unroll
        for (int d = 0; d < 4; ++d) { float v = o[d][r]; if (ACCUM) v += rp[d * 32]; rp[d * 32] = v; } }
}
}

constexpr float SC128 = 0.08838834764831845f, SC64 = 0.125f, LOG2E = 1.4426950408889634f;

DEV void nsa_unit_mfma(const Params& p, int l, int unit, char* lds) {
    using namespace fa;
    const int tid = tid_opq(), lane = tid & 63, wid = __builtin_amdgcn_readfirstlane(tid >> 6), r32 = lane & 31, hi = lane >> 5;
    const int b = unit >> 6, qb = unit & 63, h = wid >> 1, tl = (wid & 1) * 32 + r32, pos = qb * 64 + tl;
    const size_t tok = (size_t)b * SEQ + pos, tok_w0 = (size_t)b * SEQ + qb * 64 + (wid & 1) * 32;
    float* wsl = (float*)(lds + OFF_WS) + wid * 64;
    float* imp = (float*)(lds + OFF_X);
    u64* selm = (u64*)(lds + OFF_X + 64 * 64 * 4);
    const bf16_t* Pb = p.P;
    bf16x8 qr[8];
    load_q<8>(qr, Pb + tok * PW + C_AQ + h * 128, hi);
    const float C2 = SC128 * LOG2E;
    const float g0 = sigmoidf_(bf2f(Pb[tok * PW + C_AG + 0 + h])), g1 = sigmoidf_(bf2f(Pb[tok * PW + C_AG + 4 + h])), g2 = sigmoidf_(bf2f(Pb[tok * PW + C_AG + 8 + h]));
    for (int i = tid; i < 64 * 64; i += 512) imp[i] = 0.f;
    float* dst = p.OACC + h * 128;
    const KV kvc{p.KCB + (size_t)b * 256 * 128, p.VCB + (size_t)b * 256 * 128, 128};
    const int qic = pos >= 31 ? (pos - 31) >> 4 : -1;
    const int posw = qb * 64 + (wid & 1) * 32, qlo_c = posw >= 31 ? (posw - 31) >> 4 : -1, qhi_c = (posw + 31 - 31) >> 4;
    {
        f32x16 o[4] = {}; float m_reg = -1e30f, l_reg = 0.f;
        softmax_pass<8, false>(lds, kvc, 0, 4, qr, 0, qic, qlo_c, qhi_c, 0x80000000u, 0ull, C2, o, m_reg, l_reg);
        store_rows<false>(o, l_reg > 0.f ? g0 / l_reg : 0.f, wsl, dst, tok_w0, 1, DM, r32, hi);
        const float mnL = -m_reg * C2, inv = l_reg > 0.f ? 1.f / l_reg : 0.f;
        const int sr = tid >> 4, sc = (tid & 15) * 8;
        for (int t = 0; t < 4; ++t) {
            __syncthreads();
            { const bf16_t* kp = kvc.K + (size_t)(t * 64 + sr) * 128 + sc; const bf16x8 k0 = *(const bf16x8*)kp, k1 = *(const bf16x8*)(kp + 32 * 128);
              const int kws = FA_KSWZ(sr, sc * 2); *(bf16x8*)(lds + OFF_K + kws) = k0; *(bf16x8*)(lds + OFF_K + kws + 32 * 256) = k1; }
            __syncthreads();
            f32x16 p0, p1;
            qkt<8>(p0, p1, lds + OFF_K, 0, r32, hi, qr);
            mask_tile(p0, p1, qic - t * 64 - 4 * hi, 0x80000000u, true);
#pragma unroll
            for (int r = 0; r < 16; ++r) { p0[r] = __builtin_amdgcn_exp2f(fmaf(p0[r], C2, mnL)) * inv; p1[r] = __builtin_amdgcn_exp2f(fmaf(p1[r], C2, mnL)) * inv; }
#pragma unroll
            for (int g = 0; g < 4; ++g) {
                { const int j = t * 16 + 2 * g + hi; const float G = (p0[4 * g] + p0[4 * g + 1]) + (p0[4 * g + 2] + p0[4 * g + 3]);
                  atomicAdd(&imp[tl * 64 + j], G); if (j + 1 < 64) atomicAdd(&imp[tl * 64 + j + 1], p0[4 * g + 3]); }
                { const int j = t * 16 + 8 + 2 * g + hi; const float G = (p1[4 * g] + p1[4 * g + 1]) + (p1[4 * g + 2] + p1[4 * g + 3]);
                  atomicAdd(&imp[tl * 64 + j], G); if (j + 1 < 64) atomicAdd(&imp[tl * 64 + j + 1], p1[4 * g + 3]); }
            }
        }
    }
    __syncthreads();
    for (int q = 0; q < 8; ++q) {
        const int tk = wid * 8 + q, tb = (qb * 64 + tk) >> 6;
        float v = imp[tk * 64 + lane];
        if (lane == 0 || lane == tb || lane == tb - 1) v += 1000.f;
        if (lane > tb) v = NEG_INF;
        int rank = 0;
        for (int jp = 0; jp < 64; ++jp) { const float ov = __shfl(v, jp); rank += (ov > v || (ov == v && jp < lane)) ? 1 : 0; }
        const u64 mk = __ballot(v != NEG_INF && rank < 16);
        if (lane == 0) selm[tk] = mk;
    }
    __syncthreads();
    const u64 sel = selm[tl];
    const int qlo = qb * 64 + (wid & 1) * 32, qhi = qlo + 31;
    {
        const KV kvs{Pb + (size_t)b * SEQ * PW + C_AKS, Pb + (size_t)b * SEQ * PW + C_AVS, (size_t)PW};
        f32x16 o[4] = {}; float m_reg = -1e30f, l_reg = 0.f;
        softmax_pass<8, true>(lds, kvs, 0, qb + 1, qr, 0, pos, qlo, qhi, 0x80000000u, sel, C2, o, m_reg, l_reg);
        store_rows<true>(o, g1 / l_reg, wsl, dst, tok_w0, 1, DM, r32, hi);
    }
    {
        const KV kvw{Pb + (size_t)b * SEQ * PW + C_AKW, Pb + (size_t)b * SEQ * PW + C_AVW, (size_t)PW};
        f32x16 o[4] = {}; float m_reg = -1e30f, l_reg = 0.f;
        softmax_pass<8, false>(lds, kvw, qb - 8 < 0 ? 0 : qb - 8, qb + 1, qr, 0, pos, qlo, qhi, 512u, 0ull, C2, o, m_reg, l_reg);
        store_rows<true>(o, g2 / l_reg, wsl, dst, tok_w0, 1, DM, r32, hi);
    }
}

DEV void dil_unit_mfma(const Params& p, int unit, char* lds) {
    using namespace fa;
    const int tid = tid_opq(), lane = tid & 63, wid = __builtin_amdgcn_readfirstlane(tid >> 6), r32 = lane & 31, hi = lane >> 5;
    const int sub = unit & 15, pat = (unit >> 4) % 3, bh = unit / 48, b = bh >> 2, h = bh & 3;
    const int dl = pat == 0 ? 1 : pat == 1 ? 4 : 16;
    const int nblk = 16 / dl, res = sub / nblk, blk = sub % nblk;
    float* wsl = (float*)(lds + OFF_WS) + wid * 64;
    const bf16_t* Pb = p.P + ((size_t)b * SEQ + res) * PW;
    const int si0 = blk * 256 + wid * 32, si = si0 + r32;
    bf16x8 qr[8];
    load_q<8>(qr, Pb + (size_t)si * dl * PW + C_BQ + h * 128, hi);
    const KV kv{Pb + C_BK + h * 128, Pb + C_BV + h * 128, (size_t)dl * PW};
    f32x16 o[4] = {}; float m_reg = -1e30f, l_reg = 0.f;
    const int j_lo = blk * 4 - 2 < 0 ? 0 : blk * 4 - 2, j_hi = blk * 4 + 4;
    softmax_pass<8, false>(lds, kv, j_lo, j_hi, qr, 0, si, si0, si0 + 31, 129u, 0ull, SC128 * LOG2E, o, m_reg, l_reg);
    const size_t tok0 = (size_t)b * SEQ + res + (size_t)si0 * dl;
    store_rows<false>(o, 1.f / l_reg, wsl, p.DILO + (size_t)pat * TT * 512 + h * 128, tok0, (size_t)dl, 512, r32, hi);
    if (hi == 0) p.DILL[(size_t)pat * TT * 4 + (tok0 + (size_t)r32 * dl) * 4 + h] = m_reg * SC128 + __logf(l_reg);
}

DEV void diff_unit_mfma(const Params& p, int unit, char* lds) {
    using namespace fa;
    const int tid = tid_opq(), lane = tid & 63, wid = __builtin_amdgcn_readfirstlane(tid >> 6), r32 = lane & 31, hi = lane >> 5;
    const int qb = 15 - (unit >> 4), map = unit & 1, h = (unit >> 1) & 3, b = (unit >> 3) & 1;
    float* wsl = (float*)(lds + OFF_WS) + wid * 64;
    const bf16_t* Pb = p.P + (size_t)b * SEQ * PW;
    const int pos0 = qb * 256 + wid * 32, pos = pos0 + r32;
    bf16x8 qr[4];
    load_q<4>(qr, Pb + (size_t)pos * PW + C_CQ + (2 * h + map) * 64, hi);
    const KV kv{Pb + C_CK + h * 128, Pb + C_CV + h * 128, (size_t)PW};
    f32x16 o[4] = {}; float m_reg = -1e30f, l_reg = 0.f;
    softmax_pass<4, false>(lds, kv, 0, qb * 4 + 4, qr, map * 128, pos, pos0, pos0 + 31, 0x80000000u, 0ull, SC64 * LOG2E, o, m_reg, l_reg);
    store_rows<false>(o, 1.f / l_reg, wsl, p.DIFO + (size_t)map * TT * 512 + h * 128, (size_t)b * SEQ + pos0, 1, 512, r32, hi);
}

DEV void stick_unit_mfma(const Params& p, int unit, char* lds) {
    using namespace fa;
    const int tid = tid_opq(), lane = tid & 63, wid = __builtin_amdgcn_readfirstlane(tid >> 6), r32 = lane & 31, hi = lane >> 5;
    const int qb = 15 - (unit >> 3), h = unit & 3, b = (unit >> 2) & 1;
    float* wsl = (float*)(lds + OFF_WS) + wid * 64;
    int* flags = (int*)(lds + LDS_FLAGS_OFF);
    const bf16_t* Pb = p.P + (size_t)b * SEQ * PW;
    const int pos0 = qb * 256 + wid * 32, pos = pos0 + r32;
    bf16x8 qr[8];
    load_q<8>(qr, Pb + (size_t)pos * PW + C_DQ + h * 128, hi);
    const KV kv{Pb + C_DK + h * 128, Pb + C_DV + h * 128, (size_t)PW};
    const int sr = tid >> 4, sc = (tid & 15) * 8, vrb = v_rd_base(lane);
    f32x16 o[4] = {};
    float carry = 0.f;
    Stage st;
    const int t_hi = qb * 4 + 3;
    __syncthreads();
    stage_load(st, kv, t_hi * 64, sr, sc); stage_write(st, lds, 0, sr, sc);
    __syncthreads();
    for (int t = t_hi; t >= 0; --t) {
        const int it = t_hi - t, buf = it & 1;
        stage_load(st, kv, (t > 0 ? t - 1 : 0) * 64, sr, sc);
        const int kb = t * 64;
        if (kb < pos0 + 31) {
            f32x16 p0, p1, q0, q1;
            qkt<8>(p0, p1, lds + OFF_K + buf * SHM_T, 0, r32, hi, qr);
            const int dq = pos - kb - 4 * hi;
#pragma unroll
            for (int r = 0; r < 16; ++r) { const int c = (r & 3) + 8 * (r >> 2);
                { const float z = p0[r] * SC128, ls = fminf(z, 0.f) - __logf(1.f + __expf(-fabsf(z))); const bool ok = (dq - c) >= 1;
                  p0[r] = ok ? ls : NEG_INF; q0[r] = ok ? ls - z : 0.f; }
                { const float z = p1[r] * SC128, ls = fminf(z, 0.f) - __logf(1.f + __expf(-fabsf(z))); const bool ok = (dq - c - 32) >= 1;
                  p1[r] = ok ? ls : NEG_INF; q1[r] = ok ? ls - z : 0.f; } }
            float gs[8], og[8], aft[8];
#pragma unroll
            for (int g = 0; g < 4; ++g) { gs[g] = (q0[4 * g] + q0[4 * g + 1]) + (q0[4 * g + 2] + q0[4 * g + 3]); gs[4 + g] = (q1[4 * g] + q1[4 * g + 1]) + (q1[4 * g + 2] + q1[4 * g + 3]); }
#pragma unroll
            for (int i = 0; i < 8; ++i) og[i] = __shfl_xor(gs[i], 32);
            float run = 0.f;
#pragma unroll
            for (int pi = 7; pi >= 0; --pi) { const float vo = hi ? gs[pi] : og[pi], ve = hi ? og[pi] : gs[pi];
                const float ao = run; run += vo; const float ae = run; run += ve; aft[pi] = hi ? ao : ae; }
#pragma unroll
            for (int g = 0; g < 4; ++g) {
                { float tl = carry + aft[g];
                  const float a3 = __expf(p0[4 * g + 3] + tl); tl += q0[4 * g + 3]; const float a2 = __expf(p0[4 * g + 2] + tl); tl += q0[4 * g + 2];
                  const float a1 = __expf(p0[4 * g + 1] + tl); tl += q0[4 * g + 1]; const float a0 = __expf(p0[4 * g] + tl);
                  p0[4 * g] = a0; p0[4 * g + 1] = a1; p0[4 * g + 2] = a2; p0[4 * g + 3] = a3; }
                { float tl = carry + aft[4 + g];
                  const float a3 = __expf(p1[4 * g + 3] + tl); tl += q1[4 * g + 3]; const float a2 = __expf(p1[4 * g + 2] + tl); tl += q1[4 * g + 2];
                  const float a1 = __expf(p1[4 * g + 1] + tl); tl += q1[4 * g + 1]; const float a0 = __expf(p1[4 * g] + tl);
                  p1[4 * g] = a0; p1[4 * g + 1] = a1; p1[4 * g + 2] = a2; p1[4 * g + 3] = a3; }
            }
            carry += run;
            bf16x8 pa0, pa1, pa2, pa3;
            pack_p(p0, p1, pa0, pa1, pa2, pa3);
            pv_tile(o, (int)(uintptr_t)(lds + OFF_V + buf * SHM_T) + vrb, pa0, pa1, pa2, pa3);
        }
        const int wok = __all(carry < -110.f) ? 1 : 0;
        if (lane == 0) flags[(it & 1) * 8 + wid] = wok;
        stage_write(st, lds, buf ^ 1, sr, sc);
        __syncthreads();
        int all_ok = 1;
#pragma unroll
        for (int w = 0; w < 8; ++w) all_ok &= flags[(it & 1) * 8 + w];
        if (all_ok) break;
    }
    store_rows<false>(o, 1.f, wsl, p.OACC + 1536 + h * 128, (size_t)b * SEQ + pos0, 1, DM, r32, hi);
}

DEV void ph_attn_final(const Params& p, int l, int wg, int nwg) {
    const int tid = tid_opq(), wave = tid >> 6, lane = tid & 63;
    const float* lp = p.diff_lambda + (size_t)l * 256;
    const float d01 = wave_sum(lp[lane] * lp[64 + lane]), d23 = wave_sum(lp[128 + lane] * lp[192 + lane]);
    const float lam_init = 0.8f - 0.6f * expf(-0.3f * (float)l), lam = expf(d01) - expf(d23) + lam_init;
    const float* gg = p.diff_g + (size_t)l * 128;
    const int c = lane * 8, hd = lane >> 4;
    const float4 ga = *(const float4*)(gg + (c & 127)), gb = *(const float4*)(gg + (c & 127) + 4);
    for (int tok = wg * 8 + wave; tok < TT; tok += nwg * 8) {
        bf16_t* orow = p.OCAT + (size_t)tok * DM;
        { const float* n0 = p.NSAO + (size_t)tok * 512 + c; const float* n1 = n0 + (size_t)TT * 512; const float* n2 = n1 + (size_t)TT * 512;
          const float4 a0 = *(const float4*)n0, b0 = *(const float4*)(n0 + 4), a1 = *(const float4*)n1, b1 = *(const float4*)(n1 + 4), a2 = *(const float4*)n2, b2 = *(const float4*)(n2 + 4);
          uint4 w; w.x = pack2(a0.x + a1.x + a2.x, a0.y + a1.y + a2.y); w.y = pack2(a0.z + a1.z + a2.z, a0.w + a1.w + a2.w);
          w.z = pack2(b0.x + b1.x + b2.x, b0.y + b1.y + b2.y); w.w = pack2(b0.z + b1.z + b2.z, b0.w + b1.w + b2.w); *(uint4*)(orow + c) = w; }
        { const float l0 = p.DILL[(size_t)0 * TT * 4 + (size_t)tok * 4 + hd], l1 = p.DILL[(size_t)1 * TT * 4 + (size_t)tok * 4 + hd], l2 = p.DILL[(size_t)2 * TT * 4 + (size_t)tok * 4 + hd];
          const float mx = fmaxf(l0, fmaxf(l1, l2)); float w0 = __expf(l0 - mx), w1 = __expf(l1 - mx), w2 = __expf(l2 - mx); const float inv = 1.f / (w0 + w1 + w2); w0 *= inv; w1 *= inv; w2 *= inv;
          const float* s0 = p.DILO + (size_t)tok * 512 + c; const float* s1 = s0 + (size_t)TT * 512; const float* s2 = s1 + (size_t)TT * 512;
          const float4 a0 = *(const float4*)s0, b0 = *(const float4*)(s0 + 4), a1 = *(const float4*)s1, b1 = *(const float4*)(s1 + 4), a2 = *(const float4*)s2, b2 = *(const float4*)(s2 + 4);
          uint4 w; w.x = pack2(w0 * a0.x + w1 * a1.x + w2 * a2.x, w0 * a0.y + w1 * a1.y + w2 * a2.y); w.y = pack2(w0 * a0.z + w1 * a1.z + w2 * a2.z, w0 * a0.w + w1 * a1.w + w2 * a2.w);
          w.z = pack2(w0 * b0.x + w1 * b1.x + w2 * b2.x, w0 * b0.y + w1 * b1.y + w2 * b2.y); w.w = pack2(w0 * b0.z + w1 * b1.z + w2 * b2.z, w0 * b0.w + w1 * b1.w + w2 * b2.w);
          *(uint4*)(orow + 512 + c) = w; }
        { const float* s0 = p.DIFO + (size_t)tok * 512 + c; const float* s1 = s0 + (size_t)TT * 512;
          const float4 a0 = *(const float4*)s0, b0 = *(const float4*)(s0 + 4), a1 = *(const float4*)s1, b1 = *(const float4*)(s1 + 4);
          float v[8] = {a0.x - lam * a1.x, a0.y - lam * a1.y, a0.z - lam * a1.z, a0.w - lam * a1.w, b0.x - lam * b1.x, b0.y - lam * b1.y, b0.z - lam * b1.z, b0.w - lam * b1.w};
          float ss = (v[0] * v[0] + v[1] * v[1]) + (v[2] * v[2] + v[3] * v[3]) + (v[4] * v[4] + v[5] * v[5]) + (v[6] * v[6] + v[7] * v[7]);
          ss += __shfl_xor(ss, 1); ss += __shfl_xor(ss, 2); ss += __shfl_xor(ss, 4); ss += __shfl_xor(ss, 8);
          const float rs = rsqrtf(ss * (1.f / 128.f) + 1e-6f) * (1.f - lam_init);
          uint4 w; w.x = pack2(v[0] * rs * ga.x, v[1] * rs * ga.y); w.y = pack2(v[2] * rs * ga.z, v[3] * rs * ga.w); w.z = pack2(v[4] * rs * gb.x, v[5] * rs * gb.y); w.w = pack2(v[6] * rs * gb.z, v[7] * rs * gb.w);
          *(uint4*)(orow + 1024 + c) = w; }
        { const float4 a = *(const float4*)(p.OACC + (size_t)tok * DM + 1536 + c), bb = *(const float4*)(p.OACC + (size_t)tok * DM + 1536 + c + 4);
          uint4 w; w.x = pack2(a.x, a.y); w.y = pack2(a.z, a.w); w.z = pack2(bb.x, bb.y); w.w = pack2(bb.z, bb.w); *(uint4*)(orow + 1536 + c) = w; }
    }
}


namespace fa {
constexpr int S2_V = 0, S2_K = 5 * SHM_T, S2_WS = 9 * SHM_T, S2_X = S2_WS + 8 * 64 * 4;
struct Stage2 { bf16x8 k[4], v[4]; };
DEV void stage2_load(Stage2& s, const KV& kv, int j0  , int sr16, int sc) {
#pragma unroll
    for (int i = 0; i < 4; ++i) { const size_t ro = (size_t)(j0 + sr16 + 16 * i) * kv.stride + sc; s.v[i] = *(const bf16x8*)(kv.V + ro); s.k[i] = *(const bf16x8*)(kv.K + ro); }
}
DEV void stage2_write(const Stage2& s, char* lds, int kslot, int vslot, int sr16, int sc) {
#pragma unroll
    for (int i = 0; i < 4; ++i) { const int row = sr16 + 16 * i;
        *(bf16x8*)(lds + S2_K + kslot * SHM_T + FA_KSWZ(row, sc * 2)) = s.k[i];
        *(bf16x8*)(lds + S2_V + vslot * SHM_T + v_st(row, sc)) = s.v[i]; }
}
DEV int vslot2(int g, int s) { return g == 0 ? (s & 1) : 2 + (s % 3); }
template <int ND0, bool USE_SEL, bool KEEP_K = false>
DEV void softmax_pass2(char* lds, const KV& kv, int j_lo, int j_hi, const bf16x8* qr, int kdB, int qi, int qlo, int qhi, unsigned W, u64 selbits, float C2,
                       f32x16* o, float& m_reg, float& l_reg) {
    const int tid = tid_opq(), lane = tid & 63, wid = __builtin_amdgcn_readfirstlane(tid >> 6), r32 = lane & 31, hi = lane >> 5;
    const int grp = wid >> 2, wr = wid & 3;
    const int sg = tid >> 8, sr16 = (tid & 255) >> 4, sc = (tid & 15) * 8;
    float* wsl = (float*)(lds + S2_WS) + wid * 64;
    const int vrb = v_rd_base(lane);
    const int ns = (j_hi - j_lo + 1) >> 1;
    Stage2 st;
    TIC(5);
    __syncthreads();
    { const int t0 = j_lo + sg < j_hi ? j_lo + sg : j_hi - 1; stage2_load(st, kv, t0 * 64, sr16, sc); stage2_write(st, lds, sg, vslot2(sg, 0), sr16, sc); }
    __syncthreads();
    TOC(5); TIC(1);
    if (grp == 1) __builtin_amdgcn_s_setprio(1);
#define FA_SP(P0_, P1_, VSLOT_) do { float alpha_; softmax_tile(P0_, P1_, m_reg, l_reg, C2, alpha_); if (__any(alpha_ < 1.f)) scale_rows(o, alpha_, wsl, r32, hi); \
        bf16x8 pa0_, pa1_, pa2_, pa3_; pack_p(P0_, P1_, pa0_, pa1_, pa2_, pa3_); pv_tile(o, (int)(uintptr_t)(lds + S2_V + (VSLOT_) * SHM_T) + vrb, pa0_, pa1_, pa2_, pa3_); } while (0)
    for (int s = 0; s < ns; ++s) {
        const int buf = s & 1; int tn = j_lo + 2 * (s + 1) + sg; tn = tn < j_hi ? tn : j_hi - 1;
        stage2_load(st, kv, tn * 64, sr16, sc);
        const int t = j_lo + 2 * s + grp, kb = t * 64;
        const bool act = (t < j_hi) && (kb <= qhi) && ((unsigned)(qlo - (kb + 63)) < W || qlo - (kb + 63) < 0);
        if (act) {
            f32x16 p0, p1;
            qkt<ND0>(p0, p1, lds + S2_K + (buf * 2 + grp) * SHM_T, kdB, r32, hi, qr);
            const bool en = USE_SEL ? (((selbits >> t) & 1ull) != 0ull) : true;
            const bool full = (qlo - kb - 63 >= 0) && ((unsigned)(qhi - kb) < W);
            if (!full || (USE_SEL && __any(!en))) mask_tile(p0, p1, qi - kb - 4 * hi, W, en);
            FA_SP(p0, p1, vslot2(grp, s));
        }
        if (!KEEP_K || s + 1 < ns) stage2_write(st, lds, (buf ^ 1) * 2 + sg, vslot2(sg, s + 1), sr16, sc);
        __syncthreads();
    }
#undef FA_SP
    __builtin_amdgcn_s_setprio(0);
    __syncthreads();
    TOC(1); TIC(2);
    float* mo = (float*)(lds + S2_V) + wr * 4096;
    float* ml = (float*)(lds + S2_X + 8704) + wr * 128;
    if (grp == 1) {
#pragma unroll
        for (int d = 0; d < 4; ++d)
#pragma unroll
            for (int r = 0; r < 16; ++r) mo[(d * 16 + r) * 64 + lane] = o[d][r];
        ml[lane] = m_reg; ml[64 + lane] = l_reg;
    }
    __syncthreads();
    if (grp == 0) {
        const float m1 = ml[lane], l1 = ml[64 + lane], mn = fmaxf(m_reg, m1);
        const float a0 = __builtin_amdgcn_exp2f((m_reg - mn) * C2), a1 = __builtin_amdgcn_exp2f((m1 - mn) * C2);
        l_reg = l_reg * a0 + l1 * a1; m_reg = mn;
        if (hi == 0) { wsl[r32] = a0; wsl[32 + r32] = a1; }
        asm volatile("s_waitcnt lgkmcnt(0)" ::: "memory");
#pragma unroll
        for (int r = 0; r < 16; ++r) { const float f0 = wsl[crow(r, hi)], f1 = wsl[32 + crow(r, hi)];
#pragma unroll
            for (int d = 0; d < 4; ++d) o[d][r] = o[d][r] * f0 + mo[(d * 16 + r) * 64 + lane] * f1; }
        asm volatile("s_waitcnt lgkmcnt(0)" ::: "memory");
    }
    __syncthreads();
    if (grp == 0) { ml[lane] = m_reg; ml[64 + lane] = l_reg; }
    __syncthreads();
    if (grp == 1) { m_reg = ml[lane]; l_reg = ml[64 + lane]; }
    TOC(2);
}
}

DEV void nsa_unit2(const Params& p, int l, int unit, char* lds) {
    using namespace fa;
    const int tid = tid_opq(), lane = tid & 63, wid = __builtin_amdgcn_readfirstlane(tid >> 6), r32 = lane & 31, hi = lane >> 5;
    const int grp = wid >> 2, h = wid & 3;
    const int b = unit >> 7, blk = unit & 127, qb = blk >> 1, pos0 = blk * 32, pos = pos0 + r32;
    const size_t tok = (size_t)b * SEQ + pos, tok0 = (size_t)b * SEQ + pos0;
    float* wsl = (float*)(lds + S2_WS) + wid * 64;
    unsigned* imp = (unsigned*)(lds + S2_X);
    u64* selm = (u64*)(lds + S2_X + 32 * 65 * 4 + 8);
    const bf16_t* Pb = p.P;
    bf16x8 qr[8];
    load_q<8>(qr, Pb + tok * PW + C_AQ + h * 128, hi);
    const float C2 = SC128 * LOG2E;
    const float g0 = sigmoidf_(bf2f(Pb[tok * PW + C_AG + 0 + h])), g1 = sigmoidf_(bf2f(Pb[tok * PW + C_AG + 4 + h])), g2 = sigmoidf_(bf2f(Pb[tok * PW + C_AG + 8 + h]));
    for (int i = tid; i < 32 * 65; i += 512) imp[i] = 0u;
    float* dst = p.NSAO + h * 128;
    const KV kvc{p.KCB + (size_t)b * 256 * 128, p.VCB + (size_t)b * 256 * 128, 128};
    const int qic = pos >= 31 ? (pos - 31) >> 4 : -1;
    const int qlo_c = pos0 >= 31 ? (pos0 - 31) >> 4 : -1, qhi_c = pos0 >> 4;
    {
        f32x16 o[4] = {}; float m_reg = -1e30f, l_reg = 0.f;
        softmax_pass2<8, false, true>(lds, kvc, 0, 4, qr, 0, qic, qlo_c, qhi_c, 0x80000000u, 0ull, C2, o, m_reg, l_reg);
        if (grp == 0) store_rows<false>(o, l_reg > 0.f ? g0 / l_reg : 0.f, wsl, dst, tok0, 1, 512, r32, hi);
        TIC(3);
        const float mnL = -m_reg * C2, inv = l_reg > 0.f ? 1.f / l_reg : 0.f;
        for (int s = 0; s < 2; ++s) {
            const int t = 2 * s + grp;
            f32x16 p0, p1;
            qkt<8>(p0, p1, lds + S2_K + t * SHM_T, 0, r32, hi, qr);
            mask_tile(p0, p1, qic - t * 64 - 4 * hi, 0x80000000u, true);
#pragma unroll
            for (int r = 0; r < 16; ++r) { p0[r] = __builtin_amdgcn_exp2f(fmaf(p0[r], C2, mnL)) * inv; p1[r] = __builtin_amdgcn_exp2f(fmaf(p1[r], C2, mnL)) * inv; }
#pragma unroll
            for (int g = 0; g < 4; ++g) {
                { const int j = t * 16 + 2 * g + hi; const float G = (p0[4 * g] + p0[4 * g + 1]) + (p0[4 * g + 2] + p0[4 * g + 3]);
                  atomicAdd(&imp[r32 * 65 + j], (unsigned)(G * 16777216.f + 0.5f)); if (j + 1 < 64) atomicAdd(&imp[r32 * 65 + j + 1], (unsigned)(p0[4 * g + 3] * 16777216.f + 0.5f)); }
                { const int j = t * 16 + 8 + 2 * g + hi; const float G = (p1[4 * g] + p1[4 * g + 1]) + (p1[4 * g + 2] + p1[4 * g + 3]);
                  atomicAdd(&imp[r32 * 65 + j], (unsigned)(G * 16777216.f + 0.5f)); if (j + 1 < 64) atomicAdd(&imp[r32 * 65 + j + 1], (unsigned)(p1[4 * g + 3] * 16777216.f + 0.5f)); }
            }
        }
    }
    __syncthreads();
    for (int q = 0; q < 4; ++q) {
        const int tk = wid * 4 + q;
        float v = (float)imp[tk * 65 + lane] * (1.f / 16777216.f);
        if (lane == 0 || lane == qb || lane == qb - 1) v += 1000.f;
        if (lane > qb) v = NEG_INF;
        int rank = 0;
        for (int jp = 0; jp < 64; ++jp) { const float ov = __shfl(v, jp); rank += (ov > v || (ov == v && jp < lane)) ? 1 : 0; }
        const u64 mk = __ballot(v != NEG_INF && rank < 16);
        if (lane == 0) selm[tk] = mk;
    }
    __syncthreads();
    TOC(3);
    const u64 sel = selm[r32];
    const int qlo = pos0, qhi = pos0 + 31;
    {
        const KV kvs{Pb + (size_t)b * SEQ * PW + C_AKS, Pb + (size_t)b * SEQ * PW + C_AVS, (size_t)PW};
        f32x16 o[4] = {}; float m_reg = -1e30f, l_reg = 0.f;
        softmax_pass2<8, true>(lds, kvs, 0, qb + 1, qr, 0, pos, qlo, qhi, 0x80000000u, sel, C2, o, m_reg, l_reg);
        if (grp == 0) store_rows<false>(o, g1 / l_reg, wsl, dst + (size_t)TT * 512, tok0, 1, 512, r32, hi);
    }
    {
        const KV kvw{Pb + (size_t)b * SEQ * PW + C_AKW, Pb + (size_t)b * SEQ * PW + C_AVW, (size_t)PW};
        f32x16 o[4] = {}; float m_reg = -1e30f, l_reg = 0.f;
        softmax_pass2<8, false>(lds, kvw, qb - 8 < 0 ? 0 : qb - 8, qb + 1, qr, 0, pos, qlo, qhi, 512u, 0ull, C2, o, m_reg, l_reg);
        if (grp == 0) store_rows<false>(o, g2 / l_reg, wsl, dst + (size_t)2 * TT * 512, tok0, 1, 512, r32, hi);
    }
}

DEV void diff_unit2(const Params& p, int unit, char* lds) {
    using namespace fa;
    const int tid = tid_opq(), lane = tid & 63, wid = __builtin_amdgcn_readfirstlane(tid >> 6), r32 = lane & 31, hi = lane >> 5;
    const int grp = wid >> 2, wr = wid & 3;
    const int qb = 31 - (unit >> 4), map = unit & 1, h = (unit >> 1) & 3, b = (unit >> 3) & 1;
    float* wsl = (float*)(lds + S2_WS) + wid * 64;
    const bf16_t* Pb = p.P + (size_t)b * SEQ * PW;
    const int pos0 = qb * 128 + wr * 32, pos = pos0 + r32;
    bf16x8 qr[4];
    load_q<4>(qr, Pb + (size_t)pos * PW + C_CQ + (2 * h + map) * 64, hi);
    const KV kv{Pb + C_CK + h * 128, Pb + C_CV + h * 128, (size_t)PW};
    f32x16 o[4] = {}; float m_reg = -1e30f, l_reg = 0.f;
    softmax_pass2<4, false>(lds, kv, 0, qb * 2 + 2, qr, map * 128, pos, pos0, pos0 + 31, 0x80000000u, 0ull, SC64 * LOG2E, o, m_reg, l_reg);
    if (grp == 0) store_rows<false>(o, 1.f / l_reg, wsl, p.DIFO + (size_t)map * TT * 512 + h * 128, (size_t)b * SEQ + pos0, 1, 512, r32, hi);
}

DEV void ph_cmp_bias(const Params& p, float* lds, int wg, int nwg) {
    const int tid = tid_opq(), j4 = tid & 15, ks = tid >> 4;
    for (int u = wg; u < NL * 2 * 4 * 8; u += nwg) {
        const int lk = u >> 5, jb = (u >> 3) & 3, kp = u & 7, k0 = kp * 512 + ks * 16;
        const float* w1 = p.cmp_w1 + (size_t)lk * 4096 * 256 + (size_t)k0 * 256 + jb * 64 + j4 * 4; const float* pe = p.cmp_pe + (size_t)lk * 4096 + k0;
        float4 s = make_float4(0.f, 0.f, 0.f, 0.f);
#pragma unroll
        for (int k = 0; k < 16; ++k) { const float4 w = *(const float4*)(w1 + (size_t)k * 256); const float e = pe[k]; s.x += e * w.x; s.y += e * w.y; s.z += e * w.z; s.w += e * w.w; }
        __syncthreads();
        *(float4*)(lds + ks * 64 + j4 * 4) = s;
        __syncthreads();
        if (tid < 64) { float t = 0.f;
#pragma unroll
            for (int q = 0; q < 32; ++q) t += lds[q * 64 + tid];
            p.CB[(size_t)(lk * 8 + kp) * 256 + jb * 64 + tid] = t; }
    }
}
DEV void compress_unit_mfma(const Params& p, int l, int unit, char* lds) {
    using namespace fa;
    const int tid = tid_opq(), lane = tid & 63, wid = __builtin_amdgcn_readfirstlane(tid >> 6), r32 = lane & 31, hi = lane >> 5;
    const int kv = unit >> 4, b = (unit >> 3) & 1, rt = unit & 7;
    const int col = kv ? C_AVC : C_AKC;
    const bf16_t* W1T = p.W1T + ((size_t)l * 2 + kv) * 256 * 4096; const bf16_t* W2T = p.W2T + ((size_t)l * 2 + kv) * 128 * 256;
    constexpr int PITCH = 272;
    char* As = lds;
    char* Bs = lds + 32 * PITCH + wid * (32 * PITCH);
    bf16_t* hid = (bf16_t*)(lds + 9 * 32 * PITCH);
    const int arow = tid >> 4, apc = tid & 15;
    int atok0 = 16 * (rt * 32 + arow);
    const bf16_t* abase = p.P + ((size_t)b * SEQ) * PW + col + apc * 8;
    const bf16_t* bbase = W1T + (size_t)(wid * 32 + (lane >> 4)) * 4096 + (lane & 15) * 8;
    __syncthreads();
    f32x16 acc = {};
    bf16x8 ra, rb[8];
    { int tk = atok0; tk = tk > SEQ - 1 ? SEQ - 1 : tk; ra = *(const bf16x8*)(abase + (size_t)tk * PW);
#pragma unroll
      for (int i = 0; i < 8; ++i) rb[i] = *(const bf16x8*)(bbase + (size_t)(4 * i) * 4096); }
    for (int tl = 0; tl < 32; ++tl) {
        __syncthreads();
        *(bf16x8*)(As + arow * PITCH + apc * 16) = ra;
#pragma unroll
        for (int i = 0; i < 8; ++i) *(bf16x8*)(Bs + ((lane >> 4) + 4 * i) * PITCH + (lane & 15) * 16) = rb[i];
        __syncthreads();
        { const int tn = tl < 31 ? tl + 1 : 31; int tk = atok0 + tn; tk = tk > SEQ - 1 ? SEQ - 1 : tk;
          ra = *(const bf16x8*)(abase + (size_t)tk * PW);
#pragma unroll
          for (int i = 0; i < 8; ++i) rb[i] = *(const bf16x8*)(bbase + (size_t)(4 * i) * 4096 + tn * 128); }
#pragma unroll
        for (int s = 0; s < 8; ++s) {
            const bf16x8 a = *(const bf16x8*)(As + r32 * PITCH + s * 32 + hi * 16);
            const bf16x8 bb = *(const bf16x8*)(Bs + r32 * PITCH + s * 32 + hi * 16);
            acc = __builtin_amdgcn_mfma_f32_32x32x16_bf16(a, bb, acc, 0, 0, 0);
        }
    }
    {
        float bias = 0.f;
#pragma unroll
        for (int kp = 0; kp < 8; ++kp) bias += p.CB[(((size_t)l * 2 + kv) * 8 + kp) * 256 + wid * 32 + r32];
#pragma unroll
        for (int r = 0; r < 16; ++r) hid[crow(r, hi) * 264 + wid * 32 + r32] = f2bf(gelu_tanh(acc[r] + bias));
    }
    __syncthreads();
    if (wid < 4) {
        f32x16 acc2 = {};
        const bf16_t* brow = W2T + (size_t)(wid * 32 + r32) * 256 + hi * 8;
#pragma unroll
        for (int s = 0; s < 16; ++s) {
            const bf16x8 a = *(const bf16x8*)(hid + r32 * 264 + s * 16 + hi * 8);
            const bf16x8 bb = *(const bf16x8*)(brow + s * 16);
            acc2 = __builtin_amdgcn_mfma_f32_32x32x16_bf16(a, bb, acc2, 0, 0, 0);
        }
        bf16_t* dst = (kv ? p.VCB : p.KCB) + ((size_t)b * 256 + rt * 32) * 128 + wid * 32 + r32;
#pragma unroll
        for (int r = 0; r < 16; ++r) { const int row = crow(r, hi); dst[(size_t)row * 128] = (rt * 32 + row < 255) ? f2bf(acc2[r]) : (bf16_t)0; }
    }
}

DEV int next_unit_x(unsigned* ctrs, int nper, int& xq, int& tries, char* lds) {
    int* slot = (int*)(lds + LDS_SLOT_OFF);
    __syncthreads();
    if (tid_opq() < 64) {
        const int lane = tid_opq();
        int q = xq, i = -1, done = tries;
        while (!done) {
            int v = 0;
            if (lane == 0) v = (int)atomicAdd(ctrs + q * 64, 1u);
            v = __builtin_amdgcn_readfirstlane(v);
            if (v < nper) { i = v; break; }
            const int c = lane < 8 ? (int)xb_ld(ctrs + lane * 64) : nper;
            const unsigned m = (unsigned)(__ballot(c < nper) & 0xFFull);
            if (!m) { done = 1; break; }
            const unsigned rot = ((m >> q) | (m << (8 - q))) & 0xFFu;
            q = (q + __builtin_ctz(rot)) & 7;
        }
        if (lane == 0) { slot[0] = i; slot[1] = q; slot[2] = done; }
    }
    __syncthreads();
    const int i = slot[0]; xq = slot[1]; tries = slot[2];
    return i;
}
DEV int next_unit(unsigned* ctr, char* lds) {
    int* slot = (int*)(lds + LDS_SLOT_OFF);
    __syncthreads();
    if (tid_opq() == 0) *slot = (int)atomicAdd(ctr, 1u);
    __syncthreads();
    return *slot;
}

typedef float f32x2_t __attribute__((ext_vector_type(2)));
typedef _Float16 h2_t __attribute__((ext_vector_type(2)));
constexpr float U8_SCALE = 64.f, V8_SCALE = 16.f;
DEV void ph_cvt8(const float* __restrict__ src, unsigned char* __restrict__ dst, size_t n, float scale, int wg, int nwg) {
    const size_t n4 = n / 4;
    const int tid = tid_opq(), lane = tid & 63, gw = wg * 8 + (tid >> 6), nw = nwg * 8;
    for (size_t b = (size_t)gw * 256; b < n4; b += (size_t)nw * 256) {
#pragma unroll
        for (int j = 0; j < 4; ++j) { const float4 a = ((const float4*)src)[b + j * 64 + lane]; int w = 0;
            w = __builtin_amdgcn_cvt_pk_fp8_f32(a.x * scale, a.y * scale, w, false); w = __builtin_amdgcn_cvt_pk_fp8_f32(a.z * scale, a.w * scale, w, true);
            ((int*)dst)[b + j * 64 + lane] = w; }
    }
}
template <int CTRL> DEV float dpp_f(float v) { return __int_as_float(__builtin_amdgcn_update_dpp(0, __float_as_int(v), CTRL, 0xF, 0xF, false)); }
DEV float wave_sum_uniform(float v) {
    v += dpp_f<0xB1>(v); v += dpp_f<0x4E>(v); v += dpp_f<0x141>(v); v += dpp_f<0x140>(v);
    const float a = __int_as_float(__builtin_amdgcn_readlane(__float_as_int(v), 0)), b = __int_as_float(__builtin_amdgcn_readlane(__float_as_int(v), 16));
    const float c = __int_as_float(__builtin_amdgcn_readlane(__float_as_int(v), 32)), d = __int_as_float(__builtin_amdgcn_readlane(__float_as_int(v), 48));
    return (a + b) + (c + d);
}
DEV float dot16_fp8(const uint4 w, const float* x) {
    float s = 0.f;
    f32x2_t t;
    t = __builtin_amdgcn_cvt_pk_f32_fp8((int)w.x, false); s += t.x * x[0] + t.y * x[1];   t = __builtin_amdgcn_cvt_pk_f32_fp8((int)w.x, true); s += t.x * x[2] + t.y * x[3];
    t = __builtin_amdgcn_cvt_pk_f32_fp8((int)w.y, false); s += t.x * x[4] + t.y * x[5];   t = __builtin_amdgcn_cvt_pk_f32_fp8((int)w.y, true); s += t.x * x[6] + t.y * x[7];
    t = __builtin_amdgcn_cvt_pk_f32_fp8((int)w.z, false); s += t.x * x[8] + t.y * x[9];   t = __builtin_amdgcn_cvt_pk_f32_fp8((int)w.z, true); s += t.x * x[10] + t.y * x[11];
    t = __builtin_amdgcn_cvt_pk_f32_fp8((int)w.w, false); s += t.x * x[12] + t.y * x[13]; t = __builtin_amdgcn_cvt_pk_f32_fp8((int)w.w, true); s += t.x * x[14] + t.y * x[15];
    return s;
}
typedef float f32x4_t __attribute__((ext_vector_type(4)));
DEV void ph_peer_u(const Params& p, int l, unsigned char* smem, int wg, int nwg) {
    const int tid = tid_opq(), wave = __builtin_amdgcn_readfirstlane(tid_opq() >> 6), lane = tid & 63, r = lane & 15, q = lane >> 4;
    const unsigned char* U8l = p.U8 + (size_t)l * 16384 * 2048;
    unsigned char* x8 = smem;
    unsigned* sorted = (unsigned*)(smem + 65536);
    int* hist = (int*)(smem + 65536 + 16384);
    unsigned char* ring = smem + 82944 + wave * 8192;
    for (int unit = wg; unit < TT / 32; unit += nwg) {
        const int tok0 = unit * 32;
        __syncthreads();
        if (tid < 128) hist[tid] = 0;
        for (int t = wave; t < 32; t += 8) {
            const uint4* xs = (const uint4*)(p.XB + (size_t)(tok0 + t) * DM + lane * 32);
            int w[8];
#pragma unroll
            for (int i = 0; i < 4; ++i) { const uint4 a = xs[i]; int v = 0; v = __builtin_amdgcn_cvt_pk_fp8_f32(bflo(a.x), bfhi(a.x), v, false); v = __builtin_amdgcn_cvt_pk_fp8_f32(bflo(a.y), bfhi(a.y), v, true); w[2 * i] = v;
                v = 0; v = __builtin_amdgcn_cvt_pk_fp8_f32(bflo(a.z), bfhi(a.z), v, false); v = __builtin_amdgcn_cvt_pk_fp8_f32(bflo(a.w), bfhi(a.w), v, true); w[2 * i + 1] = v; }
            *(uint4*)(x8 + t * 2048 + (((lane * 2) ^ (t & 15)) << 4)) = make_uint4((unsigned)w[0], (unsigned)w[1], (unsigned)w[2], (unsigned)w[3]);
            *(uint4*)(x8 + t * 2048 + (((lane * 2 + 1) ^ (t & 15)) << 4)) = make_uint4((unsigned)w[4], (unsigned)w[5], (unsigned)w[6], (unsigned)w[7]);
        }
        int ev[8];
#pragma unroll
        for (int i = 0; i < 8; ++i) ev[i] = p.EIDX[(size_t)tok0 * 128 + i * 512 + tid];
        __syncthreads();
#pragma unroll
        for (int i = 0; i < 8; ++i) atomicAdd(&hist[ev[i] >> 7], 1);
        __syncthreads();
        if (tid < 64) {
            const int a = hist[2 * tid], b = hist[2 * tid + 1]; int s = a + b;
#pragma unroll
            for (int o = 1; o < 64; o <<= 1) { const int t2 = __shfl_up(s, o); if (tid >= o) s += t2; }
            const int ex = s - (a + b); hist[2 * tid] = ex; hist[2 * tid + 1] = ex + a;
        }
        __syncthreads();
#pragma unroll
        for (int i = 0; i < 8; ++i) { const int pos = atomicAdd(&hist[ev[i] >> 7], 1); sorted[pos] = ((unsigned)ev[i] << 12) | (unsigned)(i * 512 + tid); }
        __syncthreads();
#define PU_DMA(src_, slot_) __builtin_amdgcn_global_load_lds((const unsigned*)(src_), (LAS unsigned*)(ring + (slot_) * 1024), 16, 0, 0)
        const int lr = lane >> 2, lq = lane & 3; const unsigned ring_a = (unsigned)(uintptr_t)ring + (unsigned)((r * 4 + q) * 16), x8_a = (unsigned)(uintptr_t)x8, sorted_a = (unsigned)(uintptr_t)sorted;
        unsigned ent = sorted[wave * 16 + r];
        const unsigned char* rp = U8l + (size_t)(sorted[wave * 16 + lr] >> 12) * 2048 + lq * 16;
        asm volatile("" ::: "memory");
#pragma unroll
        for (int j = 0; j < 4; ++j) { PU_DMA(rp + (2 * j) * 64, 2 * j); PU_DMA(rp + (2 * j + 1) * 64, 2 * j + 1); }
        int rsl = 0;
        for (int g = wave; g < 256; g += 8) {
            f32x4_t acc = {0.f, 0.f, 0.f, 0.f};
            const unsigned slot = (ent >> 7) & 31u, sw = slot & 15u;
            const unsigned xrow = x8_a + slot * 2048u;
            const unsigned xo[4] = {((0u + q) ^ sw) << 4, ((4u + q) ^ sw) << 4, ((8u + q) ^ sw) << 4, ((12u + q) ^ sw) << 4};
            const int gn = g + 8 < 256 ? g + 8 : g;
            unsigned entn, rown;
            asm volatile("ds_read_b32 %0, %2\n\tds_read_b32 %1, %3\n\ts_waitcnt lgkmcnt(0)" : "=&v"(entn), "=&v"(rown) : "v"(sorted_a + (unsigned)(gn * 16 + r) * 4u), "v"(sorted_a + (unsigned)(gn * 16 + lr) * 4u) : "memory");
            const unsigned char* rpn = U8l + (size_t)(rown >> 12) * 2048 + lq * 16;
            const size_t wo = (size_t)tok0 * 128 + (ent & 4095u);
            const float gate = p.GATE[wo];
#pragma unroll 4
            for (int c2 = 0; c2 < 16; ++c2) {
                __builtin_amdgcn_s_waitcnt(0x0F76);
                asm volatile("" ::: "memory");
                typedef unsigned u32x4_t __attribute__((ext_vector_type(4)));
                u32x4_t a0, a1, x0, x1; const unsigned ra = ring_a + (unsigned)rsl * 2048u; const int fsl = rsl;
                rsl = (rsl + 1) & 3;
                const int c = 2 * c2;
                const unsigned xa0 = xrow + (unsigned)((c >> 2) << 8) + xo[c & 3], xa1 = xrow + (unsigned)(((c + 1) >> 2) << 8) + xo[(c + 1) & 3];
                asm volatile("ds_read_b128 %0, %4\n\tds_read_b128 %1, %4 offset:1024\n\tds_read_b128 %2, %5\n\tds_read_b128 %3, %6\n\ts_waitcnt lgkmcnt(0)"
                             : "=&v"(a0), "=&v"(a1), "=&v"(x0), "=&v"(x1) : "v"(ra), "v"(xa0), "v"(xa1) : "memory");
                acc = __builtin_amdgcn_mfma_f32_16x16x32_fp8_fp8((long)(((unsigned long long)a0[1] << 32) | a0[0]), (long)(((unsigned long long)x0[1] << 32) | x0[0]), acc, 0, 0, 0);
                acc = __builtin_amdgcn_mfma_f32_16x16x32_fp8_fp8((long)(((unsigned long long)a0[3] << 32) | a0[2]), (long)(((unsigned long long)x0[3] << 32) | x0[2]), acc, 0, 0, 0);
                acc = __builtin_amdgcn_mfma_f32_16x16x32_fp8_fp8((long)(((unsigned long long)a1[1] << 32) | a1[0]), (long)(((unsigned long long)x1[1] << 32) | x1[0]), acc, 0, 0, 0);
                acc = __builtin_amdgcn_mfma_f32_16x16x32_fp8_fp8((long)(((unsigned long long)a1[3] << 32) | a1[2]), (long)(((unsigned long long)x1[3] << 32) | x1[2]), acc, 0, 0, 0);
                { const int ci = c2 + 4; const unsigned char* src = ci < 16 ? rp + ci * 128 : rpn + (ci - 16) * 128;
                  asm volatile("" ::: "memory");
                  PU_DMA(src, fsl * 2); PU_DMA(src + 64, fsl * 2 + 1); }
            }
            const int sel = r & 3; const float d = sel == 0 ? acc[0] : sel == 1 ? acc[1] : sel == 2 ? acc[2] : acc[3];
            if (q == (r >> 2)) {
                const _Float16 wh = (_Float16)(gate * gelu_tanh(d * (1.f / U8_SCALE)));
                p.WPK[wo] = ((ent >> 12) << 3) | (((unsigned)__builtin_bit_cast(unsigned short, wh) << 16) & 0xFFFE0000u); }
            rp = rpn; ent = entn;
        }
        asm volatile("s_waitcnt vmcnt(0)" ::: "memory");
#undef PU_DMA
    }
}
DEV void ph_peer_v(const Params& p, int l, unsigned char* smem, int wg, int nwg) {
    const int tid = tid_opq(), lane = tid & 63, wave = tid >> 6;
    const unsigned char* V8l = p.V8 + (size_t)l * 16384 * 2048;
    for (int chunk = wg; chunk < 256; chunk += nwg) {
        const int cm = (chunk & 7) * 32 + (chunk >> 3);
        __syncthreads();
        { const float* Vl = p.peer_v + (size_t)l * 16384 * 2048 + cm * 8 + (tid & 1) * 4;
#pragma unroll 1
          for (int i0 = 0; i0 < 64; i0 += 32) { float4 va[32];
#pragma unroll
            for (int i = 0; i < 32; ++i) va[i] = *(const float4*)(Vl + (size_t)((i0 + i) * 256 + (tid >> 1)) * 2048);
#pragma unroll
            for (int i = 0; i < 32; ++i) { int w0 = 0;
                w0 = __builtin_amdgcn_cvt_pk_fp8_f32(va[i].x * V8_SCALE, va[i].y * V8_SCALE, w0, false); w0 = __builtin_amdgcn_cvt_pk_fp8_f32(va[i].z * V8_SCALE, va[i].w * V8_SCALE, w0, true);
                *(unsigned*)(smem + ((i0 + i) * 256 + (tid >> 1)) * 8 + (tid & 1) * 4) = (unsigned)w0; } } }
        __syncthreads();
        const int sub = lane & 3, tl = lane >> 2;
        const uint4* __restrict__ wpk = (const uint4*)p.WPK; const bf16_t* __restrict__ xb = p.XB; bf16_t* __restrict__ yo = (bf16_t*)p.Y;
        const float sv = 1.f / V8_SCALE;
#define PV_TOK(it_) ((((it_) * 128 + wave * 16 + (wg >> 3) * 16 + (wg & 7) * 1024) & (TT - 1)) + tl)
#define PV_LOAD(E, X0, tk_) do { _Pragma("unroll") for (int q_ = 0; q_ < 8; ++q_) E[q_] = wpk[(size_t)(tk_) * 32 + q_ * 4 + sub]; \
        X0 = *(const uint4*)(xb + (size_t)(tk_) * DM + cm * 8); } while (0)
#define PV_CVT(v_, hi_) __builtin_bit_cast(h2_t, __builtin_amdgcn_cvt_scalef32_pk_f16_fp8((int)(v_), 1.0f, hi_))
#define PV_ACC(vv, x_) do { const _Float16 wq_ = __builtin_bit_cast(_Float16, (unsigned short)((x_) >> 16)); const h2_t w_ = {wq_, wq_}; \
        a01 = __builtin_elementwise_fma(PV_CVT(vv.x, false), w_, a01); a23 = __builtin_elementwise_fma(PV_CVT(vv.x, true), w_, a23); \
        a45 = __builtin_elementwise_fma(PV_CVT(vv.y, false), w_, a45); a67 = __builtin_elementwise_fma(PV_CVT(vv.y, true), w_, a67); } while (0)
#define PV_RD(x_) (*(const uint2*)(smem + ((x_) & 0x1FFF8u)))
#define PV_ENT(E, i_) (((i_) & 3) == 0 ? E[(i_) >> 2].x : ((i_) & 3) == 1 ? E[(i_) >> 2].y : ((i_) & 3) == 2 ? E[(i_) >> 2].z : E[(i_) >> 2].w)
#define PV_RED(a_) do { unsigned u_ = __builtin_bit_cast(unsigned, a_); h2_t t_ = __builtin_bit_cast(h2_t, (unsigned)__builtin_amdgcn_update_dpp(0, (int)u_, 0xB1, 0xF, 0xF, false)); a_ = a_ + t_; \
        u_ = __builtin_bit_cast(unsigned, a_); t_ = __builtin_bit_cast(h2_t, (unsigned)__builtin_amdgcn_update_dpp(0, (int)u_, 0x4E, 0xF, 0xF, false)); a_ = a_ + t_; } while (0)
#define PV_STEP(E, R, EN, RN, X0, tk_) do { h2_t a01 = {(_Float16)0.f, (_Float16)0.f}, a23 = a01, a45 = a01, a67 = a01;     \
        uint2 T_[16]; \
        _Pragma("unroll") for (int i_ = 0; i_ < 16; ++i_) { T_[i_] = PV_RD(PV_ENT(E, 16 + i_)); PV_ACC(R[i_], PV_ENT(E, i_)); } \
        _Pragma("unroll") for (int i_ = 0; i_ < 16; ++i_) { RN[i_] = PV_RD(PV_ENT(EN, i_)); PV_ACC(T_[i_], PV_ENT(E, 16 + i_)); } \
        PV_RED(a01); PV_RED(a23); PV_RED(a45); PV_RED(a67);     \
        if (sub == 0) { const size_t o = (size_t)(tk_) * DM + cm * 8; \
            uint4 y_; y_.x = pack2(ALPHA * bflo(X0.x) + (float)a01.x * sv, ALPHA * bfhi(X0.x) + (float)a01.y * sv); y_.y = pack2(ALPHA * bflo(X0.y) + (float)a23.x * sv, ALPHA * bfhi(X0.y) + (float)a23.y * sv); \
            y_.z = pack2(ALPHA * bflo(X0.z) + (float)a45.x * sv, ALPHA * bfhi(X0.z) + (float)a45.y * sv); y_.w = pack2(ALPHA * bflo(X0.w) + (float)a67.x * sv, ALPHA * bfhi(X0.w) + (float)a67.y * sv); \
            *(uint4*)(yo + o) = y_; } } while (0)
        uint4 enA[8], enB[8], xA0, xB0; uint2 rA[16], rB[16];
        PV_LOAD(enA, xA0, PV_TOK(0));
#pragma unroll
        for (int i = 0; i < 16; ++i) rA[i] = PV_RD(PV_ENT(enA, i));
        for (int it = 0; it < TT / 128; it += 2) {
            const int tk0 = PV_TOK(it), tk1 = PV_TOK(it + 1), tk2 = PV_TOK(it + 2);
            PV_LOAD(enB, xB0, tk1);
            PV_STEP(enA, rA, enB, rB, xA0, tk0);
            PV_LOAD(enA, xA0, tk2);
            PV_STEP(enB, rB, enA, rA, xB0, tk1);
        }
#undef PV_ENT
#undef PV_STEP
#undef PV_CVT
#undef PV_RED
#undef PV_RD
#undef PV_ACC
#undef PV_LOAD
#undef PV_TOK
    }
}

DEV void ph_peer_v2(const Params& p, int l, unsigned char* smem, int wg, int nwg) {
    const int tid = tid_opq(), wave = tid >> 6, lane = tid & 63;
    const unsigned char* V8l = p.V8 + (size_t)l * 16384 * 2048;
    unsigned* sorted = (unsigned*)(smem + wave * 4096);
    int* hist = (int*)(smem + wave * 4096 + 2048);
    const float* lg = p.ln2_g + (size_t)l * DM; const float* lb = p.ln2_b + (size_t)l * DM;
    float* xo = (l == NL - 1) ? p.out : p.XF; bf16_t* xbo = (l == NL - 1) ? nullptr : p.XB;
    for (int unit = wg; unit < TT / 32; unit += nwg) {
        const int tokw = unit * 32 + wave * 4;
        {
            unsigned ent[8];
#pragma unroll
            for (int s = 0; s < 4; ++s) { ent[2 * s] = p.WPK[(size_t)(tokw + s) * 128 + lane]; ent[2 * s + 1] = p.WPK[(size_t)(tokw + s) * 128 + 64 + lane]; }
            hist[lane] = 0; hist[64 + lane] = 0;
            __builtin_amdgcn_s_waitcnt(0x0070);
#pragma unroll
            for (int i = 0; i < 8; ++i) atomicAdd(&hist[(ent[i] & 0x3FFFu) >> 7], 1);
            __builtin_amdgcn_s_waitcnt(0x0070);
            { int ln = lane; asm volatile("" : "+v"(ln));
              const int a = hist[2 * ln], b = hist[2 * ln + 1]; int s = a + b;
#pragma unroll
              for (int o = 1; o < 64; o <<= 1) { const int t2 = __builtin_amdgcn_ds_bpermute((ln - o) * 4, s); if (ln >= o) s += t2; }
              const int ex = s - (a + b); hist[2 * ln] = ex; hist[2 * ln + 1] = ex + a; }
            __builtin_amdgcn_s_waitcnt(0x0070);
#pragma unroll
            for (int i = 0; i < 8; ++i) { const unsigned e = ent[i] & 0x3FFFu; const int pos = atomicAdd(&hist[e >> 7], 1);
                sorted[pos] = (e << 18) | ((unsigned)(i >> 1) << 16) | (ent[i] >> 16); }
            __builtin_amdgcn_s_waitcnt(0x0070);
        }
        float s1[4] = {0.f, 0.f, 0.f, 0.f}, s2[4] = {0.f, 0.f, 0.f, 0.f};
#define PV2_ROW(e_, h_) (((const uint4*)(V8l + (size_t)(e_) * 2048))[(h_) * 64 + lane])
#define PV2_FMA(ACC, ra, w_) do { \
        ACC[0] += __builtin_amdgcn_cvt_pk_f32_fp8((int)ra.x, false) * w_; ACC[1] += __builtin_amdgcn_cvt_pk_f32_fp8((int)ra.x, true) * w_; \
        ACC[2] += __builtin_amdgcn_cvt_pk_f32_fp8((int)ra.y, false) * w_; ACC[3] += __builtin_amdgcn_cvt_pk_f32_fp8((int)ra.y, true) * w_; \
        ACC[4] += __builtin_amdgcn_cvt_pk_f32_fp8((int)ra.z, false) * w_; ACC[5] += __builtin_amdgcn_cvt_pk_f32_fp8((int)ra.z, true) * w_; \
        ACC[6] += __builtin_amdgcn_cvt_pk_f32_fp8((int)ra.w, false) * w_; ACC[7] += __builtin_amdgcn_cvt_pk_f32_fp8((int)ra.w, true) * w_; } while (0)
#define PV2_ACC(en_, ra) do { const float w_ = __uint_as_float((en_) << 16); const unsigned sl_ = ((en_) >> 16) & 3u; \
        if (sl_ == 0u) PV2_FMA(acc0, ra, w_); else if (sl_ == 1u) PV2_FMA(acc1, ra, w_); else if (sl_ == 2u) PV2_FMA(acc2, ra, w_); else PV2_FMA(acc3, ra, w_); } while (0)
#define PV2_ENT(j_) ((unsigned)__builtin_amdgcn_readfirstlane((int)sorted[(j_)]))
#define PV2_Y(ACC, s_, hf, y) do { const size_t ro = (size_t)(tokw + (s_)) * DM + (hf) * 1024 + lnE * 16; \
        _Pragma("unroll") for (int q_ = 0; q_ < 4; ++q_) { const float4 xv = *(const float4*)(p.XF + ro + q_ * 4); const f32x2_t c0 = ACC[q_ * 2], c1 = ACC[q_ * 2 + 1]; \
            y[q_ * 4 + 0] = ALPHA * xv.x + c0.x * (1.f / V8_SCALE); y[q_ * 4 + 1] = ALPHA * xv.y + c0.y * (1.f / V8_SCALE); \
            y[q_ * 4 + 2] = ALPHA * xv.z + c1.x * (1.f / V8_SCALE); y[q_ * 4 + 3] = ALPHA * xv.w + c1.y * (1.f / V8_SCALE); } \
        _Pragma("unroll") for (int i_ = 0; i_ < 16; ++i_) { s1[s_] += y[i_]; s2[s_] += y[i_] * y[i_]; } } while (0)
#define PV2_NORM(s_, hf, y, mu, rstd) do { const size_t ro = (size_t)(tokw + (s_)) * DM + (hf) * 1024 + lnE * 16; \
        _Pragma("unroll") for (int q_ = 0; q_ < 4; ++q_) { const int c_ = (hf) * 1024 + lnE * 16 + q_ * 4; const float4 g4 = *(const float4*)(lg + c_), b4 = *(const float4*)(lb + c_); float4 o; \
            o.x = (y[q_ * 4 + 0] - mu) * rstd * g4.x + b4.x; o.y = (y[q_ * 4 + 1] - mu) * rstd * g4.y + b4.y; o.z = (y[q_ * 4 + 2] - mu) * rstd * g4.z + b4.z; o.w = (y[q_ * 4 + 3] - mu) * rstd * g4.w + b4.w; \
            *(float4*)(xo + ro + q_ * 4) = o; \
            if (xbo) { uint2 w2; w2.x = pack2(o.x, o.y); w2.y = pack2(o.z, o.w); *(uint2*)(xbo + ro + q_ * 4) = w2; } } } while (0)
#pragma unroll 1
        for (int hf = 0; hf < 2; ++hf) {
            f32x2_t acc0[8], acc1[8], acc2[8], acc3[8];
#pragma unroll
            for (int i = 0; i < 8; ++i) { acc0[i] = (f32x2_t){0.f, 0.f}; acc1[i] = acc0[i]; acc2[i] = acc0[i]; acc3[i] = acc0[i]; }
            unsigned e0 = PV2_ENT(0), e1 = PV2_ENT(1), e2 = PV2_ENT(2), e3 = PV2_ENT(3), e4 = PV2_ENT(4), e5 = PV2_ENT(5), e6 = PV2_ENT(6), e7 = PV2_ENT(7);
            uint4 a0 = PV2_ROW(e0 >> 18, hf), a1 = PV2_ROW(e1 >> 18, hf), a2 = PV2_ROW(e2 >> 18, hf), a3 = PV2_ROW(e3 >> 18, hf);
            uint4 a4 = PV2_ROW(e4 >> 18, hf), a5 = PV2_ROW(e5 >> 18, hf), a6 = PV2_ROW(e6 >> 18, hf), a7 = PV2_ROW(e7 >> 18, hf);
            for (int j = 0; j < 512; j += 8) {
#define PV2_STEP(ek, ak, dj) do { const int jn = j + 8 + (dj) < 512 ? j + 8 + (dj) : 511; const unsigned en = PV2_ENT(jn); const uint4 an = PV2_ROW(en >> 18, hf); \
                PV2_ACC(ek, ak); ek = (j + 8 + (dj) < 512) ? en : (en & 0xFFFF0000u); ak = an; } while (0)
                PV2_STEP(e0, a0, 0); PV2_STEP(e1, a1, 1); PV2_STEP(e2, a2, 2); PV2_STEP(e3, a3, 3);
                PV2_STEP(e4, a4, 4); PV2_STEP(e5, a5, 5); PV2_STEP(e6, a6, 6); PV2_STEP(e7, a7, 7);
#undef PV2_STEP
            }
            int lnE = lane; asm volatile("" : "+v"(lnE));
            if (hf == 0) {
                float y[16];
                PV2_Y(acc0, 0, 0, y); { float* d = p.Y + (size_t)(tokw + 0) * DM + lnE * 16; _Pragma("unroll") for (int q_ = 0; q_ < 4; ++q_) *(float4*)(d + q_ * 4) = make_float4(y[q_ * 4], y[q_ * 4 + 1], y[q_ * 4 + 2], y[q_ * 4 + 3]); }
                asm volatile("" ::: "memory"); PV2_Y(acc1, 1, 0, y); { float* d = p.Y + (size_t)(tokw + 1) * DM + lnE * 16; _Pragma("unroll") for (int q_ = 0; q_ < 4; ++q_) *(float4*)(d + q_ * 4) = make_float4(y[q_ * 4], y[q_ * 4 + 1], y[q_ * 4 + 2], y[q_ * 4 + 3]); }
                asm volatile("" ::: "memory"); PV2_Y(acc2, 2, 0, y); { float* d = p.Y + (size_t)(tokw + 2) * DM + lnE * 16; _Pragma("unroll") for (int q_ = 0; q_ < 4; ++q_) *(float4*)(d + q_ * 4) = make_float4(y[q_ * 4], y[q_ * 4 + 1], y[q_ * 4 + 2], y[q_ * 4 + 3]); }
                asm volatile("" ::: "memory"); PV2_Y(acc3, 3, 0, y); { float* d = p.Y + (size_t)(tokw + 3) * DM + lnE * 16; _Pragma("unroll") for (int q_ = 0; q_ < 4; ++q_) *(float4*)(d + q_ * 4) = make_float4(y[q_ * 4], y[q_ * 4 + 1], y[q_ * 4 + 2], y[q_ * 4 + 3]); }
            } else {
#define PV2_FIN(ACC, s_) do { float y[16]; PV2_Y(ACC, s_, 1, y); \
                const float m1 = wave_sum(s1[s_]) * (1.f / 2048.f), m2 = wave_sum(s2[s_]) * (1.f / 2048.f); const float rstd = rsqrtf(fmaxf(m2 - m1 * m1, 0.f) + 1e-5f); \
                asm volatile("" ::: "memory"); PV2_NORM(s_, 1, y, m1, rstd); asm volatile("" ::: "memory"); \
                { const float* d = p.Y + (size_t)(tokw + (s_)) * DM + lnE * 16; _Pragma("unroll") for (int q_ = 0; q_ < 4; ++q_) { const float4 t = *(const float4*)(d + q_ * 4); y[q_ * 4] = t.x; y[q_ * 4 + 1] = t.y; y[q_ * 4 + 2] = t.z; y[q_ * 4 + 3] = t.w; } } \
                asm volatile("" ::: "memory"); PV2_NORM(s_, 0, y, m1, rstd); } while (0)
                PV2_FIN(acc0, 0); asm volatile("" ::: "memory"); PV2_FIN(acc1, 1); asm volatile("" ::: "memory"); PV2_FIN(acc2, 2); asm volatile("" ::: "memory"); PV2_FIN(acc3, 3);
#undef PV2_FIN
            }
        }
#undef PV2_NORM
#undef PV2_Y
#undef PV2_ENT
#undef PV2_ACC
#undef PV2_FMA
#undef PV2_ROW
    }
}

namespace ps {
typedef float f32x16 __attribute__((ext_vector_type(16)));
DEV unsigned f2key(float v) { const unsigned b = __float_as_uint(v); return (b & 0x80000000u) ? ~b : (b | 0x80000000u); }
DEV float key2f(unsigned k) { k &= ~0xFFu; const unsigned b = (k & 0x80000000u) ? (k & 0x7fffffffu) : ~k; return __uint_as_float(b); }
#define PS_CE(a_, b_) do { const unsigned x_ = (a_), y_ = (b_); (a_) = x_ > y_ ? x_ : y_; (b_) = x_ > y_ ? y_ : x_; } while (0)
template <int N> DEV void bitonic_sort_desc(unsigned (&k)[N]) {
#pragma unroll
    for (int sz = 2; sz <= N; sz <<= 1)
#pragma unroll
        for (int j = sz >> 1; j > 0; j >>= 1)
#pragma unroll
            for (int i = 0; i < N; ++i) { const int l = i ^ j; if (l > i) { if ((i & sz) == 0) PS_CE(k[i], k[l]); else PS_CE(k[l], k[i]); } }
}
template <int N> DEV void bitonic_merge_desc(unsigned (&k)[N]) {
#pragma unroll
    for (int j = N >> 1; j > 0; j >>= 1)
#pragma unroll
        for (int i = 0; i < N; ++i) { const int l = i ^ j; if (l > i) PS_CE(k[i], k[l]); }
}
DEV void top16_of_64(const unsigned (&k)[64], unsigned (&out)[16]) {
    unsigned a[16], b[16], c[16], d[16];
#pragma unroll
    for (int i = 0; i < 16; ++i) { a[i] = k[i]; b[i] = k[16 + i]; c[i] = k[32 + i]; d[i] = k[48 + i]; }
    bitonic_sort_desc<16>(a); bitonic_sort_desc<16>(b); bitonic_sort_desc<16>(c); bitonic_sort_desc<16>(d);
#pragma unroll
    for (int i = 0; i < 16; ++i) { a[i] = a[i] > b[15 - i] ? a[i] : b[15 - i]; c[i] = c[i] > d[15 - i] ? c[i] : d[15 - i]; }
    bitonic_merge_desc<16>(a); bitonic_merge_desc<16>(c);
#pragma unroll
    for (int i = 0; i < 16; ++i) out[i] = a[i] > c[15 - i] ? a[i] : c[15 - i];
    bitonic_merge_desc<16>(out);
}
typedef short bf16x8 __attribute__((ext_vector_type(8)));
typedef unsigned u32x4 __attribute__((ext_vector_type(4)));
DEV unsigned split_hi2(float a, float b, float& ra, float& rb) {
    const unsigned ha = f2bf(a), hb = f2bf(b); ra = a - __uint_as_float(ha << 16); rb = b - __uint_as_float(hb << 16); return ha | (hb << 16);
}
DEV void half_top16(const float* __restrict__ qrow  , const unsigned char* __restrict__ tabh  ,
                    int r32, int hi, unsigned (&top)[16]) {
    bf16x8 qh[8], ql[8];
#pragma unroll
    for (int s8 = 0; s8 < 8; ++s8) { const float4 a = *(const float4*)(qrow + s8 * 16 + hi * 8), b = *(const float4*)(qrow + s8 * 16 + hi * 8 + 4);
        float r0, r1, r2, r3, r4, r5, r6, r7, d0, d1;
        u32x4 h, l;
        h.x = split_hi2(a.x, a.y, r0, r1); h.y = split_hi2(a.z, a.w, r2, r3); h.z = split_hi2(b.x, b.y, r4, r5); h.w = split_hi2(b.z, b.w, r6, r7);
        l.x = split_hi2(r0, r1, d0, d1); l.y = split_hi2(r2, r3, d0, d1); l.z = split_hi2(r4, r5, d0, d1); l.w = split_hi2(r6, r7, d0, d1);
        qh[s8] = *reinterpret_cast<bf16x8*>(&h); ql[s8] = *reinterpret_cast<bf16x8*>(&l); }
    f32x16 a0 = {}, a1 = {}, a2 = {}, a3 = {};
    const unsigned char* ah = tabh + r32 * 272 + hi * 16;
    const unsigned char* al = ah + 128 * 272;
#pragma unroll
    for (int s8 = 0; s8 < 8; ++s8) {
#define PS_MM(ACC, NT) do { const bf16x8 xh = *(const bf16x8*)(ah + (NT) * 8704 + s8 * 32), xl = *(const bf16x8*)(al + (NT) * 8704 + s8 * 32); \
        ACC = __builtin_amdgcn_mfma_f32_32x32x16_bf16(xh, qh[s8], ACC, 0, 0, 0); ACC = __builtin_amdgcn_mfma_f32_32x32x16_bf16(xh, ql[s8], ACC, 0, 0, 0); \
        ACC = __builtin_amdgcn_mfma_f32_32x32x16_bf16(xl, qh[s8], ACC, 0, 0, 0); } while (0)
        PS_MM(a0, 0); PS_MM(a1, 1); PS_MM(a2, 2); PS_MM(a3, 3);
#undef PS_MM
    }
    unsigned k[64];
#pragma unroll
    for (int i = 0; i < 16; ++i) {
        k[i] = (f2key(a0[i]) & ~0xFFu) | (unsigned)(((0 * 16 + i) << 1) | hi);  k[16 + i] = (f2key(a1[i]) & ~0xFFu) | (unsigned)(((1 * 16 + i) << 1) | hi);
        k[32 + i] = (f2key(a2[i]) & ~0xFFu) | (unsigned)(((2 * 16 + i) << 1) | hi); k[48 + i] = (f2key(a3[i]) & ~0xFFu) | (unsigned)(((3 * 16 + i) << 1) | hi); }
    unsigned t16[16];
    top16_of_64(k, t16);
    unsigned m[16];
#pragma unroll
    for (int i = 0; i < 16; ++i) { const unsigned o = (unsigned)__shfl_xor((int)t16[15 - i], 32); m[i] = t16[i] > o ? t16[i] : o; }
    bitonic_merge_desc<16>(m);
#pragma unroll
    for (int i = 0; i < 16; ++i) top[i] = m[i];
}
DEV int key_n(unsigned k) { const int idx = (int)(k & 0x7Fu), hi = idx & 1, loc = idx >> 1, nt = loc >> 4, ii = loc & 15; return (nt << 5) | ((ii >> 2) << 3) | (hi << 2) | (ii & 3); }
}

DEV void ph_peer_select2(const Params& p, int l, unsigned char* smem, int wg, int nwg, int only_unit = -1) {
    using namespace ps;
    const int tid = tid_opq(), lane = tid & 63, wave = __builtin_amdgcn_readfirstlane(tid >> 6), r32 = lane & 31, hi = lane >> 5;
    int* tab = (int*)(smem + 69632) + wave * 2048;
    for (int unit = (only_unit >= 0 ? only_unit : wg); unit < (only_unit >= 0 ? only_unit + 1 : 8 * (TT / 256)); unit += nwg) {
        const int h = unit & 7, tok = (unit >> 3) * 256 + wave * 32 + r32;
        const float* qb = p.Q2 + (size_t)tok * DM + h * 256;
        const float* skb = p.subkeys + (((size_t)l * 8 + h) * 2) * 16384;
        unsigned t1[16], t2[16];
#pragma unroll 1
        for (int part = 0; part < 2; ++part) {
            __syncthreads();
#pragma unroll
            for (int i = 0; i < 8; ++i) { const int f4 = i * 512 + tid, row = f4 >> 5, c4 = f4 & 31;
                const float4 v = ((const float4*)(skb + (size_t)part * 16384))[f4]; float r0, r1, r2, r3, d0, d1; uint2 hw, lw;
                hw.x = split_hi2(v.x, v.y, r0, r1); hw.y = split_hi2(v.z, v.w, r2, r3); lw.x = split_hi2(r0, r1, d0, d1); lw.y = split_hi2(r2, r3, d0, d1);
                *(uint2*)(smem + row * 272 + c4 * 8) = hw; *(uint2*)(smem + 128 * 272 + row * 272 + c4 * 8) = lw; }
            __syncthreads();
            if (part == 0) half_top16(qb, smem, r32, hi, t1); else half_top16(qb + 128, smem, r32, hi, t2);
        }
        float s1[16], s2[16];
#pragma unroll
        for (int i = 0; i < 16; ++i) { s1[i] = key2f(t1[i]); s2[i] = key2f(t2[i]); tab[i * 64 + lane] = key_n(t1[i]); tab[(16 + i) * 64 + lane] = key_n(t2[i]); }
        unsigned ck[64];
        ck[0] = (f2key(s1[0] + s2[0]) & ~0xFFu) | 0u;
        ck[1] = (f2key(s1[0] + s2[1]) & ~0xFFu) | 1u;
        ck[2] = (f2key(s1[0] + s2[2]) & ~0xFFu) | 2u;
        ck[3] = (f2key(s1[0] + s2[3]) & ~0xFFu) | 3u;
        ck[4] = (f2key(s1[0] + s2[4]) & ~0xFFu) | 4u;
        ck[5] = (f2key(s1[0] + s2[5]) & ~0xFFu) | 5u;
        ck[6] = (f2key(s1[0] + s2[6]) & ~0xFFu) | 6u;
        ck[7] = (f2key(s1[0] + s2[7]) & ~0xFFu) | 7u;
        ck[8] = (f2key(s1[0] + s2[8]) & ~0xFFu) | 8u;
        ck[9] = (f2key(s1[0] + s2[9]) & ~0xFFu) | 9u;
        ck[10] = (f2key(s1[0] + s2[10]) & ~0xFFu) | 10u;
        ck[11] = (f2key(s1[0] + s2[11]) & ~0xFFu) | 11u;
        ck[12] = (f2key(s1[0] + s2[12]) & ~0xFFu) | 12u;
        ck[13] = (f2key(s1[0] + s2[13]) & ~0xFFu) | 13u;
        ck[14] = (f2key(s1[0] + s2[14]) & ~0xFFu) | 14u;
        ck[15] = (f2key(s1[0] + s2[15]) & ~0xFFu) | 15u;
        ck[16] = (f2key(s1[1] + s2[0]) & ~0xFFu) | 16u;
        ck[17] = (f2key(s1[1] + s2[1]) & ~0xFFu) | 17u;
        ck[18] = (f2key(s1[1] + s2[2]) & ~0xFFu) | 18u;
        ck[19] = (f2key(s1[1] + s2[3]) & ~0xFFu) | 19u;
        ck[20] = (f2key(s1[1] + s2[4]) & ~0xFFu) | 20u;
        ck[21] = (f2key(s1[1] + s2[5]) & ~0xFFu) | 21u;
        ck[22] = (f2key(s1[1] + s2[6]) & ~0xFFu) | 22u;
        ck[23] = (f2key(s1[1] + s2[7]) & ~0xFFu) | 23u;
        ck[24] = (f2key(s1[2] + s2[0]) & ~0xFFu) | 32u;
        ck[25] = (f2key(s1[2] + s2[1]) & ~0xFFu) | 33u;
        ck[26] = (f2key(s1[2] + s2[2]) & ~0xFFu) | 34u;
        ck[27] = (f2key(s1[2] + s2[3]) & ~0xFFu) | 35u;
        ck[28] = (f2key(s1[2] + s2[4]) & ~0xFFu) | 36u;
        ck[29] = (f2key(s1[3] + s2[0]) & ~0xFFu) | 48u;
        ck[30] = (f2key(s1[3] + s2[1]) & ~0xFFu) | 49u;
        ck[31] = (f2key(s1[3] + s2[2]) & ~0xFFu) | 50u;
        ck[32] = (f2key(s1[3] + s2[3]) & ~0xFFu) | 51u;
        ck[33] = (f2key(s1[4] + s2[0]) & ~0xFFu) | 64u;
        ck[34] = (f2key(s1[4] + s2[1]) & ~0xFFu) | 65u;
        ck[35] = (f2key(s1[4] + s2[2]) & ~0xFFu) | 66u;
        ck[36] = (f2key(s1[5] + s2[0]) & ~0xFFu) | 80u;
        ck[37] = (f2key(s1[5] + s2[1]) & ~0xFFu) | 81u;
        ck[38] = (f2key(s1[6] + s2[0]) & ~0xFFu) | 96u;
        ck[39] = (f2key(s1[6] + s2[1]) & ~0xFFu) | 97u;
        ck[40] = (f2key(s1[7] + s2[0]) & ~0xFFu) | 112u;
        ck[41] = (f2key(s1[7] + s2[1]) & ~0xFFu) | 113u;
        ck[42] = (f2key(s1[8] + s2[0]) & ~0xFFu) | 128u;
        ck[43] = (f2key(s1[9] + s2[0]) & ~0xFFu) | 144u;
        ck[44] = (f2key(s1[10] + s2[0]) & ~0xFFu) | 160u;
        ck[45] = (f2key(s1[11] + s2[0]) & ~0xFFu) | 176u;
        ck[46] = (f2key(s1[12] + s2[0]) & ~0xFFu) | 192u;
        ck[47] = (f2key(s1[13] + s2[0]) & ~0xFFu) | 208u;
        ck[48] = (f2key(s1[14] + s2[0]) & ~0xFFu) | 224u;
        ck[49] = (f2key(s1[15] + s2[0]) & ~0xFFu) | 240u;
        ck[50] = 0u;
        ck[51] = 0u;
        ck[52] = 0u;
        ck[53] = 0u;
        ck[54] = 0u;
        ck[55] = 0u;
        ck[56] = 0u;
        ck[57] = 0u;
        ck[58] = 0u;
        ck[59] = 0u;
        ck[60] = 0u;
        ck[61] = 0u;
        ck[62] = 0u;
        ck[63] = 0u;
        unsigned ct[16];
        top16_of_64(ck, ct);
        float e[16], sum = 0.f; const float mx = key2f(ct[0]);
#pragma unroll
        for (int k = 0; k < 16; ++k) { e[k] = __expf(key2f(ct[k]) - mx); sum += e[k]; }
        const float inv = 1.f / sum;
        int ei[8]; float gi[8];
#pragma unroll
        for (int k = 0; k < 8; ++k) { unsigned ca = ct[k], cb = ct[k + 8]; float ea = e[k], eb = e[k + 8];
            asm volatile("" : "+v"(ca), "+v"(cb), "+v"(ea), "+v"(eb));
            const unsigned c = hi ? cb : ca; const int ci = (int)(c >> 4) & 15, cj = (int)c & 15;
            ei[k] = tab[ci * 64 + lane] * 128 + tab[(16 + cj) * 64 + lane]; gi[k] = (hi ? eb : ea) * inv; }
        const size_t o = (size_t)tok * 128 + h * 16 + hi * 8;
        *(int4*)(p.EIDX + o) = make_int4(ei[0], ei[1], ei[2], ei[3]); *(int4*)(p.EIDX + o + 4) = make_int4(ei[4], ei[5], ei[6], ei[7]);
        *(float4*)(p.GATE + o) = make_float4(gi[0], gi[1], gi[2], gi[3]); *(float4*)(p.GATE + o + 4) = make_float4(gi[4], gi[5], gi[6], gi[7]);
    }
}

enum { PH_PRO = 0, PH_GEMM_IN, PH_ROPE, PH_ATTN_A, PH_ATTN_B, PH_AFIN, PH_GEMM_OUT, PH_LN1, PH_GEMM_Q, PH_PSEL, PH_PU, PH_PV, PH_LN2, PH_COUNT };

#ifndef PROBE_REP
#define PROBE_REP 0
#endif
template <int PH>
DEV void run_phase(const Params& p, int l, unsigned char* smem, int wg, int nwg, int rep = 0) {
    float* lds = (float*)smem;
    const float* xin = l == 0 ? p.x : p.XF;
    if constexpr (PH == PH_PRO) {
        for (int ll = 0; ll < NL; ++ll) {
            ph_transpose<1>(p.w_in + (size_t)ll * DM * INW, p.WINT + (size_t)ll * PW * DM, INW, PW, lds, wg, nwg);
            ph_transpose<0>(p.w_out + (size_t)ll * DM * DM, p.WOUTT + (size_t)ll * DM * DM, DM, DM, lds, wg, nwg);
            ph_transpose<0>(p.peer_wq + (size_t)ll * DM * DM, p.WQT + (size_t)ll * DM * DM, DM, DM, lds, wg, nwg);
        }
        ph_cvt8(p.peer_u, p.U8, (size_t)NL * 16384 * 2048, U8_SCALE, wg, nwg);
        ph_cvt(p.x, p.XB, (size_t)TT * DM, wg, nwg);
        ph_ropetab(p.ROPE, wg, nwg);
        ph_cmp_bias(p, lds, wg, nwg);
        for (int lk = 0; lk < NL * 2; ++lk) {
            ph_transpose<0, 4096>(p.cmp_w1 + (size_t)lk * 4096 * 256, p.W1T + (size_t)lk * 256 * 4096, 256, 256, lds, wg, nwg);
            ph_transpose<0, 256>(p.cmp_w2 + (size_t)lk * 256 * 128, p.W2T + (size_t)lk * 128 * 256, 128, 128, lds, wg, nwg);
        }
    }
    else if constexpr (PH == PH_GEMM_IN) ph_gemm_in(p, l, smem, wg, nwg);
    else if constexpr (PH == PH_ROPE) ph_rope(p.P, p.ROPE, wg, nwg);
    else if constexpr (PH == PH_ATTN_A) {
        unsigned* ctrs = p.bar + 4096 + ((l * 4 + 0 + 2 * rep) * 8) * 64;
        unsigned* cflag = p.bar + 14336 + (l * 2) * 64;
        int xq = (int)(xb_xcc_id() & 7u), tries = 0;
        for (;;) { const int i = next_unit_x(ctrs, 164, xq, tries, (char*)smem); if (i < 0) break;
            if (i < 4) { const int unit = xq * 4 + i; compress_unit_mfma(p, l, unit, (char*)smem);
                asm volatile("s_waitcnt vmcnt(0)" ::: "memory"); __syncthreads();
                if (tid_opq() == 0) { __builtin_amdgcn_fence(__ATOMIC_RELEASE, "agent"); asm volatile("s_waitcnt vmcnt(0)" ::: "memory"); (void)xb_add(cflag + ((unit >> 3) & 1) * 64, 1u); } }
            else if (i < 20) stick_unit_mfma(p, ((i - 4) << 3) | xq, (char*)smem);
            else if (i < 32) { const int j = i - 20; diff_unit2(p, ((j >> 1) << 4) | (xq << 1) | (j & 1), (char*)smem); }
            else if (i < 48) dil_unit_mfma(p, xq * 48 + (i - 32), (char*)smem);
            else if (i < 80) {
                if (tid_opq() == 0) { unsigned* f = cflag + (xq >> 2) * 64; XB_SPIN(xb_ld(f) < 16u, p.bar); __builtin_amdgcn_fence(__ATOMIC_ACQUIRE, "agent"); asm volatile("s_waitcnt vmcnt(0)" ::: "memory"); }
                __syncthreads();
                nsa_unit2(p, l, (xq >> 2) * 128 + 127 - (4 * (i - 48) + (xq & 3)), (char*)smem); }
            else if (i < 116) { const int j = i - 80 + 12; diff_unit2(p, ((j >> 1) << 4) | (xq << 1) | (j & 1), (char*)smem); }
            else if (i < 148) dil_unit_mfma(p, xq * 48 + 16 + (i - 116), (char*)smem);
            else { const int j = i - 148 + 48; diff_unit2(p, ((j >> 1) << 4) | (xq << 1) | (j & 1), (char*)smem); } }
    }
    else if constexpr (PH == PH_ATTN_B) { }
    else if constexpr (PH == PH_AFIN) ph_attn_final(p, l, wg, nwg);
    else if constexpr (PH == PH_GEMM_OUT) ph_gemm_out(p, l, xin, smem, wg, nwg, ((PROBE_REP >> 1) & 1) ? l * 2 + rep + 1 : l + 1);
    else if constexpr (PH == PH_LN1) ph_ln<false>(p.Y, p.ln1_g + (size_t)l * DM, p.ln1_b + (size_t)l * DM, p.XF, p.XB, wg, nwg);
    else if constexpr (PH == PH_GEMM_Q) {
        ph_gemm_q(p, l, smem, wg, nwg);
        if (nwg == 256) { pg8::StaticOrder S; S.init(TT, DM, nwg, wg); pg8::Unit u; (void)S.next(0, u);
            asm volatile("s_waitcnt vmcnt(0)" ::: "memory"); __syncthreads();
            ph_peer_select2(p, l, smem, wg, nwg, u.pm * 8 + u.pn); }
    }
    else if constexpr (PH == PH_PSEL) { if (nwg != 256) ph_peer_select2(p, l, smem, wg, nwg); }
    else if constexpr (PH == PH_PU) ph_peer_u(p, l, smem, wg, nwg);
    else if constexpr (PH == PH_PV) ph_peer_v(p, l, smem, wg, nwg);
    else if constexpr (PH == PH_LN2) ph_ln_bf((const bf16_t*)p.Y, p.ln2_g + (size_t)l * DM, p.ln2_b + (size_t)l * DM, l == NL - 1 ? p.out : (nwg != 256 ? p.XF : nullptr), l == NL - 1 ? nullptr : p.XB, wg, nwg);
}

__global__ __launch_bounds__(512, 2) void k_mega(Params p) {
    extern __shared__ __attribute__((aligned(16))) unsigned char smem[];
    const int wg = (int)blockIdx.x, nwg = (int)gridDim.x;
    uint4* xbw = (uint4*)(smem + LDS_BYTES - 16);
    if (threadIdx.x == 0) *xbw = make_uint4(0u, 0u, 0u, 0u);
    __syncthreads();
    XcdBarrier bar = xcd_barrier_post(p.bar, (volatile LAS unsigned*)xbw);
#define RUN(PH, bit, l_) do { for (int rep_ = 0; rep_ < (((PROBE_REP) >> (bit)) & 1) + 1; ++rep_) { run_phase<PH>(p, l_, smem, wg, nwg, rep_); xcd_barrier(bar); } } while (0)
    RUN(PH_PRO, 0, 0);
    for (int l = 0; l < NL; ++l) {
        RUN(PH_GEMM_IN, 1, l);
        RUN(PH_ATTN_A, 2, l);
        RUN(PH_AFIN, 4, l);
        RUN(PH_GEMM_OUT, 1, l);
        if (nwg != 256) RUN(PH_LN1, 5, l);
        RUN(PH_GEMM_Q, 1, l);
        if (nwg != 256) RUN(PH_PSEL, 6, l);
        RUN(PH_PU, 7, l);
        RUN(PH_PV, 8, l);
        RUN(PH_LN2, 5, l);
    }
#undef RUN
}

static size_t carve(size_t& off, size_t bytes) { const size_t o = off; off = (off + bytes + 255) & ~(size_t)255; return o; }

extern "C" void kernel_launch(void* const* d_in, const int* in_sizes, int n_in, void* d_out, int out_size, void* d_ws, size_t ws_size, hipStream_t stream) {
    (void)in_sizes; (void)n_in; (void)out_size; (void)ws_size;
    Params p{};
    p.x = (const float*)d_in[0]; p.w_in = (const float*)d_in[1]; p.w_out = (const float*)d_in[2]; p.cmp_pe = (const float*)d_in[3]; p.cmp_w1 = (const float*)d_in[4];
    p.cmp_w2 = (const float*)d_in[5]; p.diff_lambda = (const float*)d_in[6]; p.diff_g = (const float*)d_in[7]; p.ln1_g = (const float*)d_in[8]; p.ln1_b = (const float*)d_in[9];
    p.peer_wq = (const float*)d_in[10]; p.subkeys = (const float*)d_in[11]; p.peer_u = (const float*)d_in[12]; p.peer_v = (const float*)d_in[13]; p.ln2_g = (const float*)d_in[14]; p.ln2_b = (const float*)d_in[15];
    p.out = (float*)d_out;
    char* ws = (char*)d_ws; size_t off = 0;
    p.bar = (unsigned*)(ws + carve(off, 65536));
    p.XF = (float*)(ws + carve(off, (size_t)TT * DM * 4)); p.Y = (float*)(ws + carve(off, (size_t)TT * DM * 4));
    p.Q2 = (float*)(ws + carve(off, (size_t)TT * DM * 4)); p.OACC = (float*)(ws + carve(off, (size_t)TT * DM * 4));
    p.KC = (float*)(ws + carve(off, (size_t)NB * 256 * 128 * 4)); p.VC = (float*)(ws + carve(off, (size_t)NB * 256 * 128 * 4));
    p.ROPE = (float*)(ws + carve(off, (size_t)SEQ * 48 * 4)); p.SKT = (float*)(ws + carve(off, (size_t)NL * 16 * 16384 * 4));
    p.GATE = (float*)(ws + carve(off, (size_t)TT * 128 * 4)); p.EIDX = (int*)(ws + carve(off, (size_t)TT * 128 * 4)); p.SEL = (u64*)(ws + carve(off, (size_t)TT * 8));
    p.XB = (bf16_t*)(ws + carve(off, (size_t)TT * DM * 2)); p.OCAT = (bf16_t*)(ws + carve(off, (size_t)TT * DM * 2)); p.P = (bf16_t*)(ws + carve(off, (size_t)TT * PW * 2));
    p.WINT = (bf16_t*)(ws + carve(off, (size_t)NL * PW * DM * 2)); p.WOUTT = (bf16_t*)(ws + carve(off, (size_t)NL * DM * DM * 2)); p.WQT = (bf16_t*)(ws + carve(off, (size_t)NL * DM * DM * 2));
    p.U8 = (unsigned char*)(ws + carve(off, (size_t)NL * 16384 * 2048)); p.V8 = (unsigned char*)(ws + carve(off, (size_t)NL * 16384 * 2048)); p.WPK = (unsigned*)(ws + carve(off, (size_t)TT * 128 * 4));
    p.KCB = (bf16_t*)(ws + carve(off, (size_t)NB * 256 * 128 * 2)); p.VCB = (bf16_t*)(ws + carve(off, (size_t)NB * 256 * 128 * 2));
    p.W1T = (bf16_t*)(ws + carve(off, (size_t)NL * 2 * 256 * 4096 * 2)); p.W2T = (bf16_t*)(ws + carve(off, (size_t)NL * 2 * 128 * 256 * 2)); p.CB = (float*)(ws + carve(off, (size_t)NL * 2 * 8 * 256 * 4));
    p.NSAO = (float*)(ws + carve(off, (size_t)3 * TT * 512 * 4));
    p.LNX = (u64*)(ws + carve(off, (size_t)TT * 8 * 8));
    p.DILO = (float*)(ws + carve(off, (size_t)3 * TT * 512 * 4)); p.DILL = (float*)(ws + carve(off, (size_t)3 * TT * 4 * 4)); p.DIFO = (float*)(ws + carve(off, (size_t)2 * TT * 512 * 4));
    static int grid = 0;
    if (!grid) {
        int dev = 0, cus = 0, per_cu = 0;
        (void)hipGetDevice(&dev);
        (void)hipDeviceGetAttribute(&cus, hipDeviceAttributeMultiprocessorCount, dev);
        (void)hipFuncSetAttribute((const void*)k_mega, hipFuncAttributeMaxDynamicSharedMemorySize, LDS_BYTES);
        (void)hipOccupancyMaxActiveBlocksPerMultiprocessor(&per_cu, (const void*)k_mega, 512, LDS_BYTES);
        grid = cus * (per_cu < 1 ? per_cu : 1);
        if (grid <= 0) grid = cus > 0 ? cus : 256;
    }
    (void)hipMemsetAsync(p.bar, 0, 65536, stream);
    k_mega<<<dim3(grid), dim3(512), LDS_BYTES, stream>>>(p);
}
```

```cpp
#include <hip/hip_runtime.h>
#include <stdint.h>
#include <stdio.h>

typedef unsigned short bf16_t;
typedef unsigned long long u64;
#define DEV __device__ __forceinline__

constexpr int NB = 2, SEQ = 4096, TT = NB * SEQ, DM = 2048, PW = 6144, NL = 4, INW = 5900;
constexpr int C_AQ = 0, C_AKC = 512, C_AVC = 640, C_AKS = 768, C_AVS = 896, C_AKW = 1024, C_AVW = 1152,
              C_BQ = 1280, C_BK = 1792, C_BV = 2304, C_CQ = 2816, C_CK = 3328, C_CV = 3840,
              C_DQ = 4352, C_DK = 4864, C_DV = 5376, C_AG = 5888;
constexpr float ALPHA = 1.681792830507429f;
constexpr int LDS_BYTES = 158 * 1024, LDS_FLAGS_OFF = LDS_BYTES - 256, LDS_SLOT_OFF = LDS_BYTES - 64;
constexpr float NEG_INF = -__builtin_inff();

struct Params {
    const float *x, *w_in, *w_out, *cmp_pe, *cmp_w1, *cmp_w2, *diff_lambda, *diff_g, *ln1_g, *ln1_b,
                *peer_wq, *subkeys, *peer_u, *peer_v, *ln2_g, *ln2_b;
    float* out;
    unsigned* bar;
    float *XF, *Y, *Q2, *OACC, *KC, *VC, *ROPE, *SKT, *GATE;
    bf16_t *XB, *P, *OCAT, *WINT, *WOUTT, *WQT, *UB, *VB;
    int* EIDX;
    u64* SEL;
    u64* LNX;
    bf16_t *KCB, *VCB;
    float *DILO, *DILL, *DIFO;
    unsigned char *U8, *V8;
    unsigned* WPK;
    bf16_t *W1T, *W2T;
    float* CB;
    float* NSAO;
};

DEV float bf2f(bf16_t b) { return __uint_as_float(((unsigned)b) << 16); }
DEV float bflo(unsigned w) { return __uint_as_float(w << 16); }
DEV float bfhi(unsigned w) { return __uint_as_float(w & 0xffff0000u); }
DEV bf16_t f2bf(float f) { unsigned u = __float_as_uint(f); u += 0x7FFFu + ((u >> 16) & 1u); return (bf16_t)(u >> 16); }
DEV unsigned pack2(float a, float b) { unsigned r; asm("v_cvt_pk_bf16_f32 %0, %1, %2" : "=v"(r) : "v"(a), "v"(b)); return r; }
DEV float wave_sum(float v) {
#pragma unroll
    for (int o = 32; o > 0; o >>= 1) v += __shfl_xor(v, o);
    return v;
}
DEV float wave_max(float v) {
#pragma unroll
    for (int o = 32; o > 0; o >>= 1) v = fmaxf(v, __shfl_xor(v, o));
    return v;
}
DEV float gelu_tanh(float x) {
    const float u = 0.7978845608028654f * (x + 0.044715f * x * x * x);
    const float t = 1.f - 2.f / (__expf(2.f * u) + 1.f);
    return 0.5f * x * (1.f + t);
}
DEV float sigmoidf_(float x) { return 1.f / (1.f + __expf(-x)); }
DEV int srccol_in(int np) { return np < 1280 ? np : (np < 5888 ? np + 12 : (np < 5900 ? 1280 + (np - 5888) : -1)); }

DEV int tid_opq() { int t = (int)threadIdx.x; asm volatile("" : "+v"(t)); return t; }

namespace pg8 {
#define PG8_LAS __attribute__((address_space(3)))
typedef unsigned short bf16_t;
typedef short bf16x8 __attribute__((ext_vector_type(8)));
typedef float f32x4 __attribute__((ext_vector_type(4)));
typedef unsigned u32x4 __attribute__((ext_vector_type(4)));
constexpr int BM = 256, BK = 64, HALF = 128, HTB = HALF * BK * 2  , STAGE_BYTES = 8 * HTB, NXCD = 8, WGM = 8;

__host__ __device__ __forceinline__ int lds_byte(int r, int c) { const int st = (r >> 4) * 2 + (c >> 5), rr = r & 15, cc = c & 31, ob = rr * 64 + cc * 2; return st * 1024 + (ob ^ (((ob >> 9) & 1) << 5)); }
__host__ __device__ __forceinline__ void stage_rc(int b, int& R, int& C) { const int st = b / 1024, sb = b % 1024, swz = sb ^ (((sb >> 9) & 1) << 5); R = (st >> 1) * 16 + swz / 64; C = (st & 1) * 32 + (swz % 64) / 2; }
__host__ __device__ __forceinline__ int perm32(int rho) { const int n = rho >> 4, i = rho & 15; return 8 * (i >> 2) + 4 * n + (i & 3); }

struct Unit { int pm, pn; };
struct Gemm { const bf16_t* A; const bf16_t* Bt; int M, N, K; };

struct StaticOrder {
    int nM, nN, nwg, G, c;
    __host__ __device__ void init(int M, int N, int G_, int c_) { nM = M / BM; nN = N / BM; nwg = nM * nN; G = G_; c = c_; }
    __host__ __device__ bool next(int i, Unit& u) const {
        const long L = (long)i * G + c; if (L >= nwg) return false;
        int wgid = (int)L; { const int q = nwg / NXCD, r = nwg % NXCD, xcd = wgid % NXCD, off = wgid / NXCD; wgid = (xcd < r ? xcd * (q + 1) : r * (q + 1) + (xcd - r) * q) + off; }
        const int nig = WGM * nN, gid = wgid / nig, fm = gid * WGM, gsz = (nM - fm) < WGM ? (nM - fm) : WGM;
        u.pm = fm + ((wgid % nig) % gsz); u.pn = (wgid % nig) / gsz; return true;
    }
    __device__ __forceinline__ void a_ready(const Unit&) const {}
    __device__ __forceinline__ void done(const Unit&) const {}
};
__device__ __forceinline__ unsigned cvt_pk_bf16(float lo, float hi) { unsigned r; asm volatile("v_cvt_pk_bf16_f32 %0, %1, %2" : "=v"(r) : "v"(lo), "v"(hi)); return r; }
typedef float f32x2 __attribute__((ext_vector_type(2)));
__device__ __forceinline__ f32x2 gelu_pk(f32x2 v) {
    const f32x2 av = __builtin_elementwise_abs(v), d = av * 0.2316418882f + 1.0f;
    f32x2 t; t.x = __builtin_amdgcn_rcpf(d.x); t.y = __builtin_amdgcn_rcpf(d.y);
    f32x2 q = t * 0.5307027145f + (-0.7265760135f); q = q * t + 0.7107068705f; q = q * t + (-0.142248368f); q = q * t + 0.127414796f; q = q * t;
    const f32x2 s = (v * v) * (-0.72134752044f);
    f32x2 e; e.x = __builtin_amdgcn_exp2f(s.x); e.y = __builtin_amdgcn_exp2f(s.y);
    const f32x2 m = v * (q * e), r = v - m;
    f32x2 o; o.x = v.x < 0.f ? m.x : r.x; o.y = v.y < 0.f ? m.y : r.y; return o;
}

struct EpiF32 {
    static constexpr bool PERM = false, AFTER_DRAIN = false;
    float* C; int ldc; const float* bias;
    __device__ __forceinline__ void operator()(const f32x4 (&acc)[2][2][4][2], const Unit& u, int wr, int wc, int fr, int fq) const {
        const int row0 = u.pm * BM + wr * 64 + fr, col0 = u.pn * BM + wc * 32 + 4 * fq;
        f32x4 bv[2][2];
#pragma unroll
        for (int bj = 0; bj < 2; ++bj)
#pragma unroll
            for (int n = 0; n < 2; ++n) bv[bj][n] = bias ? *(const f32x4*)(bias + col0 + bj * HALF + n * 16) : (f32x4){0.f, 0.f, 0.f, 0.f};
#pragma unroll
        for (int ai = 0; ai < 2; ++ai)
#pragma unroll
            for (int m = 0; m < 4; ++m) { float* rowp = C + (size_t)(row0 + ai * HALF + m * 16) * ldc + col0;
#pragma unroll
                for (int bj = 0; bj < 2; ++bj)
#pragma unroll
                    for (int n = 0; n < 2; ++n) *(f32x4*)(rowp + bj * HALF + n * 16) = acc[ai][bj][m][n] + bv[bj][n]; }
    }
};
template <int ACT  > struct EpiBf16 {
    static constexpr bool PERM = true, AFTER_DRAIN = false;
    bf16_t* O; int ldc; const float* bias; int split_cols; size_t split_stride;
    __device__ __forceinline__ void operator()(const f32x4 (&acc)[2][2][4][2], const Unit& u, int wr, int wc, int fr, int fq) const {
        const int row0 = u.pm * BM + wr * 64 + fr; int colt = u.pn * BM; bf16_t* base = O;
        if (split_cols) { const int t = colt / split_cols; base += (size_t)t * split_stride; colt -= t * split_cols; }
        const int col0 = colt + wc * 32 + 8 * fq, bcol0 = u.pn * BM + wc * 32 + 8 * fq;
        f32x4 bv[2][2];
#pragma unroll
        for (int bj = 0; bj < 2; ++bj)
#pragma unroll
            for (int n = 0; n < 2; ++n) bv[bj][n] = bias ? *(const f32x4*)(bias + bcol0 + bj * HALF + 4 * n) : (f32x4){0.f, 0.f, 0.f, 0.f};
#pragma unroll
        for (int ai = 0; ai < 2; ++ai)
#pragma unroll
            for (int m = 0; m < 4; ++m) { bf16_t* rowp = base + (size_t)(row0 + ai * HALF + m * 16) * ldc + col0;
#pragma unroll
                for (int bj = 0; bj < 2; ++bj) { f32x4 v0 = acc[ai][bj][m][0] + bv[bj][0], v1 = acc[ai][bj][m][1] + bv[bj][1];
                    if (ACT == 1) { f32x2 a = gelu_pk((f32x2){v0[0], v0[1]}), b = gelu_pk((f32x2){v0[2], v0[3]}), c = gelu_pk((f32x2){v1[0], v1[1]}), d = gelu_pk((f32x2){v1[2], v1[3]});
                        v0 = (f32x4){a.x, a.y, b.x, b.y}; v1 = (f32x4){c.x, c.y, d.x, d.y}; }
                    if (ACT == 2) {
#pragma unroll
                        for (int j = 0; j < 4; ++j) { v0[j] = 0.5f * v0[j] * (1.0f + erff(v0[j] * 0.70710678f)); v1[j] = 0.5f * v1[j] * (1.0f + erff(v1[j] * 0.70710678f)); } }
                    u32x4 w; w.x = cvt_pk_bf16(v0[0], v0[1]); w.y = cvt_pk_bf16(v0[2], v0[3]); w.z = cvt_pk_bf16(v1[0], v1[1]); w.w = cvt_pk_bf16(v1[2], v1[3]);
                    *(u32x4*)(rowp + bj * HALF) = w; } }
    }
};
template <class Epi, class Sched, bool STAMP = false>
__device__ __forceinline__ void gemm_phase(PG8_LAS unsigned char* lds, const Gemm g, const Sched& S, const Epi& E, unsigned long long* stamps) {
    const int tid = tid_opq(), wid = __builtin_amdgcn_readfirstlane(tid >> 6), lane = tid & 63, wr = wid >> 2, wc = wid & 3, fr = lane & 15, fq = lane >> 4;
    const int K = g.K, nt = K / BK;
    int ts_lo = 0, ts_hi = 0, nts = 0; const unsigned long long rt_entry = STAMP ? (unsigned long long)wall_clock64() : 0ull;
#define PG8_STAMP() do { if (STAMP && wid == 0 && nts < 64) { const unsigned long long _c = (unsigned long long)clock64(); \
        ts_lo = (lane == nts) ? (int)(unsigned)_c : ts_lo; ts_hi = (lane == nts) ? (int)(unsigned)(_c >> 32) : ts_hi; ++nts; } } while (0)
    PG8_STAMP();
    unsigned voffA[2], voffB[2];
#pragma unroll
    for (int i = 0; i < 2; ++i) { int R, C; stage_rc(tid * 16 + i * 8192, R, C); const int Rb = Epi::PERM ? ((R & ~31) + perm32(R & 31)) : R;
        voffA[i] = (unsigned)(R * K + C) * 2u; voffB[i] = (unsigned)(Rb * K + C) * 2u; }
    const size_t kstep = (size_t)(BK * 2);
    const size_t hstep = (size_t)HALF * K * 2;
    const size_t tstep = 2 * hstep;
    const unsigned ldsw = (unsigned)wid * 1024u;
    const int aoff = lds_byte(wr * 64 + fr, fq * 8), boff = lds_byte(wc * 32 + fr, fq * 8);
#define PG8_SA(b, h) (((b) * 2 + (h)) * HTB)
#define PG8_SB(b, h) ((4 + (b) * 2 + (h)) * HTB)
#define PG8_STAGE(bufoff, gbase, voff) do { _Pragma("unroll") for (int _i = 0; _i < 2; ++_i) \
        __builtin_amdgcn_global_load_lds((const unsigned*)((const char*)(gbase) + (voff)[_i]), (PG8_LAS unsigned*)(lds + (bufoff) + ldsw + _i * 8192), 16, 0, 0); } while (0)
#define PG8_LDA(dst, b, h) do { _Pragma("unroll") for (int m = 0; m < 4; ++m) _Pragma("unroll") for (int k = 0; k < 2; ++k) dst[m][k] = *(const PG8_LAS bf16x8*)(lds + PG8_SA(b, h) + aoff + m * 2048 + k * 1024); } while (0)
#define PG8_LDB(dst, b, h) do { _Pragma("unroll") for (int n = 0; n < 2; ++n) _Pragma("unroll") for (int k = 0; k < 2; ++k) dst[n][k] = *(const PG8_LAS bf16x8*)(lds + PG8_SB(b, h) + boff + n * 2048 + k * 1024); } while (0)
#define PG8_MMA(ai, bj, At, Bt) do { __builtin_amdgcn_s_setprio(1); _Pragma("unroll") for (int m = 0; m < 4; ++m) _Pragma("unroll") for (int n = 0; n < 2; ++n) _Pragma("unroll") for (int k = 0; k < 2; ++k) \
        acc[ai][bj][m][n] = __builtin_amdgcn_mfma_f32_16x16x32_bf16(Bt[n][k], At[m][k], acc[ai][bj][m][n], 0, 0, 0); __builtin_amdgcn_s_setprio(0); } while (0)
#define PG8_WAIT_V(n) asm volatile("s_waitcnt vmcnt(" #n ")" ::: "memory")
#define PG8_WAIT_L(n) asm volatile("s_waitcnt lgkmcnt(" #n ")" ::: "memory")
#define PG8_BAR __builtin_amdgcn_s_barrier()
#define PG8_SCHED __builtin_amdgcn_sched_barrier(0)
    Unit cur, nxt; int ui = 0;
    if (!S.next(0, cur)) return;
    f32x4 acc[2][2][4][2];
#pragma unroll
    for (int a = 0; a < 2; ++a)
#pragma unroll
        for (int b = 0; b < 2; ++b)
#pragma unroll
            for (int m = 0; m < 4; ++m)
#pragma unroll
                for (int n = 0; n < 2; ++n) acc[a][b][m][n] = (f32x4){0.f, 0.f, 0.f, 0.f};
    bf16x8 At[4][2], B0[2][2], B1[2][2];
    const char* cA = (const char*)g.A + (size_t)cur.pm * tstep; const char* cB = (const char*)g.Bt + (size_t)cur.pn * tstep;
    S.a_ready(cur);
    PG8_STAGE(PG8_SB(0, 0), cB, voffB); PG8_STAGE(PG8_SA(0, 0), cA, voffA); PG8_STAGE(PG8_SB(0, 1), cB + hstep, voffB); PG8_STAGE(PG8_SA(0, 1), cA + hstep, voffA);
    if (wr == 1) PG8_BAR;
    PG8_WAIT_V(4); PG8_BAR;
    PG8_STAGE(PG8_SB(1, 0), cB + kstep, voffB); PG8_STAGE(PG8_SA(1, 0), cA + kstep, voffA); PG8_STAGE(PG8_SB(1, 1), cB + hstep + kstep, voffB);
    PG8_WAIT_V(6); PG8_BAR;
    PG8_STAMP();
    for (;;) {
        const bool has_next = S.next(ui + 1, nxt);
        const char* nA = has_next ? (const char*)g.A + (size_t)nxt.pm * tstep : cA; const char* nB = has_next ? (const char*)g.Bt + (size_t)nxt.pn * tstep : cB;
        for (int t = 0; t < nt; t += 2) {
            const bool last = (t == nt - 2);
            const char* a1 = cA + (size_t)(t + 1) * kstep;
            const char* a2 = last ? nA : cA + (size_t)(t + 2) * kstep; const char* b2 = last ? nB : cB + (size_t)(t + 2) * kstep;
            const char* a3 = a2 + kstep; const char* b3 = b2 + kstep;
            if (last && has_next) S.a_ready(nxt);
            PG8_LDB(B0, 0, 0); PG8_SCHED; PG8_LDA(At, 0, 0); PG8_STAGE(PG8_SA(1, 1), a1 + hstep, voffA);
            PG8_WAIT_L(8); PG8_BAR; PG8_WAIT_L(0); PG8_MMA(0, 0, At, B0); PG8_BAR; PG8_SCHED;
            PG8_LDB(B1, 0, 1); PG8_STAGE(PG8_SB(0, 0), b2, voffB);
            PG8_BAR; PG8_WAIT_L(0); PG8_MMA(0, 1, At, B1); PG8_BAR;
            PG8_LDA(At, 0, 1); PG8_STAGE(PG8_SA(0, 0), a2, voffA);
            PG8_BAR; PG8_WAIT_L(0); PG8_MMA(1, 0, At, B0); PG8_BAR; PG8_SCHED;
            PG8_STAGE(PG8_SB(0, 1), b2 + hstep, voffB);
            PG8_WAIT_V(6); PG8_BAR; PG8_MMA(1, 1, At, B1); PG8_BAR;
            PG8_LDB(B0, 1, 0); PG8_SCHED; PG8_LDA(At, 1, 0); PG8_STAGE(PG8_SA(0, 1), a2 + hstep, voffA);
            PG8_WAIT_L(8); PG8_BAR; PG8_WAIT_L(0); PG8_MMA(0, 0, At, B0); PG8_BAR; PG8_SCHED;
            PG8_LDB(B1, 1, 1); PG8_STAGE(PG8_SB(1, 0), b3, voffB);
            PG8_BAR; PG8_WAIT_L(0); PG8_MMA(0, 1, At, B1); PG8_BAR;
            PG8_LDA(At, 1, 1); PG8_STAGE(PG8_SA(1, 0), a3, voffA);
            PG8_BAR; PG8_WAIT_L(0); PG8_MMA(1, 0, At, B0); PG8_BAR; PG8_SCHED;
            PG8_STAGE(PG8_SB(1, 1), b3 + hstep, voffB);
            PG8_WAIT_V(6); PG8_BAR; PG8_MMA(1, 1, At, B1); PG8_BAR;
        }
        PG8_STAMP();
        if constexpr (!Epi::AFTER_DRAIN) { E(acc, cur, wr, wc, fr, fq); S.done(cur); }
        PG8_STAMP();
        if (!has_next) break;
#pragma unroll
        for (int a = 0; a < 2; ++a)
#pragma unroll
            for (int b = 0; b < 2; ++b)
#pragma unroll
                for (int m = 0; m < 4; ++m)
#pragma unroll
                    for (int n = 0; n < 2; ++n) acc[a][b][m][n] = (f32x4){0.f, 0.f, 0.f, 0.f};
        cur = nxt; cA = nA; cB = nB; ++ui;
    }
    PG8_WAIT_V(0);
    if (wr == 0) PG8_BAR;
    PG8_BAR;
    if constexpr (Epi::AFTER_DRAIN) { E.fused(acc, cur, wr, wc, fr, fq, lds, wid, lane); S.done(cur); }
    PG8_STAMP();
    if (STAMP && wid == 0) { stamps[lane] = lane < nts ? (((unsigned long long)(unsigned)ts_hi << 32) | (unsigned)ts_lo) : 0ull;
        if (lane == 62) stamps[62] = rt_entry; if (lane == 63) stamps[63] = (unsigned long long)wall_clock64(); }
#undef PG8_STAMP
#undef PG8_SA
#undef PG8_SB
#undef PG8_STAGE
#undef PG8_LDA
#undef PG8_LDB
#undef PG8_MMA
#undef PG8_WAIT_V
#undef PG8_WAIT_L
#undef PG8_BAR
#undef PG8_SCHED
}
}
#define XB_TMO      128
#define XB_XCNT(j)  (256  + 64 * (j))
#define XB_XSUB(j)  (1280 + 64 * (j))
#define XB_XGEN(j)  (2304 + 64 * (j))
#define XB_TOP      3328
#define XB_TOPGEN   3392
#define XCD_BAR_WORDS 3456
#define XB_SPIN_CAP (1u << 18)
#define LAS __attribute__((address_space(3)))

__device__ __forceinline__ unsigned xb_ld(unsigned* p)              { return __hip_atomic_load(p, __ATOMIC_RELAXED, __HIP_MEMORY_SCOPE_AGENT); }
__device__ __forceinline__ unsigned xb_add(unsigned* p, unsigned v) { return __hip_atomic_fetch_add(p, v, __ATOMIC_RELAXED, __HIP_MEMORY_SCOPE_AGENT); }
__device__ __forceinline__ unsigned xb_xcc_id() { return (unsigned)__builtin_amdgcn_s_getreg((3 << 11) | 20) & 0xFu; }
#define XB_SPIN(cond, bar) do { unsigned _sp = 0; while (cond) { __builtin_amdgcn_s_sleep(1); \
    if ((++_sp & 255u) == 0u) { if (xb_ld(&(bar)[XB_TMO])) break; if (_sp > XB_SPIN_CAP) { atomicAdd(&(bar)[XB_TMO], 1u); break; } } } } while (0)

struct XcdBarrier {
    unsigned* bar; unsigned x;
    volatile LAS unsigned* st;
};

__device__ __forceinline__ XcdBarrier xcd_barrier_post(unsigned* bar, volatile LAS unsigned* st) {
    XcdBarrier b; b.bar = bar; b.x = xb_xcc_id(); b.st = st;
    if (threadIdx.x == 0) (void)xb_add(&bar[XB_XCNT(b.x)], 1u);
    return b;
}
__device__ __forceinline__ void xcd_barrier_complete(unsigned* bar, unsigned x, unsigned& nloc, unsigned& nx) {
    const unsigned G = gridDim.x * gridDim.y * gridDim.z;
    unsigned sum, cnt, mine, sp = 0u;
    for (;;) {
        sum = 0u; cnt = 0u; mine = 0u;
#pragma unroll
        for (unsigned j = 0; j < 16; ++j) { const unsigned c = xb_ld(&bar[XB_XCNT(j)]); sum += c; cnt += (c > 0u) ? 1u : 0u; mine = (j == x) ? c : mine; }
        if (sum == G) break;
        __builtin_amdgcn_s_sleep(1);
        if ((++sp & 255u) == 0u) { if (xb_ld(&bar[XB_TMO])) break; if (sp > XB_SPIN_CAP) { atomicAdd(&bar[XB_TMO], 1u); break; } }
    }
    nloc = mine > 0u ? mine : 1u; nx = cnt > 0u ? cnt : 1u;
}

__device__ __forceinline__ void xcd_barrier(const XcdBarrier& b) {
    asm volatile("s_waitcnt vmcnt(0)" ::: "memory");
    __syncthreads();
    if (threadIdx.x == 0) {
        unsigned* bar = b.bar;
        __builtin_amdgcn_s_waitcnt(0);
        unsigned nloc = b.st[0], nx = b.st[1];
        if (nloc == 0u) { xcd_barrier_complete(bar, b.x, nloc, nx); b.st[0] = nloc; b.st[1] = nx; }
        const unsigned old = xb_add(&bar[XB_XSUB(b.x)], 1u);
        const unsigned gen = old / nloc;
        if (old + 1u == (gen + 1u) * nloc) {
            __builtin_amdgcn_fence(__ATOMIC_RELEASE, "agent");
            asm volatile("s_waitcnt vmcnt(0)" ::: "memory");
            const unsigned og = xb_add(&bar[XB_TOP], 1u);
            const unsigned tg = og / nx;
            if (og + 1u == (tg + 1u) * nx) xb_add(&bar[XB_TOPGEN], 1u);
            else XB_SPIN(xb_ld(&bar[XB_TOPGEN]) == tg, bar);
            __builtin_amdgcn_fence(__ATOMIC_ACQUIRE, "agent");
            xb_add(&bar[XB_XGEN(b.x)], 1u);
            asm volatile("s_waitcnt vmcnt(0)" ::: "memory");
        } else {
            XB_SPIN(xb_ld(&bar[XB_XGEN(b.x)]) == gen, bar);
            __builtin_amdgcn_fence(__ATOMIC_ACQUIRE, "agent");
            asm volatile("s_waitcnt vmcnt(0)" ::: "memory");
        }
    }
    __syncthreads();
}


template <int MODE, int KD = 2048>
DEV void ph_transpose(const float* __restrict__ src, bf16_t* __restrict__ dst, int N, int NP, float* lds, int wg, int nwg) {
    const int tid = tid_opq();
    const int ntk = KD / 64, ntiles = (NP / 64) * ntk;
    for (int tile = wg; tile < ntiles; tile += nwg) {
        const int n0 = (tile / ntk) * 64, k0 = (tile % ntk) * 64;
        __syncthreads();
        {
            const int nl = tid & 63, np = n0 + nl;
            const int sc = MODE == 1 ? srccol_in(np) : (np < N ? np : -1);
#pragma unroll
            for (int i = 0; i < 8; ++i) { const int kl = (tid >> 6) + 8 * i; lds[kl * 65 + nl] = sc >= 0 ? src[(size_t)(k0 + kl) * N + sc] : 0.f; }
        }
        __syncthreads();
        {
            const int kl = 2 * (tid & 31);
#pragma unroll
            for (int i = 0; i < 4; ++i) { const int nl = (tid >> 5) + 16 * i;
                *(unsigned*)(dst + (size_t)(n0 + nl) * KD + k0 + kl) = pack2(lds[kl * 65 + nl], lds[(kl + 1) * 65 + nl]); }
        }
    }
}
DEV void ph_cvt(const float* __restrict__ src, bf16_t* __restrict__ dst, size_t n, int wg, int nwg) {
    const size_t n4 = n / 4;
    const int tid = tid_opq(), lane = tid & 63, gw = wg * 8 + (tid >> 6), nw = nwg * 8;
    for (size_t b = (size_t)gw * 128; b < n4; b += (size_t)nw * 128) {
        const float4 a = ((const float4*)src)[b + lane], c = ((const float4*)src)[b + 64 + lane];
        uint2 w0, w1; w0.x = pack2(a.x, a.y); w0.y = pack2(a.z, a.w); w1.x = pack2(c.x, c.y); w1.y = pack2(c.z, c.w);
        ((uint2*)dst)[b + lane] = w0; ((uint2*)dst)[b + 64 + lane] = w1;
    }
}
DEV void ph_ropetab(float* ROPE, int wg, int nwg) {
    for (int i = wg * 512 + tid_opq(); i < SEQ * 24; i += nwg * 512) {
        const int pos = i / 24, j = i % 24;
        const float ex = j < 16 ? (float)j / 16.f : (float)(j - 16) / 8.f;
        const float inv = exp2f(-ex * 18.931568569324174f);
        const float ang = (float)pos * inv;
        const double a = (double)ang, k = rint(a * 0.15915494309189535), r = a - k * 6.283185307179586;
        const float rf = (float)r;
        const float s = sinf(rf), c = cosf(rf);
        const int co = j < 16 ? j : 32 + (j - 16), so = j < 16 ? 16 + j : 40 + (j - 16);
        ROPE[pos * 48 + co] = c; ROPE[pos * 48 + so] = s;
    }
}
DEV void ph_skt(const float* __restrict__ sk, float* __restrict__ skt, int wg, int nwg) {
    for (size_t i = (size_t)wg * 512 + tid_opq(); i < (size_t)NL * 16 * 16384; i += (size_t)nwg * 512) {
        const size_t m = i >> 14; const int r = (int)(i & 16383), c = r >> 7, n = r & 127;
        skt[i] = sk[(m << 14) + (size_t)n * 128 + c];
    }
}

DEV void ph_ln_bf(const bf16_t* __restrict__ Y, const float* __restrict__ g, const float* __restrict__ bt, float* XFo, bf16_t* XBo, int wg, int nwg) {
    const int wave = tid_opq() >> 6, lane = tid_opq() & 63, stride = nwg * 8;
    for (int row0 = wg * 8 + wave; row0 < TT; row0 += 4 * stride) {
        uint4 w[4][4]; float mu[4], rstd[4];
#pragma unroll
        for (int k = 0; k < 4; ++k) { const int row = row0 + k * stride < TT ? row0 + k * stride : row0;
#pragma unroll
            for (int i = 0; i < 4; ++i) w[k][i] = *(const uint4*)(Y + (size_t)row * DM + i * 512 + lane * 8); }
#pragma unroll
        for (int k = 0; k < 4; ++k) { float s = 0.f;
#pragma unroll
            for (int i = 0; i < 4; ++i) s += ((bflo(w[k][i].x) + bfhi(w[k][i].x)) + (bflo(w[k][i].y) + bfhi(w[k][i].y))) + ((bflo(w[k][i].z) + bfhi(w[k][i].z)) + (bflo(w[k][i].w) + bfhi(w[k][i].w)));
            s = wave_sum(s); const float m = s * (1.f / 2048.f); float q = 0.f;
#pragma unroll
            for (int i = 0; i < 4; ++i) { const unsigned u[4] = {w[k][i].x, w[k][i].y, w[k][i].z, w[k][i].w};
#pragma unroll
                for (int j = 0; j < 4; ++j) { const float a = bflo(u[j]) - m, b = bfhi(u[j]) - m; q += a * a + b * b; } }
            q = wave_sum(q); mu[k] = m; rstd[k] = rsqrtf(q * (1.f / 2048.f) + 1e-5f); }
#pragma unroll
        for (int i = 0; i < 4; ++i) {
            const float4 g0 = *(const float4*)(g + i * 512 + lane * 8), g1 = *(const float4*)(g + i * 512 + lane * 8 + 4), b0 = *(const float4*)(bt + i * 512 + lane * 8), b1 = *(const float4*)(bt + i * 512 + lane * 8 + 4);
#pragma unroll
            for (int k = 0; k < 4; ++k) { const int row = row0 + k * stride; if (row >= TT) continue;
                const float m = mu[k], r = rstd[k]; const uint4 x = w[k][i];
                float4 o0, o1; o0.x = (bflo(x.x) - m) * r * g0.x + b0.x; o0.y = (bfhi(x.x) - m) * r * g0.y + b0.y; o0.z = (bflo(x.y) - m) * r * g0.z + b0.z; o0.w = (bfhi(x.y) - m) * r * g0.w + b0.w;
                o1.x = (bflo(x.z) - m) * r * g1.x + b1.x; o1.y = (bfhi(x.z) - m) * r * g1.y + b1.y; o1.z = (bflo(x.w) - m) * r * g1.z + b1.z; o1.w = (bfhi(x.w) - m) * r * g1.w + b1.w;
                const size_t off = (size_t)row * DM + i * 512 + lane * 8;
                if (XFo) { *(float4*)(XFo + off) = o0; *(float4*)(XFo + off + 4) = o1; }
                if (XBo) { uint4 y; y.x = pack2(o0.x, o0.y); y.y = pack2(o0.z, o0.w); y.z = pack2(o1.x, o1.y); y.w = pack2(o1.z, o1.w); *(uint4*)(XBo + off) = y; } }
        }
    }
}
template <bool BF16IN>
DEV void ph_ln(const float* __restrict__ Y, const float* __restrict__ g, const float* __restrict__ bt, float* XFo, bf16_t* XBo, int wg, int nwg) {
    const int wave = tid_opq() >> 6, lane = tid_opq() & 63;
    for (int row = wg * 8 + wave; row < TT; row += nwg * 8) {
        float4 v[8]; float s = 0.f;
        if constexpr (BF16IN) { const uint2* yr = (const uint2*)((const bf16_t*)Y + (size_t)row * DM);
#pragma unroll
            for (int i = 0; i < 8; ++i) { const uint2 w = yr[i * 64 + lane]; v[i] = make_float4(bflo(w.x), bfhi(w.x), bflo(w.y), bfhi(w.y)); s += (v[i].x + v[i].y) + (v[i].z + v[i].w); } }
        else { const float4* yr = (const float4*)(Y + (size_t)row * DM);
#pragma unroll
            for (int i = 0; i < 8; ++i) { v[i] = yr[i * 64 + lane]; s += (v[i].x + v[i].y) + (v[i].z + v[i].w); } }
        s = wave_sum(s); const float mu = s * (1.f / 2048.f);
        float q = 0.f;
#pragma unroll
        for (int i = 0; i < 8; ++i) { const float a = v[i].x - mu, b = v[i].y - mu, c = v[i].z - mu, d = v[i].w - mu; q += (a * a + b * b) + (c * c + d * d); }
        q = wave_sum(q); const float rstd = rsqrtf(q * (1.f / 2048.f) + 1e-5f);
#pragma unroll
        for (int i = 0; i < 8; ++i) {
            const float4 g4 = ((const float4*)g)[i * 64 + lane], b4 = ((const float4*)bt)[i * 64 + lane];
            float4 o; o.x = (v[i].x - mu) * rstd * g4.x + b4.x; o.y = (v[i].y - mu) * rstd * g4.y + b4.y; o.z = (v[i].z - mu) * rstd * g4.z + b4.z; o.w = (v[i].w - mu) * rstd * g4.w + b4.w;
            if (XFo) ((float4*)(XFo + (size_t)row * DM))[i * 64 + lane] = o;
            if (XBo) { uint2 w; w.x = pack2(o.x, o.y); w.y = pack2(o.z, o.w); ((uint2*)(XBo + (size_t)row * DM))[i * 64 + lane] = w; }
        }
    }
}

DEV void ph_rope(bf16_t* P, const float* __restrict__ ROPE, int wg, int nwg) {
    for (size_t i = (size_t)wg * 512 + tid_opq(); i < (size_t)TT * 46; i += (size_t)nwg * 512) {
        const int tok = (int)(i / 46), r = (int)(i % 46), pos = tok & (SEQ - 1);
        int c1, c2, to;
        if (r < 30) { const int hd = r >> 1, j8 = (r & 1) * 8;
            const int base = hd < 4 ? C_AQ + hd * 128 : hd == 4 ? C_AKC : hd == 5 ? C_AKS : hd == 6 ? C_AKW : hd < 11 ? C_BQ + (hd - 7) * 128 : C_BK + (hd - 11) * 128;
            c1 = base + j8; c2 = base + 16 + j8; to = j8; }
        else { const int hd = r - 30; const int base = hd < 8 ? C_CQ + hd * 64 : C_CK + (hd - 8) * 64; c1 = base; c2 = base + 8; to = 32; }
        const float* ct = ROPE + pos * 48 + to; const float* stb = ct + (r < 30 ? 16 : 8);
        const float4 ca = *(const float4*)ct, cb = *(const float4*)(ct + 4), sa = *(const float4*)stb, sb = *(const float4*)(stb + 4);
        bf16_t* row = P + (size_t)tok * PW;
        const uint4 w1 = *(const uint4*)(row + c1), w2 = *(const uint4*)(row + c2);
        const float x1[8] = {bflo(w1.x), bfhi(w1.x), bflo(w1.y), bfhi(w1.y), bflo(w1.z), bfhi(w1.z), bflo(w1.w), bfhi(w1.w)};
        const float x2[8] = {bflo(w2.x), bfhi(w2.x), bflo(w2.y), bfhi(w2.y), bflo(w2.z), bfhi(w2.z), bflo(w2.w), bfhi(w2.w)};
        const float cc[8] = {ca.x, ca.y, ca.z, ca.w, cb.x, cb.y, cb.z, cb.w}, ss[8] = {sa.x, sa.y, sa.z, sa.w, sb.x, sb.y, sb.z, sb.w};
        uint4 o1, o2;
        o1.x = pack2(x1[0] * cc[0] - x2[0] * ss[0], x1[1] * cc[1] - x2[1] * ss[1]); o1.y = pack2(x1[2] * cc[2] - x2[2] * ss[2], x1[3] * cc[3] - x2[3] * ss[3]);
        o1.z = pack2(x1[4] * cc[4] - x2[4] * ss[4], x1[5] * cc[5] - x2[5] * ss[5]); o1.w = pack2(x1[6] * cc[6] - x2[6] * ss[6], x1[7] * cc[7] - x2[7] * ss[7]);
        o2.x = pack2(x1[0] * ss[0] + x2[0] * cc[0], x1[1] * ss[1] + x2[1] * cc[1]); o2.y = pack2(x1[2] * ss[2] + x2[2] * cc[2], x1[3] * ss[3] + x2[3] * cc[3]);
        o2.z = pack2(x1[4] * ss[4] + x2[4] * cc[4], x1[5] * ss[5] + x2[5] * cc[5]); o2.w = pack2(x1[6] * ss[6] + x2[6] * cc[6], x1[7] * ss[7] + x2[7] * cc[7]);
        *(uint4*)(row + c1) = o1; *(uint4*)(row + c2) = o2;
    }
}

DEV void ph_compress(const Params& p, int l, float* lds, int wg, int nwg, int only_unit = -1) {
    float* td = lds;
    float* pe = lds + 144 * 128;
    float* hid = pe + 4096;
    const int tid = tid_opq();
    for (int unit = (only_unit >= 0 ? only_unit : wg); unit < (only_unit >= 0 ? only_unit + 1 : 128); unit += nwg) {
        const int kv = unit >> 6, b = (unit >> 5) & 1, grp = unit & 31, c0 = grp * 8, tb0 = c0 * 16;
        const int col = kv ? C_AVC : C_AKC;
        const float* w1 = p.cmp_w1 + ((size_t)l * 2 + kv) * 4096 * 256;
        const float* w2 = p.cmp_w2 + ((size_t)l * 2 + kv) * 256 * 128;
        const float* peg = p.cmp_pe + ((size_t)l * 2 + kv) * 4096;
        __syncthreads();
        for (int i = tid; i < 144 * 16; i += 512) { const int tl = i >> 4, c8 = (i & 15) * 8, tk = tb0 + tl;
            float4 a = {0.f, 0.f, 0.f, 0.f}, bb = a;
            if (tk < SEQ) { const uint4 w = *(const uint4*)(p.P + ((size_t)b * SEQ + tk) * PW + col + c8);
                a = {bflo(w.x), bfhi(w.x), bflo(w.y), bfhi(w.y)}; bb = {bflo(w.z), bfhi(w.z), bflo(w.w), bfhi(w.w)}; }
            *(float4*)(td + tl * 128 + c8) = a; *(float4*)(td + tl * 128 + c8 + 4) = bb; }
        for (int i = tid; i < 4096; i += 512) pe[i] = peg[i];
        __syncthreads();
        {
            const int j = tid & 255, rg = tid >> 8;
            float acc0 = 0.f, acc1 = 0.f, acc2 = 0.f, acc3 = 0.f, bias = 0.f;
            const float* t0 = td + (rg * 4 + 0) * 2048; const float* t1 = td + (rg * 4 + 1) * 2048; const float* t2 = td + (rg * 4 + 2) * 2048; const float* t3 = td + (rg * 4 + 3) * 2048;
            for (int i = 0; i < 4096; i += 4) {
                const float wa = w1[(size_t)(i + 0) * 256 + j], wb = w1[(size_t)(i + 1) * 256 + j], wc = w1[(size_t)(i + 2) * 256 + j], wd = w1[(size_t)(i + 3) * 256 + j];
                const float4 pp = *(const float4*)(pe + i);
                bias += pp.x * wa + pp.y * wb + pp.z * wc + pp.w * wd;
                float4 x = *(const float4*)(t0 + i); acc0 += x.x * wa + x.y * wb + x.z * wc + x.w * wd;
                x = *(const float4*)(t1 + i); acc1 += x.x * wa + x.y * wb + x.z * wc + x.w * wd;
                x = *(const float4*)(t2 + i); acc2 += x.x * wa + x.y * wb + x.z * wc + x.w * wd;
                x = *(const float4*)(t3 + i); acc3 += x.x * wa + x.y * wb + x.z * wc + x.w * wd;
            }
            hid[(rg * 4 + 0) * 256 + j] = gelu_tanh(acc0 + bias); hid[(rg * 4 + 1) * 256 + j] = gelu_tanh(acc1 + bias);
            hid[(rg * 4 + 2) * 256 + j] = gelu_tanh(acc2 + bias); hid[(rg * 4 + 3) * 256 + j] = gelu_tanh(acc3 + bias);
        }
        __syncthreads();
        {
            const int n = tid & 127, r0 = (tid >> 7) * 2;
            float a0 = 0.f, a1 = 0.f;
            for (int j = 0; j < 256; ++j) { const float w = w2[j * 128 + n]; a0 += hid[r0 * 256 + j] * w; a1 += hid[(r0 + 1) * 256 + j] * w; }
            float* dst = (kv ? p.VC : p.KC) + ((size_t)b * 256 + c0) * 128;
            dst[(r0 + 0) * 128 + n] = (c0 + r0 + 0 < 255) ? a0 : 0.f;
            dst[(r0 + 1) * 128 + n] = (c0 + r0 + 1 < 255) ? a1 : 0.f;
            bf16_t* dsb = (kv ? p.VCB : p.KCB) + ((size_t)b * 256 + c0) * 128;
            dsb[(r0 + 0) * 128 + n] = f2bf((c0 + r0 + 0 < 255) ? a0 : 0.f);
            dsb[(r0 + 1) * 128 + n] = f2bf((c0 + r0 + 1 < 255) ? a1 : 0.f);
        }
    }
}

DEV void ph_nsa_cmp(const Params& p, int l, float* lds, int wg, int nwg) {
    float* qs = lds;
    float* sc = lds + 64 * 128;
    float* imp = sc + 64 * 256;
    const int tid = tid_opq(), lane = tid & 63, wave = tid >> 6;
    for (int unit = wg; unit < TT / 16; unit += nwg) {
        const int tok0 = unit * 16, b = tok0 >> 12, pos0 = tok0 & (SEQ - 1);
        __syncthreads();
        { const int row = tid >> 3, ch = (tid & 7) * 16, tl = row >> 2, h = row & 3;
          const bf16_t* src = p.P + (size_t)(tok0 + tl) * PW + C_AQ + h * 128 + ch;
          const uint4 w0 = *(const uint4*)src, w1 = *(const uint4*)(src + 8);
          float* d = qs + row * 128 + ch;
          *(float4*)(d + 0) = {bflo(w0.x), bfhi(w0.x), bflo(w0.y), bfhi(w0.y)}; *(float4*)(d + 4) = {bflo(w0.z), bfhi(w0.z), bflo(w0.w), bfhi(w0.w)};
          *(float4*)(d + 8) = {bflo(w1.x), bfhi(w1.x), bflo(w1.y), bfhi(w1.y)}; *(float4*)(d + 12) = {bflo(w1.z), bfhi(w1.z), bflo(w1.w), bfhi(w1.w)}; }
        __syncthreads();
        {
            const int c = tid & 255, rg = tid >> 8;
            float acc[32];
#pragma unroll
            for (int r = 0; r < 32; ++r) acc[r] = 0.f;
            const float4* kr = (const float4*)(p.KC + ((size_t)b * 256 + c) * 128);
            for (int d4 = 0; d4 < 32; ++d4) { const float4 kv = kr[d4];
#pragma unroll
                for (int r = 0; r < 32; ++r) { const float4 q = *(const float4*)(qs + (rg * 32 + r) * 128 + d4 * 4); acc[r] += q.x * kv.x + q.y * kv.y + q.z * kv.z + q.w * kv.w; } }
#pragma unroll
            for (int r = 0; r < 32; ++r) { const int row = rg * 32 + r, pos = pos0 + (row >> 2);
                sc[row * 256 + c] = (16 * c + 31 <= pos) ? acc[r] * 0.08838834764831845f : NEG_INF; }
        }
        __syncthreads();
        for (int rr = 0; rr < 8; ++rr) {
            float* r = sc + (wave * 8 + rr) * 256;
            float v0 = r[lane], v1 = r[lane + 64], v2 = r[lane + 128], v3 = r[lane + 192];
            float m = wave_max(fmaxf(fmaxf(v0, v1), fmaxf(v2, v3)));
            if (m == NEG_INF) m = 0.f;
            v0 = __expf(v0 - m); v1 = __expf(v1 - m); v2 = __expf(v2 - m); v3 = __expf(v3 - m);
            const float s = wave_sum((v0 + v1) + (v2 + v3)), inv = 1.f / fmaxf(s, 1e-30f);
            r[lane] = v0 * inv; r[lane + 64] = v1 * inv; r[lane + 128] = v2 * inv; r[lane + 192] = v3 * inv;
        }
        __syncthreads();
        {
            const int d = tid & 127, rgp = tid >> 7;
            float acc[16];
#pragma unroll
            for (int r = 0; r < 16; ++r) acc[r] = 0.f;
            const float* vcb = p.VC + (size_t)b * 256 * 128 + d;
            for (int c = 0; c < 256; c += 4) { const float va = vcb[(c + 0) * 128], vb = vcb[(c + 1) * 128], vc = vcb[(c + 2) * 128], vd = vcb[(c + 3) * 128];
#pragma unroll
                for (int r = 0; r < 16; ++r) { const float4 pp = *(const float4*)(sc + (rgp * 16 + r) * 256 + c); acc[r] += pp.x * va + pp.y * vb + pp.z * vc + pp.w * vd; } }
#pragma unroll
            for (int r = 0; r < 16; ++r) { const int row = rgp * 16 + r, tl = row >> 2, h = row & 3; const size_t tok = (size_t)tok0 + tl;
                const float g = sigmoidf_(bf2f(p.P[tok * PW + C_AG + h]));
                p.OACC[tok * DM + h * 128 + d] = g * acc[r]; }
        }
        {
            const int tl = tid >> 5, tb = (pos0 + tl) >> 6;
#pragma unroll
            for (int q = 0; q < 2; ++q) { const int j = (tid & 31) + 32 * q; float v = 0.f;
                const int clo = (4 * j - 1) < 0 ? 0 : 4 * j - 1, chi = (4 * j + 3) > 254 ? 254 : 4 * j + 3;
                for (int h = 0; h < 4; ++h) for (int c = clo; c <= chi; ++c) v += sc[(tl * 4 + h) * 256 + c];
                if (j == 0 || j == tb || j == tb - 1) v += 1000.f;
                imp[tl * 64 + j] = (j <= tb) ? v : NEG_INF; }
        }
        __syncthreads();
        for (int q = 0; q < 2; ++q) {
            const int tl = wave + 8 * q; const float v = imp[tl * 64 + lane];
            int rank = 0;
            for (int jp = 0; jp < 64; ++jp) { const float o = __shfl(v, jp); rank += (o > v || (o == v && jp < lane)) ? 1 : 0; }
            const u64 m = __ballot(v != NEG_INF && rank < 16);
            if (lane == 0) p.SEL[tok0 + tl] = m;
        }
    }
}

enum { V_SLC = 0, V_WIN = 1, V_DIL = 2, V_DIFF = 3, V_STICK = 4 };
template <int VAR> DEV int attn_units() { return VAR == V_DIFF ? 256 : 128; }

template <int VAR>
DEV void attn_naive_unit(const Params& p, int l, int unit, float* lds) {
    constexpr int NQ4 = (VAR == V_DIFF) ? 8 : 16;
    float* Ks = lds; float* Vs = lds + 64 * 128;
    const int tid = tid_opq(), row = tid >> 1, hf = tid & 1;
    int b, h, tq, qcol, kcol, vcol, koff = 0, tile_lo, tile_hi;
    if (VAR == V_SLC || VAR == V_WIN) { b = unit >> 6; const int qb = unit & 63; h = row & 3; tq = qb * 64 + (row >> 2); qcol = C_AQ + h * 128;
        kcol = VAR == V_SLC ? C_AKS : C_AKW; vcol = VAR == V_SLC ? C_AVS : C_AVW; tile_hi = qb; tile_lo = VAR == V_SLC ? 0 : (qb - 8 < 0 ? 0 : qb - 8); }
    else if (VAR == V_DIL) { b = unit >> 6; h = (unit >> 4) & 3; const int qb = unit & 15; tq = qb * 256 + row; qcol = C_BQ + h * 128; kcol = C_BK + h * 128; vcol = C_BV + h * 128;
        tile_hi = qb * 4 + 3; tile_lo = qb * 4 - 32 < 0 ? 0 : qb * 4 - 32; }
    else if (VAR == V_DIFF) { b = unit >> 7; h = (unit >> 5) & 3; const int qb = unit & 31, map = row & 1; tq = qb * 128 + (row >> 1); qcol = C_CQ + (2 * h + map) * 64;
        kcol = C_CK + h * 128; koff = map * 64; vcol = C_CV + h * 128; tile_lo = 0; tile_hi = qb * 2 + 1; }
    else { b = unit >> 6; h = (unit >> 4) & 3; const int qb = unit & 15; tq = qb * 256 + row; qcol = C_DQ + h * 128; kcol = C_DK + h * 128; vcol = C_DV + h * 128; tile_lo = 0; tile_hi = qb * 4 + 3; }
    const size_t tokq = (size_t)b * SEQ + tq;
    const bf16_t* Pb = p.P;
    float4 q4[NQ4];
#pragma unroll
    for (int i = 0; i < NQ4; ++i) { const uint2 w = *(const uint2*)(Pb + tokq * PW + qcol + (2 * i + hf) * 4); q4[i] = {bflo(w.x), bfhi(w.x), bflo(w.y), bfhi(w.y)}; }
    float o[64];
#pragma unroll
    for (int i = 0; i < 64; ++i) o[i] = 0.f;
    float m = NEG_INF, lsum = 0.f, run = 0.f;
    u64 sel = 0; if (VAR == V_SLC) sel = p.SEL[tokq];
    const float scale = VAR == V_DIFF ? 0.125f : 0.08838834764831845f;
    const int ntiles = tile_hi - tile_lo + 1;
    for (int it = 0; it < ntiles; ++it) {
        const int tile = VAR == V_STICK ? tile_hi - it : tile_lo + it;
        __syncthreads();
#pragma unroll
        for (int ps = 0; ps < 2; ++ps) { const int key = (tid >> 4) + 32 * ps, c8 = (tid & 15) * 8; const size_t base = ((size_t)b * SEQ + tile * 64 + key) * PW;
            const uint4 kw = *(const uint4*)(Pb + base + kcol + c8), vw = *(const uint4*)(Pb + base + vcol + c8);
            *(float4*)(Ks + key * 128 + c8) = {bflo(kw.x), bfhi(kw.x), bflo(kw.y), bfhi(kw.y)}; *(float4*)(Ks + key * 128 + c8 + 4) = {bflo(kw.z), bfhi(kw.z), bflo(kw.w), bfhi(kw.w)};
            *(float4*)(Vs + key * 128 + c8) = {bflo(vw.x), bfhi(vw.x), bflo(vw.y), bfhi(vw.y)}; *(float4*)(Vs + key * 128 + c8 + 4) = {bflo(vw.z), bfhi(vw.z), bflo(vw.w), bfhi(vw.w)}; }
        __syncthreads();
        for (int jj = 0; jj < 64; ++jj) {
            const int j = VAR == V_STICK ? 63 - jj : jj, kpos = tile * 64 + j;
            const float4* kr = (const float4*)(Ks + j * 128 + koff);
            float s = 0.f;
#pragma unroll
            for (int i = 0; i < NQ4; ++i) { const float4 kv = kr[2 * i + hf]; s += q4[i].x * kv.x + q4[i].y * kv.y + q4[i].z * kv.z + q4[i].w * kv.w; }
            s += __shfl_xor(s, 1); s *= scale;
            const float4* vr = (const float4*)(Vs + j * 128);
            if (VAR == V_STICK) {
                if (kpos < tq) { const float ls = fminf(s, 0.f) - log1pf(__expf(-fabsf(s))); const float a = __expf(ls + run); run += ls - s;
#pragma unroll
                    for (int i = 0; i < 16; ++i) { const float4 vv = vr[2 * i + hf]; o[4 * i] += a * vv.x; o[4 * i + 1] += a * vv.y; o[4 * i + 2] += a * vv.z; o[4 * i + 3] += a * vv.w; } }
            } else {
                float w;
                const int dist = tq - kpos;
                if (VAR == V_SLC) w = (dist >= 0 && ((sel >> (kpos >> 6)) & 1ull)) ? 1.f : 0.f;
                else if (VAR == V_WIN) w = (dist >= 0 && dist <= 511) ? 1.f : 0.f;
                else if (VAR == V_DIL) w = dist < 0 ? 0.f : (float)((dist <= 128 ? 1 : 0) + (((dist & 3) == 0 && dist <= 512) ? 1 : 0) + (((dist & 15) == 0 && dist <= 2048) ? 1 : 0));
                else w = dist >= 0 ? 1.f : 0.f;
                if (w > 0.f) {
                    if (s > m) { const float cs = __expf(m - s); lsum *= cs;
#pragma unroll
                        for (int i = 0; i < 64; ++i) o[i] *= cs;
                        m = s; }
                    const float pz = w * __expf(s - m); lsum += pz;
#pragma unroll
                    for (int i = 0; i < 16; ++i) { const float4 vv = vr[2 * i + hf]; o[4 * i] += pz * vv.x; o[4 * i + 1] += pz * vv.y; o[4 * i + 2] += pz * vv.z; o[4 * i + 3] += pz * vv.w; }
                }
            }
        }
        if (VAR == V_STICK) {
            int* flags = (int*)(lds + 2 * 64 * 128);
            const int wok = __all(run < -110.f) ? 1 : 0;
            if ((tid & 63) == 0) flags[tid >> 6] = wok;
            __syncthreads();
            int all_ok = 1;
#pragma unroll
            for (int w = 0; w < 8; ++w) all_ok &= flags[w];
            if (all_ok) break;
        }
    }
    if (VAR == V_SLC || VAR == V_WIN) {
        const int br = VAR == V_SLC ? 1 : 2; const float g = sigmoidf_(bf2f(Pb[tokq * PW + C_AG + br * 4 + h])), f = g / lsum;
        float* dst = p.OACC + tokq * DM + h * 128;
#pragma unroll
        for (int i = 0; i < 16; ++i) { float4* d4 = (float4*)(dst + (2 * i + hf) * 4); float4 cur = *d4; cur.x += f * o[4 * i]; cur.y += f * o[4 * i + 1]; cur.z += f * o[4 * i + 2]; cur.w += f * o[4 * i + 3]; *d4 = cur; }
    } else if (VAR == V_DIL || VAR == V_STICK) {
        const float f = VAR == V_DIL ? 1.f / lsum : 1.f;
        float* dst = p.OACC + tokq * DM + (VAR == V_DIL ? 512 : 1536) + h * 128;
#pragma unroll
        for (int i = 0; i < 16; ++i) { float4 r = {f * o[4 * i], f * o[4 * i + 1], f * o[4 * i + 2], f * o[4 * i + 3]}; *(float4*)(dst + (2 * i + hf) * 4) = r; }
    } else {
        const float* lp = p.diff_lambda + (size_t)l * 256;
        float d01 = 0.f, d23 = 0.f;
        for (int i = 0; i < 64; ++i) { d01 += lp[i] * lp[64 + i]; d23 += lp[128 + i] * lp[192 + i]; }
        const float lam_init = 0.8f - 0.6f * expf(-0.3f * (float)l), lam = expf(d01) - expf(d23) + lam_init;
        const float inv = 1.f / lsum; float ss = 0.f;
#pragma unroll
        for (int i = 0; i < 64; ++i) { const float v = o[i] * inv, ot = __shfl_xor(v, 2); o[i] = v - lam * ot; ss += o[i] * o[i]; }
        ss += __shfl_xor(ss, 1);
        const float rs = rsqrtf(ss * (1.f / 128.f) + 1e-6f) * (1.f - lam_init);
        if ((row & 1) == 0) { const float* gg = p.diff_g + (size_t)l * 128; float* dst = p.OACC + tokq * DM + 1024 + h * 128;
#pragma unroll
            for (int i = 0; i < 16; ++i) { const int d0 = (2 * i + hf) * 4; const float4 g4 = *(const float4*)(gg + d0);
                float4 r = {o[4 * i] * rs * g4.x, o[4 * i + 1] * rs * g4.y, o[4 * i + 2] * rs * g4.z, o[4 * i + 3] * rs * g4.w}; *(float4*)(dst + d0) = r; } }
    }
}
template <int VAR>
DEV void ph_attn_naive(const Params& p, int l, float* lds, int wg, int nwg) {
    for (int unit = wg; unit < attn_units<VAR>(); unit += nwg) attn_naive_unit<VAR>(p, l, unit, lds);
}

DEV void ph_peer_select(const Params& p, int l, float* lds, int wg, int nwg) {
    float* qs = lds;
    float* scs = lds + 8 * 2048;
    const int tid = tid_opq(), lane = tid & 63, h = tid >> 6;
    for (int unit = wg; unit < TT / 8; unit += nwg) {
        const int tok0 = unit * 8;
        __syncthreads();
#pragma unroll
        for (int i = 0; i < 8; ++i) ((float4*)qs)[i * 512 + tid] = ((const float4*)(p.Q2 + (size_t)tok0 * DM))[i * 512 + tid];
        __syncthreads();
        {
            float acc[8][4];
#pragma unroll
            for (int t = 0; t < 8; ++t) { acc[t][0] = 0.f; acc[t][1] = 0.f; acc[t][2] = 0.f; acc[t][3] = 0.f; }
            const float* s0 = p.SKT + (((size_t)l * 8 + h) * 2 + 0) * 16384, * s1 = s0 + 16384;
            for (int c = 0; c < 128; c += 4) {
                float wa[4], wb[4], wc[4], wd[4];
#pragma unroll
                for (int k = 0; k < 4; ++k) { wa[k] = s0[(c + k) * 128 + lane]; wb[k] = s0[(c + k) * 128 + 64 + lane]; wc[k] = s1[(c + k) * 128 + lane]; wd[k] = s1[(c + k) * 128 + 64 + lane]; }
#pragma unroll
                for (int t = 0; t < 8; ++t) { const float4 q0 = *(const float4*)(qs + t * 2048 + h * 256 + c), q1 = *(const float4*)(qs + t * 2048 + h * 256 + 128 + c);
                    acc[t][0] += q0.x * wa[0] + q0.y * wa[1] + q0.z * wa[2] + q0.w * wa[3]; acc[t][1] += q0.x * wb[0] + q0.y * wb[1] + q0.z * wb[2] + q0.w * wb[3];
                    acc[t][2] += q1.x * wc[0] + q1.y * wc[1] + q1.z * wc[2] + q1.w * wc[3]; acc[t][3] += q1.x * wd[0] + q1.y * wd[1] + q1.z * wd[2] + q1.w * wd[3]; }
            }
#pragma unroll
            for (int t = 0; t < 8; ++t) { float* d = scs + (t * 8 + h) * 256; d[lane] = acc[t][0]; d[64 + lane] = acc[t][1]; d[128 + lane] = acc[t][2]; d[192 + lane] = acc[t][3]; }
        }
        __builtin_amdgcn_s_waitcnt(0);
        for (int t = 0; t < 8; ++t) {
            const float* d = scs + (t * 8 + h) * 256;
            float a = d[lane], bq = d[64 + lane], c2 = d[128 + lane], d2 = d[192 + lane];
            float ts1 = NEG_INF, ts2 = NEG_INF; int ti1 = 0, ti2 = 0;
            for (int k = 0; k < 16; ++k) {
                { const float mx = wave_max(fmaxf(a, bq)); const u64 ba = __ballot(a == mx), bb = __ballot(bq == mx); int n;
                  if (ba) { const int ln = __ffsll((long long)ba) - 1; n = ln; if (lane == ln) a = NEG_INF; } else { const int ln = __ffsll((long long)bb) - 1; n = ln + 64; if (lane == ln) bq = NEG_INF; }
                  if (lane == k) { ts1 = mx; ti1 = n; } }
                { const float mx = wave_max(fmaxf(c2, d2)); const u64 ba = __ballot(c2 == mx), bb = __ballot(d2 == mx); int n;
                  if (ba) { const int ln = __ffsll((long long)ba) - 1; n = ln; if (lane == ln) c2 = NEG_INF; } else { const int ln = __ffsll((long long)bb) - 1; n = ln + 64; if (lane == ln) d2 = NEG_INF; }
                  if (lane == k) { ts2 = mx; ti2 = n; } }
            }
            const float s1i = __shfl(ts1, lane >> 2); const int jb = (lane & 3) * 4;
            float c0 = s1i + __shfl(ts2, jb), c1 = s1i + __shfl(ts2, jb + 1), c2b = s1i + __shfl(ts2, jb + 2), c3 = s1i + __shfl(ts2, jb + 3);
            float fs = NEG_INF; int fe = 0;
            for (int k = 0; k < 16; ++k) {
                const float lm = fmaxf(fmaxf(c0, c1), fmaxf(c2b, c3)), mx = wave_max(lm);
                const u64 bal = __ballot(lm == mx); const int ln = __ffsll((long long)bal) - 1;
                int jj = 0;
                if (lane == ln) { if (c0 == mx) { jj = 0; c0 = NEG_INF; } else if (c1 == mx) { jj = 1; c1 = NEG_INF; } else if (c2b == mx) { jj = 2; c2b = NEG_INF; } else { jj = 3; c3 = NEG_INF; } }
                jj = __shfl(jj, ln);
                const int pos = ln * 4 + jj;
                const int i1 = __shfl(ti1, pos >> 4), i2 = __shfl(ti2, pos & 15);
                if (lane == k) { fs = mx; fe = i1 * 128 + i2; }
            }
            const float mx = __shfl(fs, 0); const float e = lane < 16 ? __expf(fs - mx) : 0.f; const float sm = wave_sum(e);
            if (lane < 16) { const size_t o = (size_t)(tok0 + t) * 128 + h * 16 + lane; p.EIDX[o] = fe; p.GATE[o] = e / sm; }
        }
    }
}

DEV void ph_peer_apply(const Params& p, int l, const float* __restrict__ xin, int wg, int nwg) {
    const int wave = tid_opq() >> 6, lane = tid_opq() & 63;
    const bf16_t* UBl = p.UB + (size_t)l * 16384 * 2048; const bf16_t* VBl = p.VB + (size_t)l * 16384 * 2048;
    for (int tok = wg * 8 + wave; tok < TT; tok += nwg * 8) {
        float xv[32], acc[32];
#pragma unroll
        for (int i = 0; i < 4; ++i) { const float4 a = *(const float4*)(xin + (size_t)tok * DM + i * 512 + lane * 8), bb = *(const float4*)(xin + (size_t)tok * DM + i * 512 + lane * 8 + 4);
            xv[i * 8 + 0] = a.x; xv[i * 8 + 1] = a.y; xv[i * 8 + 2] = a.z; xv[i * 8 + 3] = a.w; xv[i * 8 + 4] = bb.x; xv[i * 8 + 5] = bb.y; xv[i * 8 + 6] = bb.z; xv[i * 8 + 7] = bb.w; }
#pragma unroll
        for (int i = 0; i < 32; ++i) acc[i] = 0.f;
        for (int k0 = 0; k0 < 128; k0 += 2) {
            const int e0 = p.EIDX[(size_t)tok * 128 + k0], e1 = p.EIDX[(size_t)tok * 128 + k0 + 1];
            const float g0 = p.GATE[(size_t)tok * 128 + k0], g1 = p.GATE[(size_t)tok * 128 + k0 + 1];
            const uint4* u0 = (const uint4*)(UBl + (size_t)e0 * 2048); const uint4* u1 = (const uint4*)(UBl + (size_t)e1 * 2048);
            float d0 = 0.f, d1 = 0.f;
#pragma unroll
            for (int i = 0; i < 4; ++i) { const uint4 w0 = u0[i * 64 + lane], w1 = u1[i * 64 + lane];
                d0 += xv[i * 8 + 0] * bflo(w0.x) + xv[i * 8 + 1] * bfhi(w0.x) + xv[i * 8 + 2] * bflo(w0.y) + xv[i * 8 + 3] * bfhi(w0.y) + xv[i * 8 + 4] * bflo(w0.z) + xv[i * 8 + 5] * bfhi(w0.z) + xv[i * 8 + 6] * bflo(w0.w) + xv[i * 8 + 7] * bfhi(w0.w);
                d1 += xv[i * 8 + 0] * bflo(w1.x) + xv[i * 8 + 1] * bfhi(w1.x) + xv[i * 8 + 2] * bflo(w1.y) + xv[i * 8 + 3] * bfhi(w1.y) + xv[i * 8 + 4] * bflo(w1.z) + xv[i * 8 + 5] * bfhi(w1.z) + xv[i * 8 + 6] * bflo(w1.w) + xv[i * 8 + 7] * bfhi(w1.w); }
            d0 = wave_sum(d0); d1 = wave_sum(d1);
            const float h0 = g0 * gelu_tanh(d0), h1 = g1 * gelu_tanh(d1);
            const uint4* v0 = (const uint4*)(VBl + (size_t)e0 * 2048); const uint4* v1 = (const uint4*)(VBl + (size_t)e1 * 2048);
#pragma unroll
            for (int i = 0; i < 4; ++i) { const uint4 w0 = v0[i * 64 + lane], w1 = v1[i * 64 + lane];
                acc[i * 8 + 0] += h0 * bflo(w0.x) + h1 * bflo(w1.x); acc[i * 8 + 1] += h0 * bfhi(w0.x) + h1 * bfhi(w1.x);
                acc[i * 8 + 2] += h0 * bflo(w0.y) + h1 * bflo(w1.y); acc[i * 8 + 3] += h0 * bfhi(w0.y) + h1 * bfhi(w1.y);
                acc[i * 8 + 4] += h0 * bflo(w0.z) + h1 * bflo(w1.z); acc[i * 8 + 5] += h0 * bfhi(w0.z) + h1 * bfhi(w1.z);
                acc[i * 8 + 6] += h0 * bflo(w0.w) + h1 * bflo(w1.w); acc[i * 8 + 7] += h0 * bfhi(w0.w) + h1 * bfhi(w1.w); }
        }
#pragma unroll
        for (int i = 0; i < 4; ++i) { float* d = p.Y + (size_t)tok * DM + i * 512 + lane * 8;
            float4 a = {ALPHA * xv[i * 8 + 0] + acc[i * 8 + 0], ALPHA * xv[i * 8 + 1] + acc[i * 8 + 1], ALPHA * xv[i * 8 + 2] + acc[i * 8 + 2], ALPHA * xv[i * 8 + 3] + acc[i * 8 + 3]};
            float4 bb = {ALPHA * xv[i * 8 + 4] + acc[i * 8 + 4], ALPHA * xv[i * 8 + 5] + acc[i * 8 + 5], ALPHA * xv[i * 8 + 6] + acc[i * 8 + 6], ALPHA * xv[i * 8 + 7] + acc[i * 8 + 7]};
            *(float4*)d = a; *(float4*)(d + 4) = bb; }
    }
}

struct EpiResF32 {
    static constexpr bool PERM = false, AFTER_DRAIN = false;
    float* C; const float* X; float alpha;
    __device__ __forceinline__ void operator()(const pg8::f32x4 (&acc)[2][2][4][2], const pg8::Unit& u, int wr, int wc, int fr, int fq) const {
        const int row0 = u.pm * 256 + wr * 64 + fr, col0 = u.pn * 256 + wc * 32 + 4 * fq;
#pragma unroll
        for (int ai = 0; ai < 2; ++ai)
#pragma unroll
            for (int m = 0; m < 4; ++m) { const size_t off = (size_t)(row0 + ai * 128 + m * 16) * DM + col0;
#pragma unroll
                for (int bj = 0; bj < 2; ++bj)
#pragma unroll
                    for (int n = 0; n < 2; ++n) { const pg8::f32x4 xv = *(const pg8::f32x4*)(X + off + bj * 128 + n * 16); *(pg8::f32x4*)(C + off + bj * 128 + n * 16) = acc[ai][bj][m][n] + xv * alpha; } }
    }
};
struct EpiResLn {
    static constexpr bool PERM = false, AFTER_DRAIN = true;
    bf16_t* XB; const float* g; const float* bt; u64* xbuf; unsigned* cnt; unsigned want;
    __device__ __forceinline__ void fused(pg8::f32x4 (&acc)[2][2][4][2], const pg8::Unit& u, int wr, int wc, int fr, int fq, PG8_LAS unsigned char* lds, int wid, int lane) const {
        typedef float f32x2v __attribute__((ext_vector_type(2)));
        using pg8::f32x4;
        PG8_LAS f32x2v* P = (PG8_LAS f32x2v*)lds;
        PG8_LAS f32x2v* S = (PG8_LAS f32x2v*)(lds + 8192);
        const int col0 = u.pn * 256 + wc * 32 + 4 * fq;
#pragma unroll
        for (int ai = 0; ai < 2; ++ai) {
#pragma unroll
            for (int m = 0; m < 4; ++m) { const size_t off = (size_t)(u.pm * 256 + ai * 128 + wr * 64 + m * 16 + fr) * DM + col0;
#pragma unroll
                for (int bj = 0; bj < 2; ++bj)
#pragma unroll
                    for (int n = 0; n < 2; ++n) { const uint2 xw = *(const uint2*)(XB + off + bj * 128 + n * 16); const f32x4 xv = {bflo(xw.x), bfhi(xw.x), bflo(xw.y), bfhi(xw.y)}; acc[ai][bj][m][n] += xv * ALPHA; }
                if (m & 1) asm volatile("" : "+v"(acc[ai][0][m][0]), "+v"(acc[ai][0][m][1]), "+v"(acc[ai][1][m][0]), "+v"(acc[ai][1][m][1]) :: "memory"); } }
#pragma unroll
        for (int ai = 0; ai < 2; ++ai)
#pragma unroll
            for (int m = 0; m < 4; ++m) {
                float sm = 0.f;
#pragma unroll
                for (int bj = 0; bj < 2; ++bj)
#pragma unroll
                    for (int n = 0; n < 2; ++n) { const f32x4 x = acc[ai][bj][m][n]; sm += (x[0] + x[1]) + (x[2] + x[3]); }
                sm += __shfl_xor(sm, 16); sm += __shfl_xor(sm, 32);
                const float mw = sm * (1.0f / 64.0f); float q = 0.f;
#pragma unroll
                for (int bj = 0; bj < 2; ++bj)
#pragma unroll
                    for (int n = 0; n < 2; ++n) { const f32x4 d = acc[ai][bj][m][n] - mw; q += (d[0] * d[0] + d[1] * d[1]) + (d[2] * d[2] + d[3] * d[3]); }
                q += __shfl_xor(q, 16); q += __shfl_xor(q, 32);
                if (fq == 0) P[(ai * 128 + wr * 64 + m * 16 + fr) * 4 + wc] = (f32x2v){mw, q};
            }
        asm volatile("s_waitcnt lgkmcnt(0)" ::: "memory"); __builtin_amdgcn_s_barrier(); asm volatile("" ::: "memory");
        const int row = wid * 32 + (lane & 31);
        if (lane < 32) {
            const f32x2v a = P[row * 4 + 0], b = P[row * 4 + 1], c = P[row * 4 + 2], d = P[row * 4 + 3];
            const float mt = (a.x + b.x + c.x + d.x) * 0.25f;
            const float da = a.x - mt, db = b.x - mt, dc = c.x - mt, dd = d.x - mt;
            const float m2 = (a.y + b.y) + (c.y + d.y) + 64.0f * ((da * da + db * db) + (dc * dc + dd * dd));
            __hip_atomic_store(xbuf + ((size_t)(u.pm * 256 + row) * 8 + u.pn), ((u64)__float_as_uint(m2) << 32) | __float_as_uint(mt), __ATOMIC_RELAXED, __HIP_MEMORY_SCOPE_AGENT);
        }
        asm volatile("s_waitcnt vmcnt(0)" ::: "memory");
        if (lane == 0) __hip_atomic_fetch_add(cnt + 64 * u.pm, 1u, __ATOMIC_RELAXED, __HIP_MEMORY_SCOPE_AGENT);
        if (wid == 0) {
            while ((unsigned)__builtin_amdgcn_readfirstlane(__hip_atomic_load(cnt + 64 * u.pm, __ATOMIC_RELAXED, __HIP_MEMORY_SCOPE_AGENT)) < want) __builtin_amdgcn_s_sleep(2);
            __builtin_amdgcn_fence(__ATOMIC_ACQUIRE, "agent");
        }
        asm volatile("s_waitcnt vmcnt(0) lgkmcnt(0)" ::: "memory"); __builtin_amdgcn_s_barrier(); asm volatile("" ::: "memory");
        if (lane < 32) {
            const u64* slot = xbuf + (size_t)(u.pm * 256 + row) * 8; float mt[8], m2[8]; float ms = 0.f;
#pragma unroll
            for (int t = 0; t < 8; ++t) { const u64 w = __hip_atomic_load(slot + t, __ATOMIC_RELAXED, __HIP_MEMORY_SCOPE_AGENT); mt[t] = __uint_as_float((unsigned)w); m2[t] = __uint_as_float((unsigned)(w >> 32)); ms += mt[t]; }
            const float mean = ms * 0.125f; float q = 0.f;
#pragma unroll
            for (int t = 0; t < 8; ++t) { const float dm = mt[t] - mean; q += m2[t] + 256.0f * dm * dm; }
            S[row] = (f32x2v){mean, rsqrtf(q * (1.f / 2048.f) + 1e-5f)};
        }
        asm volatile("s_waitcnt lgkmcnt(0)" ::: "memory"); __builtin_amdgcn_s_barrier(); asm volatile("" ::: "memory");
#pragma unroll
        for (int bj = 0; bj < 2; ++bj)
#pragma unroll
            for (int n = 0; n < 2; ++n) { const int c = col0 + bj * 128 + n * 16; const f32x4 gv = *(const f32x4*)(g + c), bv = *(const f32x4*)(bt + c);
#pragma unroll
                for (int ai = 0; ai < 2; ++ai)
#pragma unroll
                    for (int m = 0; m < 4; ++m) { const int r = ai * 128 + wr * 64 + m * 16 + fr; const f32x2v sr = S[r]; const size_t off = (size_t)(u.pm * 256 + r) * DM + c;
                        const f32x4 o = (acc[ai][bj][m][n] - sr.x) * sr.y * gv + bv;
                        uint2 w; w.x = pack2(o[0], o[1]); w.y = pack2(o[2], o[3]); *(uint2*)(XB + off) = w; } }
    }
};
struct EpiInRope {
    static constexpr bool PERM = true, AFTER_DRAIN = false;
    bf16_t* O; const float* ROPE;
    __device__ __forceinline__ void operator()(const pg8::f32x4 (&acc)[2][2][4][2], const pg8::Unit& u, int wr, int wc, int fr, int fq) const {
        const int row0 = u.pm * 256 + wr * 64 + fr, col0 = u.pn * 256 + wc * 32 + 8 * fq;
#pragma unroll
        for (int bj = 0; bj < 2; ++bj) {
            const int G = u.pn * 2 + bj;
            const bool t1 = ((0x3FD5FULL >> G) & 1ull) != 0ull && wc == 0, t2 = ((0x3FC00000ULL >> G) & 1ull) != 0ull && (wc & 1) == 0;
#pragma unroll
            for (int ai = 0; ai < 2; ++ai)
#pragma unroll
                for (int m = 0; m < 4; ++m) {
                    const int row = row0 + ai * 128 + m * 16, pos = row & (SEQ - 1);
                    pg8::f32x4 v0 = acc[ai][bj][m][0], v1 = acc[ai][bj][m][1];
                    if (t1) {
                        const float* ct = ROPE + pos * 48 + 8 * (fq & 1);
                        const pg8::f32x4 c0 = *(const pg8::f32x4*)ct, c1 = *(const pg8::f32x4*)(ct + 4), s0 = *(const pg8::f32x4*)(ct + 16), s1 = *(const pg8::f32x4*)(ct + 20);
                        pg8::f32x4 o0, o1;
#pragma unroll
                        for (int j = 0; j < 4; ++j) { o0[j] = __shfl_xor(v0[j], 32); o1[j] = __shfl_xor(v1[j], 32); }
                        if (fq < 2) { v0 = v0 * c0 - o0 * s0; v1 = v1 * c1 - o1 * s1; }
                        else { v0 = o0 * s0 + v0 * c0; v1 = o1 * s1 + v1 * c1; }
                    } else if (t2) {
                        const float* ct = ROPE + pos * 48 + 32;
                        const pg8::f32x4 c0 = *(const pg8::f32x4*)ct, c1 = *(const pg8::f32x4*)(ct + 4), s0 = *(const pg8::f32x4*)(ct + 8), s1 = *(const pg8::f32x4*)(ct + 12);
                        pg8::f32x4 o0, o1;
#pragma unroll
                        for (int j = 0; j < 4; ++j) { o0[j] = __shfl_xor(v0[j], 16); o1[j] = __shfl_xor(v1[j], 16); }
                        if (fq == 0) { v0 = v0 * c0 - o0 * s0; v1 = v1 * c1 - o1 * s1; }
                        else if (fq == 1) { v0 = o0 * s0 + v0 * c0; v1 = o1 * s1 + v1 * c1; }
                    }
                    pg8::u32x4 w; w.x = pg8::cvt_pk_bf16(v0[0], v0[1]); w.y = pg8::cvt_pk_bf16(v0[2], v0[3]); w.z = pg8::cvt_pk_bf16(v1[0], v1[1]); w.w = pg8::cvt_pk_bf16(v1[2], v1[3]);
                    *(pg8::u32x4*)(O + (size_t)row * PW + col0 + bj * 128) = w;
                }
        }
    }
};
DEV void ph_gemm_in(const Params& p, int l, unsigned char* smem, int wg, int nwg) {
    pg8::Gemm g{p.XB, p.WINT + (size_t)l * PW * DM, TT, PW, DM};
    pg8::StaticOrder S; S.init(TT, PW, nwg, wg);
    EpiInRope E{p.P, p.ROPE};
    pg8::gemm_phase<EpiInRope, pg8::StaticOrder, false>((PG8_LAS unsigned char*)smem, g, S, E, nullptr);
}
DEV void ph_gemm_out(const Params& p, int l, const float* xres, unsigned char* smem, int wg, int nwg, int epoch) {
    pg8::Gemm g{p.OCAT, p.WOUTT + (size_t)l * DM * DM, TT, DM, DM};
    pg8::StaticOrder S; S.init(TT, DM, nwg, wg);
    if (nwg == 256) {
        EpiResLn E{p.XB, p.ln1_g + (size_t)l * DM, p.ln1_b + (size_t)l * DM, p.LNX, p.bar + 12288, 64u * (unsigned)epoch};
        pg8::gemm_phase<EpiResLn, pg8::StaticOrder, false>((PG8_LAS unsigned char*)smem, g, S, E, nullptr);
    } else {
        EpiResF32 E{p.Y, xres, ALPHA};
        pg8::gemm_phase<EpiResF32, pg8::StaticOrder, false>((PG8_LAS unsigned char*)smem, g, S, E, nullptr);
    }
}
DEV void ph_gemm_q(const Params& p, int l, unsigned char* smem, int wg, int nwg) {
    pg8::Gemm g{p.XB, p.WQT + (size_t)l * DM * DM, TT, DM, DM};
    pg8::StaticOrder S; S.init(TT, DM, nwg, wg);
    pg8::EpiF32 E{p.Q2, DM, nullptr};
    pg8::gemm_phase<pg8::EpiF32, pg8::StaticOrder, false>((PG8_LAS unsigned char*)smem, g, S, E, nullptr);
}


#ifdef PROBE_STAMP
#define TIC(k) do { if (tid_opq() == 0) ((unsigned long long*)(lds + LDS_BYTES - 192))[k] -= wall_clock64(); } while (0)
#define TOC(k) do { if (tid_opq() == 0) ((unsigned long long*)(lds + LDS_BYTES - 192))[k] += wall_clock64(); } while (0)
#else
#define TIC(k) do {} while (0)
#define TOC(k) do {} while (0)
#endif
namespace fa {
typedef short bf16x8 __attribute__((ext_vector_type(8)));
typedef short s16x4 __attribute__((ext_vector_type(4)));
typedef float f32x16 __attribute__((ext_vector_type(16)));
typedef float f32x4 __attribute__((ext_vector_type(4)));
typedef unsigned u32x4 __attribute__((ext_vector_type(4)));
constexpr int SHM_T = 16384;
constexpr int OFF_V = 0, OFF_K = 2 * SHM_T, OFF_WS = 4 * SHM_T, OFF_X = OFF_WS + 8 * 64 * 4;
#define FA_KSWZ(row, colB) ((row) * 256 + ((colB) ^ (((row) & 7) << 4)))
#define FA_SBAR() __builtin_amdgcn_sched_barrier(0)
DEV int v_st(int k, int c) { const int kk = (k & ~0xC) | ((k & 4) << 1) | ((k & 8) >> 1); return ((kk >> 3) * 4 + (c >> 5)) * 512 + ((kk & 7) * 32 + (c & 31)) * 2; }
DEV int v_rd_base(int lane) { return ((lane & 3) << 3) | (((lane >> 2) & 3) << 6) | (((lane >> 4) & 1) << 5) | (((lane >> 5) & 1) << 8); }
constexpr int v_rd_off(int d0, int ks, int half) { return d0 * 512 + ks * 4096 + half * 2048; }
DEV int crow(int r, int hi) { return (r & 3) + 8 * (r >> 2) + 4 * hi; }
DEV unsigned cvtpk(float lo, float hi) { unsigned r; asm volatile("v_cvt_pk_bf16_f32 %0, %1, %2" : "=v"(r) : "v"(lo), "v"(hi)); return r; }

template <int ND0>
DEV void qkt(f32x16& p0, f32x16& p1, const char* Kb, int kdB, int r32, int hi, const bf16x8* qr) {
    p0 = f32x16{}; p1 = f32x16{};
    const char* kb[4];
#pragma unroll
    for (int dd = 0; dd < 4; ++dd) kb[dd] = Kb + kdB + FA_KSWZ(r32, (dd * 16 + hi * 8) * 2);
#pragma unroll
    for (int d0 = 0; d0 < ND0; ++d0) { const char* a = kb[d0 & 3] + (d0 >> 2) * 128;
        const bf16x8 b0 = *reinterpret_cast<const bf16x8*>(a);
        const bf16x8 b1 = *reinterpret_cast<const bf16x8*>(a + 32 * 256);
        p0 = __builtin_amdgcn_mfma_f32_32x32x16_bf16(b0, qr[d0], p0, 0, 0, 0);
        p1 = __builtin_amdgcn_mfma_f32_32x32x16_bf16(b1, qr[d0], p1, 0, 0, 0); }
}
DEV void pv_tile(f32x16* o, int vb0, bf16x8 pa0, bf16x8 pa1, bf16x8 pa2, bf16x8 pa3) {
#define FA_TRRD(dst, off) asm volatile("ds_read_b64_tr_b16 %0, %1 offset:%2" : "=&v"(dst) : "v"(vb0), "i"(off) : "memory")
#define FA_PV_D0(d0) do { s16x4 l0, l1, l2, l3, h0, h1, h2, h3; constexpr int b_ = v_rd_off(d0, 0, 0); \
        FA_TRRD(l0, b_); FA_TRRD(h0, b_ + 2048); FA_TRRD(l1, b_ + 4096); FA_TRRD(h1, b_ + 6144); FA_TRRD(l2, b_ + 8192); FA_TRRD(h2, b_ + 10240); FA_TRRD(l3, b_ + 12288); FA_TRRD(h3, b_ + 14336); \
        asm volatile("s_waitcnt lgkmcnt(0)" ::: "memory"); FA_SBAR(); \
        o[d0] = __builtin_amdgcn_mfma_f32_32x32x16_bf16(pa0, (bf16x8){l0[0], l0[1], l0[2], l0[3], h0[0], h0[1], h0[2], h0[3]}, o[d0], 0, 0, 0); \
        o[d0] = __builtin_amdgcn_mfma_f32_32x32x16_bf16(pa1, (bf16x8){l1[0], l1[1], l1[2], l1[3], h1[0], h1[1], h1[2], h1[3]}, o[d0], 0, 0, 0); \
        o[d0] = __builtin_amdgcn_mfma_f32_32x32x16_bf16(pa2, (bf16x8){l2[0], l2[1], l2[2], l2[3], h2[0], h2[1], h2[2], h2[3]}, o[d0], 0, 0, 0); \
        o[d0] = __builtin_amdgcn_mfma_f32_32x32x16_bf16(pa3, (bf16x8){l3[0], l3[1], l3[2], l3[3], h3[0], h3[1], h3[2], h3[3]}, o[d0], 0, 0, 0); } while (0)
    FA_PV_D0(0); FA_PV_D0(1); FA_PV_D0(2); FA_PV_D0(3);
#undef FA_PV_D0
#undef FA_TRRD
}
DEV void pack_p(const f32x16& p0, const f32x16& p1, bf16x8& pa0, bf16x8& pa1, bf16x8& pa2, bf16x8& pa3) {
#define FA_PK4(P, B_, OUT) do { unsigned a0 = cvtpk(P[B_ + 0], P[B_ + 1]), a1 = cvtpk(P[B_ + 2], P[B_ + 3]); \
        unsigned b0 = cvtpk(P[B_ + 4], P[B_ + 5]), b1 = cvtpk(P[B_ + 6], P[B_ + 7]); \
        auto r0 = __builtin_amdgcn_permlane32_swap(a0, b0, false, false); auto r1 = __builtin_amdgcn_permlane32_swap(a1, b1, false, false); \
        u32x4 w = {r0[0], r1[0], r0[1], r1[1]}; OUT = *reinterpret_cast<bf16x8*>(&w); } while (0)
    FA_PK4(p0, 0, pa0); FA_PK4(p0, 8, pa1); FA_PK4(p1, 0, pa2); FA_PK4(p1, 8, pa3);
#undef FA_PK4
}
DEV float xhalf_max(float v) { auto rr = __builtin_amdgcn_permlane32_swap(__float_as_uint(v), __float_as_uint(v), false, false); return fmaxf(__uint_as_float(rr[0]), __uint_as_float(rr[1])); }
DEV float xhalf_sum(float v) { auto rr = __builtin_amdgcn_permlane32_swap(__float_as_uint(v), __float_as_uint(v), false, false); return __uint_as_float(rr[0]) + __uint_as_float(rr[1]); }

DEV void mask_tile(f32x16& p0, f32x16& p1, int dq  , unsigned W, bool en) {
#pragma unroll
    for (int r = 0; r < 16; ++r) { const int c = (r & 3) + 8 * (r >> 2);
        if (!en || (unsigned)(dq - c) >= W) p0[r] = NEG_INF;
        if (!en || (unsigned)(dq - c - 32) >= W) p1[r] = NEG_INF; }
}
DEV void softmax_tile(f32x16& p0, f32x16& p1, float& m_reg, float& l_reg, float C2, float& alpha) {
    float pmax = p0[0];
#pragma unroll
    for (int r = 1; r < 16; ++r) pmax = fmaxf(pmax, p0[r]);
#pragma unroll
    for (int r = 0; r < 16; ++r) pmax = fmaxf(pmax, p1[r]);
    pmax = xhalf_max(pmax);
    float mn;
    if (__builtin_expect(__all((pmax - m_reg) * C2 <= 11.5f), 1)) { mn = m_reg; alpha = 1.f; }
    else { mn = fmaxf(m_reg, pmax); alpha = __builtin_amdgcn_exp2f((m_reg - mn) * C2); m_reg = mn; }
    const float mnL = -mn * C2; float ps = 0.f;
#pragma unroll
    for (int r = 0; r < 16; ++r) { p0[r] = __builtin_amdgcn_exp2f(fmaf(p0[r], C2, mnL)); ps += p0[r]; }
#pragma unroll
    for (int r = 0; r < 16; ++r) { p1[r] = __builtin_amdgcn_exp2f(fmaf(p1[r], C2, mnL)); ps += p1[r]; }
    ps = xhalf_sum(ps);
    l_reg = l_reg * alpha + ps;
}
DEV void scale_rows(f32x16* o, float fac, float* wsl, int r32, int hi) {
    if (hi == 0) wsl[r32] = fac;
    asm volatile("s_waitcnt lgkmcnt(0)" ::: "memory");
#pragma unroll
    for (int r = 0; r < 16; ++r) { const float f = wsl[crow(r, hi)];
#pragma unroll
        for (int d = 0; d < 4; ++d) o[d][r] *= f; }
    asm volatile("s_waitcnt lgkmcnt(0)" ::: "memory");
}

struct KV { const bf16_t* K; const bf16_t* V; size_t stride; };

struct Stage { bf16x8 k0, k1, v0, v1; };
DEV void stage_load(Stage& s, const KV& kv, int j0, int sr, int sc) {
    const bf16_t* kp = kv.K + (size_t)(j0 + sr) * kv.stride + sc; const bf16_t* vp = kv.V + (size_t)(j0 + sr) * kv.stride + sc;
    s.v0 = *(const bf16x8*)vp; s.v1 = *(const bf16x8*)(vp + 32 * kv.stride);
    s.k0 = *(const bf16x8*)kp; s.k1 = *(const bf16x8*)(kp + 32 * kv.stride);
}
DEV void stage_write(const Stage& s, char* lds, int buf, int sr, int sc) {
    const int kws = FA_KSWZ(sr, sc * 2);
    *(bf16x8*)(lds + OFF_K + buf * SHM_T + kws) = s.k0; *(bf16x8*)(lds + OFF_K + buf * SHM_T + kws + 32 * 256) = s.k1;
    *(bf16x8*)(lds + OFF_V + buf * SHM_T + v_st(sr, sc)) = s.v0; *(bf16x8*)(lds + OFF_V + buf * SHM_T + v_st(32 + sr, sc)) = s.v1;
}

template <int ND0, bool USE_SEL>
DEV void softmax_pass(char* lds, const KV& kv, int j_lo, int j_hi, const bf16x8* qr, int kdB, int qi, int qlo, int qhi, unsigned W, u64 selbits, float C2,
                      f32x16* o, float& m_reg, float& l_reg) {
    const int tid = tid_opq(), lane = tid & 63, wid = __builtin_amdgcn_readfirstlane(tid >> 6), r32 = lane & 31, hi = lane >> 5;
    const int sr = tid >> 4, sc = (tid & 15) * 8;
    float* wsl = (float*)(lds + OFF_WS) + wid * 64;
    const int vrb = v_rd_base(lane);
    Stage st;
    __syncthreads();
    stage_load(st, kv, j_lo * 64, sr, sc); stage_write(st, lds, 0, sr, sc);
    __syncthreads();
    for (int t = j_lo; t < j_hi; ++t) {
        const int buf = (t - j_lo) & 1;
        stage_load(st, kv, (t + 1 < j_hi ? t + 1 : j_hi - 1) * 64, sr, sc);
        const int kb = t * 64;
        const bool act = (kb <= qhi) && ((unsigned)(qlo - (kb + 63)) < W || qlo - (kb + 63) < 0);
        if (act) {
            f32x16 p0, p1;
            qkt<ND0>(p0, p1, lds + OFF_K + buf * SHM_T, kdB, r32, hi, qr);
            const bool en = USE_SEL ? (((selbits >> t) & 1ull) != 0ull) : true;
            const bool full = (qlo - kb - 63 >= 0) && ((unsigned)(qhi - kb) < W);
            if (!full || (USE_SEL && __any(!en))) mask_tile(p0, p1, qi - kb - 4 * hi, W, en);
            float alpha;
            softmax_tile(p0, p1, m_reg, l_reg, C2, alpha);
            if (__any(alpha < 1.f)) scale_rows(o, alpha, wsl, r32, hi);
            bf16x8 pa0, pa1, pa2, pa3;
            pack_p(p0, p1, pa0, pa1, pa2, pa3);
            pv_tile(o, (int)(uintptr_t)(lds + OFF_V + buf * SHM_T) + vrb, pa0, pa1, pa2, pa3);
        }
        stage_write(st, lds, buf ^ 1, sr, sc);
        __syncthreads();
    }
}

template <int ND0>
DEV void load_q(bf16x8* qr, const bf16_t* qrow, int hi) {
#pragma unroll
    for (int d0 = 0; d0 < ND0; ++d0) qr[d0] = *(const bf16x8*)(qrow + d0 * 16 + hi * 8);
    __builtin_amdgcn_s_waitcnt(0x0F70);
}
template <bool ACCUM>
DEV void store_rows(f32x16* o, float fac, float* wsl, float* dst, size_t row0, size_t rstride, int ld, int r32, int hi) {
    scale_rows(o, fac, wsl, r32, hi);
#pragma unroll
    for (int r = 0; r < 16; ++r) { float* rp = dst + (row0 + rstride * (size_t)crow(r, hi)) * (size_t)ld + r32;
#pragma unroll
        for (int d = 0; d < 4; ++d) { float v = o[d][r]; if (ACCUM) v += rp[d * 32]; rp[d * 32] = v; } }
}
}

constexpr float SC128 = 0.08838834764831845f, SC64 = 0.125f, LOG2E = 1.4426950408889634f;

DEV void nsa_unit_mfma(const Params& p, int l, int unit, char* lds) {
    using namespace fa;
    const int tid = tid_opq(), lane = tid & 63, wid = __builtin_amdgcn_readfirstlane(tid >> 6), r32 = lane & 31, hi = lane >> 5;
    const int b = unit >> 6, qb = unit & 63, h = wid >> 1, tl = (wid & 1) * 32 + r32, pos = qb * 64 + tl;
    const size_t tok = (size_t)b * SEQ + pos, tok_w0 = (size_t)b * SEQ + qb * 64 + (wid & 1) * 32;
    float* wsl = (float*)(lds + OFF_WS) + wid * 64;
    float* imp = (float*)(lds + OFF_X);
    u64* selm = (u64*)(lds + OFF_X + 64 * 64 * 4);
    const bf16_t* Pb = p.P;
    bf16x8 qr[8];
    load_q<8>(qr, Pb + tok * PW + C_AQ + h * 128, hi);
    const float C2 = SC128 * LOG2E;
    const float g0 = sigmoidf_(bf2f(Pb[tok * PW + C_AG + 0 + h])), g1 = sigmoidf_(bf2f(Pb[tok * PW + C_AG + 4 + h])), g2 = sigmoidf_(bf2f(Pb[tok * PW + C_AG + 8 + h]));
    for (int i = tid; i < 64 * 64; i += 512) imp[i] = 0.f;
    float* dst = p.OACC + h * 128;
    const KV kvc{p.KCB + (size_t)b * 256 * 128, p.VCB + (size_t)b * 256 * 128, 128};
    const int qic = pos >= 31 ? (pos - 31) >> 4 : -1;
    const int posw = qb * 64 + (wid & 1) * 32, qlo_c = posw >= 31 ? (posw - 31) >> 4 : -1, qhi_c = (posw + 31 - 31) >> 4;
    {
        f32x16 o[4] = {}; float m_reg = -1e30f, l_reg = 0.f;
        softmax_pass<8, false>(lds, kvc, 0, 4, qr, 0, qic, qlo_c, qhi_c, 0x80000000u, 0ull, C2, o, m_reg, l_reg);
        store_rows<false>(o, l_reg > 0.f ? g0 / l_reg : 0.f, wsl, dst, tok_w0, 1, DM, r32, hi);
        const float mnL = -m_reg * C2, inv = l_reg > 0.f ? 1.f / l_reg : 0.f;
        const int sr = tid >> 4, sc = (tid & 15) * 8;
        for (int t = 0; t < 4; ++t) {
            __syncthreads();
            { const bf16_t* kp = kvc.K + (size_t)(t * 64 + sr) * 128 + sc; const bf16x8 k0 = *(const bf16x8*)kp, k1 = *(const bf16x8*)(kp + 32 * 128);
              const int kws = FA_KSWZ(sr, sc * 2); *(bf16x8*)(lds + OFF_K + kws) = k0; *(bf16x8*)(lds + OFF_K + kws + 32 * 256) = k1; }
            __syncthreads();
            f32x16 p0, p1;
            qkt<8>(p0, p1, lds + OFF_K, 0, r32, hi, qr);
            mask_tile(p0, p1, qic - t * 64 - 4 * hi, 0x80000000u, true);
#pragma unroll
            for (int r = 0; r < 16; ++r) { p0[r] = __builtin_amdgcn_exp2f(fmaf(p0[r], C2, mnL)) * inv; p1[r] = __builtin_amdgcn_exp2f(fmaf(p1[r], C2, mnL)) * inv; }
#pragma unroll
            for (int g = 0; g < 4; ++g) {
                { const int j = t * 16 + 2 * g + hi; const float G = (p0[4 * g] + p0[4 * g + 1]) + (p0[4 * g + 2] + p0[4 * g + 3]);
                  atomicAdd(&imp[tl * 64 + j], G); if (j + 1 < 64) atomicAdd(&imp[tl * 64 + j + 1], p0[4 * g + 3]); }
                { const int j = t * 16 + 8 + 2 * g + hi; const float G = (p1[4 * g] + p1[4 * g + 1]) + (p1[4 * g + 2] + p1[4 * g + 3]);
                  atomicAdd(&imp[tl * 64 + j], G); if (j + 1 < 64) atomicAdd(&imp[tl * 64 + j + 1], p1[4 * g + 3]); }
            }
        }
    }
    __syncthreads();
    for (int q = 0; q < 8; ++q) {
        const int tk = wid * 8 + q, tb = (qb * 64 + tk) >> 6;
        float v = imp[tk * 64 + lane];
        if (lane == 0 || lane == tb || lane == tb - 1) v += 1000.f;
        if (lane > tb) v = NEG_INF;
        int rank = 0;
        for (int jp = 0; jp < 64; ++jp) { const float ov = __shfl(v, jp); rank += (ov > v || (ov == v && jp < lane)) ? 1 : 0; }
        const u64 mk = __ballot(v != NEG_INF && rank < 16);
        if (lane == 0) selm[tk] = mk;
    }
    __syncthreads();
    const u64 sel = selm[tl];
    const int qlo = qb * 64 + (wid & 1) * 32, qhi = qlo + 31;
    {
        const KV kvs{Pb + (size_t)b * SEQ * PW + C_AKS, Pb + (size_t)b * SEQ * PW + C_AVS, (size_t)PW};
        f32x16 o[4] = {}; float m_reg = -1e30f, l_reg = 0.f;
        softmax_pass<8, true>(lds, kvs, 0, qb + 1, qr, 0, pos, qlo, qhi, 0x80000000u, sel, C2, o, m_reg, l_reg);
        store_rows<true>(o, g1 / l_reg, wsl, dst, tok_w0, 1, DM, r32, hi);
    }
    {
        const KV kvw{Pb + (size_t)b * SEQ * PW + C_AKW, Pb + (size_t)b * SEQ * PW + C_AVW, (size_t)PW};
        f32x16 o[4] = {}; float m_reg = -1e30f, l_reg = 0.f;
        softmax_pass<8, false>(lds, kvw, qb - 8 < 0 ? 0 : qb - 8, qb + 1, qr, 0, pos, qlo, qhi, 512u, 0ull, C2, o, m_reg, l_reg);
        store_rows<true>(o, g2 / l_reg, wsl, dst, tok_w0, 1, DM, r32, hi);
    }
}

DEV void dil_unit_mfma(const Params& p, int unit, char* lds) {
    using namespace fa;
    const int tid = tid_opq(), lane = tid & 63, wid = __builtin_amdgcn_readfirstlane(tid >> 6), r32 = lane & 31, hi = lane >> 5;
    const int sub = unit & 15, pat = (unit >> 4) % 3, bh = unit / 48, b = bh >> 2, h = bh & 3;
    const int dl = pat == 0 ? 1 : pat == 1 ? 4 : 16;
    const int nblk = 16 / dl, res = sub / nblk, blk = sub % nblk;
    float* wsl = (float*)(lds + OFF_WS) + wid * 64;
    const bf16_t* Pb = p.P + ((size_t)b * SEQ + res) * PW;
    const int si0 = blk * 256 + wid * 32, si = si0 + r32;
    bf16x8 qr[8];
    load_q<8>(qr, Pb + (size_t)si * dl * PW + C_BQ + h * 128, hi);
    const KV kv{Pb + C_BK + h * 128, Pb + C_BV + h * 128, (size_t)dl * PW};
    f32x16 o[4] = {}; float m_reg = -1e30f, l_reg = 0.f;
    const int j_lo = blk * 4 - 2 < 0 ? 0 : blk * 4 - 2, j_hi = blk * 4 + 4;
    softmax_pass<8, false>(lds, kv, j_lo, j_hi, qr, 0, si, si0, si0 + 31, 129u, 0ull, SC128 * LOG2E, o, m_reg, l_reg);
    const size_t tok0 = (size_t)b * SEQ + res + (size_t)si0 * dl;
    store_rows<false>(o, 1.f / l_reg, wsl, p.DILO + (size_t)pat * TT * 512 + h * 128, tok0, (size_t)dl, 512, r32, hi);
    if (hi == 0) p.DILL[(size_t)pat * TT * 4 + (tok0 + (size_t)r32 * dl) * 4 + h] = m_reg * SC128 + __logf(l_reg);
}

DEV void diff_unit_mfma(const Params& p, int unit, char* lds) {
    using namespace fa;
    const int tid = tid_opq(), lane = tid & 63, wid = __builtin_amdgcn_readfirstlane(tid >> 6), r32 = lane & 31, hi = lane >> 5;
    const int qb = 15 - (unit >> 4), map = unit & 1, h = (unit >> 1) & 3, b = (unit >> 3) & 1;
    float* wsl = (float*)(lds + OFF_WS) + wid * 64;
    const bf16_t* Pb = p.P + (size_t)b * SEQ * PW;
    const int pos0 = qb * 256 + wid * 32, pos = pos0 + r32;
    bf16x8 qr[4];
    load_q<4>(qr, Pb + (size_t)pos * PW + C_CQ + (2 * h + map) * 64, hi);
    const KV kv{Pb + C_CK + h * 128, Pb + C_CV + h * 128, (size_t)PW};
    f32x16 o[4] = {}; float m_reg = -1e30f, l_reg = 0.f;
    softmax_pass<4, false>(lds, kv, 0, qb * 4 + 4, qr, map * 128, pos, pos0, pos0 + 31, 0x80000000u, 0ull, SC64 * LOG2E, o, m_reg, l_reg);
    store_rows<false>(o, 1.f / l_reg, wsl, p.DIFO + (size_t)map * TT * 512 + h * 128, (size_t)b * SEQ + pos0, 1, 512, r32, hi);
}

DEV void stick_unit_mfma(const Params& p, int unit, char* lds) {
    using namespace fa;
    const int tid = tid_opq(), lane = tid & 63, wid = __builtin_amdgcn_readfirstlane(tid >> 6), r32 = lane & 31, hi = lane >> 5;
    const int qb = 15 - (unit >> 3), h = unit & 3, b = (unit >> 2) & 1;
    float* wsl = (float*)(lds + OFF_WS) + wid * 64;
    int* flags = (int*)(lds + LDS_FLAGS_OFF);
    const bf16_t* Pb = p.P + (size_t)b * SEQ * PW;
    const int pos0 = qb * 256 + wid * 32, pos = pos0 + r32;
    bf16x8 qr[8];
    load_q<8>(qr, Pb + (size_t)pos * PW + C_DQ + h * 128, hi);
    const KV kv{Pb + C_DK + h * 128, Pb + C_DV + h * 128, (size_t)PW};
    const int sr = tid >> 4, sc = (tid & 15) * 8, vrb = v_rd_base(lane);
    f32x16 o[4] = {};
    float carry = 0.f;
    Stage st;
    const int t_hi = qb * 4 + 3;
    __syncthreads();
    stage_load(st, kv, t_hi * 64, sr, sc); stage_write(st, lds, 0, sr, sc);
    __syncthreads();
    for (int t = t_hi; t >= 0; --t) {
        const int it = t_hi - t, buf = it & 1;
        stage_load(st, kv, (t > 0 ? t - 1 : 0) * 64, sr, sc);
        const int kb = t * 64;
        if (kb < pos0 + 31) {
            f32x16 p0, p1, q0, q1;
            qkt<8>(p0, p1, lds + OFF_K + buf * SHM_T, 0, r32, hi, qr);
            const int dq = pos - kb - 4 * hi;
#pragma unroll
            for (int r = 0; r < 16; ++r) { const int c = (r & 3) + 8 * (r >> 2);
                { const float z = p0[r] * SC128, ls = fminf(z, 0.f) - __logf(1.f + __expf(-fabsf(z))); const bool ok = (dq - c) >= 1;
                  p0[r] = ok ? ls : NEG_INF; q0[r] = ok ? ls - z : 0.f; }
                { const float z = p1[r] * SC128, ls = fminf(z, 0.f) - __logf(1.f + __expf(-fabsf(z))); const bool ok = (dq - c - 32) >= 1;
                  p1[r] = ok ? ls : NEG_INF; q1[r] = ok ? ls - z : 0.f; } }
            float gs[8], og[8], aft[8];
#pragma unroll
            for (int g = 0; g < 4; ++g) { gs[g] = (q0[4 * g] + q0[4 * g + 1]) + (q0[4 * g + 2] + q0[4 * g + 3]); gs[4 + g] = (q1[4 * g] + q1[4 * g + 1]) + (q1[4 * g + 2] + q1[4 * g + 3]); }
#pragma unroll
            for (int i = 0; i < 8; ++i) og[i] = __shfl_xor(gs[i], 32);
            float run = 0.f;
#pragma unroll
            for (int pi = 7; pi >= 0; --pi) { const float vo = hi ? gs[pi] : og[pi], ve = hi ? og[pi] : gs[pi];
                const float ao = run; run += vo; const float ae = run; run += ve; aft[pi] = hi ? ao : ae; }
#pragma unroll
            for (int g = 0; g < 4; ++g) {
                { float tl = carry + aft[g];
                  const float a3 = __expf(p0[4 * g + 3] + tl); tl += q0[4 * g + 3]; const float a2 = __expf(p0[4 * g + 2] + tl); tl += q0[4 * g + 2];
                  const float a1 = __expf(p0[4 * g + 1] + tl); tl += q0[4 * g + 1]; const float a0 = __expf(p0[4 * g] + tl);
                  p0[4 * g] = a0; p0[4 * g + 1] = a1; p0[4 * g + 2] = a2; p0[4 * g + 3] = a3; }
                { float tl = carry + aft[4 + g];
                  const float a3 = __expf(p1[4 * g + 3] + tl); tl += q1[4 * g + 3]; const float a2 = __expf(p1[4 * g + 2] + tl); tl += q1[4 * g + 2];
                  const float a1 = __expf(p1[4 * g + 1] + tl); tl += q1[4 * g + 1]; const float a0 = __expf(p1[4 * g] + tl);
                  p1[4 * g] = a0; p1[4 * g + 1] = a1; p1[4 * g + 2] = a2; p1[4 * g + 3] = a3; }
            }
            carry += run;
            bf16x8 pa0, pa1, pa2, pa3;
            pack_p(p0, p1, pa0, pa1, pa2, pa3);
            pv_tile(o, (int)(uintptr_t)(lds + OFF_V + buf * SHM_T) + vrb, pa0, pa1, pa2, pa3);
        }
        const int wok = __all(carry < -110.f) ? 1 : 0;
        if (lane == 0) flags[(it & 1) * 8 + wid] = wok;
        stage_write(st, lds, buf ^ 1, sr, sc);
        __syncthreads();
        int all_ok = 1;
#pragma unroll
        for (int w = 0; w < 8; ++w) all_ok &= flags[(it & 1) * 8 + w];
        if (all_ok) break;
    }
    store_rows<false>(o, 1.f, wsl, p.OACC + 1536 + h * 128, (size_t)b * SEQ + pos0, 1, DM, r32, hi);
}

DEV void ph_attn_final(const Params& p, int l, int wg, int nwg) {
    const int tid = tid_opq(), wave = tid >> 6, lane = tid & 63;
    const float* lp = p.diff_lambda + (size_t)l * 256;
    const float d01 = wave_sum(lp[lane] * lp[64 + lane]), d23 = wave_sum(lp[128 + lane] * lp[192 + lane]);
    const float lam_init = 0.8f - 0.6f * expf(-0.3f * (float)l), lam = expf(d01) - expf(d23) + lam_init;
    const float* gg = p.diff_g + (size_t)l * 128;
    const int c = lane * 8, hd = lane >> 4;
    const float4 ga = *(const float4*)(gg + (c & 127)), gb = *(const float4*)(gg + (c & 127) + 4);
    for (int tok = wg * 8 + wave; tok < TT; tok += nwg * 8) {
        bf16_t* orow = p.OCAT + (size_t)tok * DM;
        { const float* n0 = p.NSAO + (size_t)tok * 512 + c; const float* n1 = n0 + (size_t)TT * 512; const float* n2 = n1 + (size_t)TT * 512;
          const float4 a0 = *(const float4*)n0, b0 = *(const float4*)(n0 + 4), a1 = *(const float4*)n1, b1 = *(const float4*)(n1 + 4), a2 = *(const float4*)n2, b2 = *(const float4*)(n2 + 4);
          uint4 w; w.x = pack2(a0.x + a1.x + a2.x, a0.y + a1.y + a2.y); w.y = pack2(a0.z + a1.z + a2.z, a0.w + a1.w + a2.w);
          w.z = pack2(b0.x + b1.x + b2.x, b0.y + b1.y + b2.y); w.w = pack2(b0.z + b1.z + b2.z, b0.w + b1.w + b2.w); *(uint4*)(orow + c) = w; }
        { const float l0 = p.DILL[(size_t)0 * TT * 4 + (size_t)tok * 4 + hd], l1 = p.DILL[(size_t)1 * TT * 4 + (size_t)tok * 4 + hd], l2 = p.DILL[(size_t)2 * TT * 4 + (size_t)tok * 4 + hd];
          const float mx = fmaxf(l0, fmaxf(l1, l2)); float w0 = __expf(l0 - mx), w1 = __expf(l1 - mx), w2 = __expf(l2 - mx); const float inv = 1.f / (w0 + w1 + w2); w0 *= inv; w1 *= inv; w2 *= inv;
          const float* s0 = p.DILO + (size_t)tok * 512 + c; const float* s1 = s0 + (size_t)TT * 512; const float* s2 = s1 + (size_t)TT * 512;
          const float4 a0 = *(const float4*)s0, b0 = *(const float4*)(s0 + 4), a1 = *(const float4*)s1, b1 = *(const float4*)(s1 + 4), a2 = *(const float4*)s2, b2 = *(const float4*)(s2 + 4);
          uint4 w; w.x = pack2(w0 * a0.x + w1 * a1.x + w2 * a2.x, w0 * a0.y + w1 * a1.y + w2 * a2.y); w.y = pack2(w0 * a0.z + w1 * a1.z + w2 * a2.z, w0 * a0.w + w1 * a1.w + w2 * a2.w);
          w.z = pack2(w0 * b0.x + w1 * b1.x + w2 * b2.x, w0 * b0.y + w1 * b1.y + w2 * b2.y); w.w = pack2(w0 * b0.z + w1 * b1.z + w2 * b2.z, w0 * b0.w + w1 * b1.w + w2 * b2.w);
          *(uint4*)(orow + 512 + c) = w; }
        { const float* s0 = p.DIFO + (size_t)tok * 512 + c; const float* s1 = s0 + (size_t)TT * 512;
          const float4 a0 = *(const float4*)s0, b0 = *(const float4*)(s0 + 4), a1 = *(const float4*)s1, b1 = *(const float4*)(s1 + 4);
          float v[8] = {a0.x - lam * a1.x, a0.y - lam * a1.y, a0.z - lam * a1.z, a0.w - lam * a1.w, b0.x - lam * b1.x, b0.y - lam * b1.y, b0.z - lam * b1.z, b0.w - lam * b1.w};
          float ss = (v[0] * v[0] + v[1] * v[1]) + (v[2] * v[2] + v[3] * v[3]) + (v[4] * v[4] + v[5] * v[5]) + (v[6] * v[6] + v[7] * v[7]);
          ss += __shfl_xor(ss, 1); ss += __shfl_xor(ss, 2); ss += __shfl_xor(ss, 4); ss += __shfl_xor(ss, 8);
          const float rs = rsqrtf(ss * (1.f / 128.f) + 1e-6f) * (1.f - lam_init);
          uint4 w; w.x = pack2(v[0] * rs * ga.x, v[1] * rs * ga.y); w.y = pack2(v[2] * rs * ga.z, v[3] * rs * ga.w); w.z = pack2(v[4] * rs * gb.x, v[5] * rs * gb.y); w.w = pack2(v[6] * rs * gb.z, v[7] * rs * gb.w);
          *(uint4*)(orow + 1024 + c) = w; }
        { const float4 a = *(const float4*)(p.OACC + (size_t)tok * DM + 1536 + c), bb = *(const float4*)(p.OACC + (size_t)tok * DM + 1536 + c + 4);
          uint4 w; w.x = pack2(a.x, a.y); w.y = pack2(a.z, a.w); w.z = pack2(bb.x, bb.y); w.w = pack2(bb.z, bb.w); *(uint4*)(orow + 1536 + c) = w; }
    }
}


namespace fa {
constexpr int S2_V = 0, S2_K = 5 * SHM_T, S2_WS = 9 * SHM_T, S2_X = S2_WS + 8 * 64 * 4;
struct Stage2 { bf16x8 k[4], v[4]; };
DEV void stage2_load(Stage2& s, const KV& kv, int j0  , int sr16, int sc) {
#pragma unroll
    for (int i = 0; i < 4; ++i) { const size_t ro = (size_t)(j0 + sr16 + 16 * i) * kv.stride + sc; s.v[i] = *(const bf16x8*)(kv.V + ro); s.k[i] = *(const bf16x8*)(kv.K + ro); }
}
DEV void stage2_write(const Stage2& s, char* lds, int kslot, int vslot, int sr16, int sc) {
#pragma unroll
    for (int i = 0; i < 4; ++i) { const int row = sr16 + 16 * i;
        *(bf16x8*)(lds + S2_K + kslot * SHM_T + FA_KSWZ(row, sc * 2)) = s.k[i];
        *(bf16x8*)(lds + S2_V + vslot * SHM_T + v_st(row, sc)) = s.v[i]; }
}
DEV int vslot2(int g, int s) { return g == 0 ? (s & 1) : 2 + (s % 3); }
template <int ND0, bool USE_SEL, bool KEEP_K = false>
DEV void softmax_pass2(char* lds, const KV& kv, int j_lo, int j_hi, const bf16x8* qr, int kdB, int qi, int qlo, int qhi, unsigned W, u64 selbits, float C2,
                       f32x16* o, float& m_reg, float& l_reg) {
    const int tid = tid_opq(), lane = tid & 63, wid = __builtin_amdgcn_readfirstlane(tid >> 6), r32 = lane & 31, hi = lane >> 5;
    const int grp = wid >> 2, wr = wid & 3;
    const int sg = tid >> 8, sr16 = (tid & 255) >> 4, sc = (tid & 15) * 8;
    float* wsl = (float*)(lds + S2_WS) + wid * 64;
    const int vrb = v_rd_base(lane);
    const int ns = (j_hi - j_lo + 1) >> 1;
    Stage2 st;
    TIC(5);
    __syncthreads();
    { const int t0 = j_lo + sg < j_hi ? j_lo + sg : j_hi - 1; stage2_load(st, kv, t0 * 64, sr16, sc); stage2_write(st, lds, sg, vslot2(sg, 0), sr16, sc); }
    __syncthreads();
    TOC(5); TIC(1);
#define FA_SP(P0_, P1_, VSLOT_) do { float alpha_; softmax_tile(P0_, P1_, m_reg, l_reg, C2, alpha_); if (__any(alpha_ < 1.f)) scale_rows(o, alpha_, wsl, r32, hi); \
        bf16x8 pa0_, pa1_, pa2_, pa3_; pack_p(P0_, P1_, pa0_, pa1_, pa2_, pa3_); pv_tile(o, (int)(uintptr_t)(lds + S2_V + (VSLOT_) * SHM_T) + vrb, pa0_, pa1_, pa2_, pa3_); } while (0)
    for (int s = 0; s < ns; ++s) {
        const int buf = s & 1; int tn = j_lo + 2 * (s + 1) + sg; tn = tn < j_hi ? tn : j_hi - 1;
        stage2_load(st, kv, tn * 64, sr16, sc);
        const int t = j_lo + 2 * s + grp, kb = t * 64;
        const bool act = (t < j_hi) && (kb <= qhi) && ((unsigned)(qlo - (kb + 63)) < W || qlo - (kb + 63) < 0);
        if (act) {
            f32x16 p0, p1;
            qkt<ND0>(p0, p1, lds + S2_K + (buf * 2 + grp) * SHM_T, kdB, r32, hi, qr);
            const bool en = USE_SEL ? (((selbits >> t) & 1ull) != 0ull) : true;
            const bool full = (qlo - kb - 63 >= 0) && ((unsigned)(qhi - kb) < W);
            if (!full || (USE_SEL && __any(!en))) mask_tile(p0, p1, qi - kb - 4 * hi, W, en);
            FA_SP(p0, p1, vslot2(grp, s));
        }
        if (!KEEP_K || s + 1 < ns) stage2_write(st, lds, (buf ^ 1) * 2 + sg, vslot2(sg, s + 1), sr16, sc);
        __syncthreads();
    }
#undef FA_SP
    __syncthreads();
    TOC(1); TIC(2);
    float* mo = (float*)(lds + S2_V) + wr * 4096;
    float* ml = (float*)(lds + S2_X + 8704) + wr * 128;
    if (grp == 1) {
#pragma unroll
        for (int d = 0; d < 4; ++d)
#pragma unroll
            for (int r = 0; r < 16; ++r) mo[(d * 16 + r) * 64 + lane] = o[d][r];
        ml[lane] = m_reg; ml[64 + lane] = l_reg;
    }
    __syncthreads();
    if (grp == 0) {
        const float m1 = ml[lane], l1 = ml[64 + lane], mn = fmaxf(m_reg, m1);
        const float a0 = __builtin_amdgcn_exp2f((m_reg - mn) * C2), a1 = __builtin_amdgcn_exp2f((m1 - mn) * C2);
        l_reg = l_reg * a0 + l1 * a1; m_reg = mn;
        if (hi == 0) { wsl[r32] = a0; wsl[32 + r32] = a1; }
        asm volatile("s_waitcnt lgkmcnt(0)" ::: "memory");
#pragma unroll
        for (int r = 0; r < 16; ++r) { const float f0 = wsl[crow(r, hi)], f1 = wsl[32 + crow(r, hi)];
#pragma unroll
            for (int d = 0; d < 4; ++d) o[d][r] = o[d][r] * f0 + mo[(d * 16 + r) * 64 + lane] * f1; }
        asm volatile("s_waitcnt lgkmcnt(0)" ::: "memory");
    }
    __syncthreads();
    if (grp == 0) { ml[lane] = m_reg; ml[64 + lane] = l_reg; }
    __syncthreads();
    if (grp == 1) { m_reg = ml[lane]; l_reg = ml[64 + lane]; }
    TOC(2);
}
}

DEV void nsa_unit2(const Params& p, int l, int unit, char* lds) {
    using namespace fa;
    const int tid = tid_opq(), lane = tid & 63, wid = __builtin_amdgcn_readfirstlane(tid >> 6), r32 = lane & 31, hi = lane >> 5;
    const int grp = wid >> 2, h = wid & 3;
    const int b = unit >> 7, blk = unit & 127, qb = blk >> 1, pos0 = blk * 32, pos = pos0 + r32;
    const size_t tok = (size_t)b * SEQ + pos, tok0 = (size_t)b * SEQ + pos0;
    float* wsl = (float*)(lds + S2_WS) + wid * 64;
    unsigned* imp = (unsigned*)(lds + S2_X);
    u64* selm = (u64*)(lds + S2_X + 32 * 65 * 4 + 8);
    const bf16_t* Pb = p.P;
    bf16x8 qr[8];
    load_q<8>(qr, Pb + tok * PW + C_AQ + h * 128, hi);
    const float C2 = SC128 * LOG2E;
    const float g0 = sigmoidf_(bf2f(Pb[tok * PW + C_AG + 0 + h])), g1 = sigmoidf_(bf2f(Pb[tok * PW + C_AG + 4 + h])), g2 = sigmoidf_(bf2f(Pb[tok * PW + C_AG + 8 + h]));
    for (int i = tid; i < 32 * 65; i += 512) imp[i] = 0u;
    float* dst = p.NSAO + h * 128;
    const KV kvc{p.KCB + (size_t)b * 256 * 128, p.VCB + (size_t)b * 256 * 128, 128};
    const int qic = pos >= 31 ? (pos - 31) >> 4 : -1;
    const int qlo_c = pos0 >= 31 ? (pos0 - 31) >> 4 : -1, qhi_c = pos0 >> 4;
    {
        f32x16 o[4] = {}; float m_reg = -1e30f, l_reg = 0.f;
        softmax_pass2<8, false, true>(lds, kvc, 0, 4, qr, 0, qic, qlo_c, qhi_c, 0x80000000u, 0ull, C2, o, m_reg, l_reg);
        if (grp == 0) store_rows<false>(o, l_reg > 0.f ? g0 / l_reg : 0.f, wsl, dst, tok0, 1, 512, r32, hi);
        TIC(3);
        const float mnL = -m_reg * C2, inv = l_reg > 0.f ? 1.f / l_reg : 0.f;
        for (int s = 0; s < 2; ++s) {
            const int t = 2 * s + grp;
            f32x16 p0, p1;
            qkt<8>(p0, p1, lds + S2_K + t * SHM_T, 0, r32, hi, qr);
            mask_tile(p0, p1, qic - t * 64 - 4 * hi, 0x80000000u, true);
#pragma unroll
            for (int r = 0; r < 16; ++r) { p0[r] = __builtin_amdgcn_exp2f(fmaf(p0[r], C2, mnL)) * inv; p1[r] = __builtin_amdgcn_exp2f(fmaf(p1[r], C2, mnL)) * inv; }
#pragma unroll
            for (int g = 0; g < 4; ++g) {
                { const int j = t * 16 + 2 * g + hi; const float G = (p0[4 * g] + p0[4 * g + 1]) + (p0[4 * g + 2] + p0[4 * g + 3]);
                  atomicAdd(&imp[r32 * 65 + j], (unsigned)(G * 16777216.f + 0.5f)); if (j + 1 < 64) atomicAdd(&imp[r32 * 65 + j + 1], (unsigned)(p0[4 * g + 3] * 16777216.f + 0.5f)); }
                { const int j = t * 16 + 8 + 2 * g + hi; const float G = (p1[4 * g] + p1[4 * g + 1]) + (p1[4 * g + 2] + p1[4 * g + 3]);
                  atomicAdd(&imp[r32 * 65 + j], (unsigned)(G * 16777216.f + 0.5f)); if (j + 1 < 64) atomicAdd(&imp[r32 * 65 + j + 1], (unsigned)(p1[4 * g + 3] * 16777216.f + 0.5f)); }
            }
        }
    }
    __syncthreads();
    for (int q = 0; q < 4; ++q) {
        const int tk = wid * 4 + q;
        float v = (float)imp[tk * 65 + lane] * (1.f / 16777216.f);
        if (lane == 0 || lane == qb || lane == qb - 1) v += 1000.f;
        if (lane > qb) v = NEG_INF;
        int rank = 0;
        for (int jp = 0; jp < 64; ++jp) { const float ov = __shfl(v, jp); rank += (ov > v || (ov == v && jp < lane)) ? 1 : 0; }
        const u64 mk = __ballot(v != NEG_INF && rank < 16);
        if (lane == 0) selm[tk] = mk;
    }
    __syncthreads();
    TOC(3);
    const u64 sel = selm[r32];
    const int qlo = pos0, qhi = pos0 + 31;
    {
        const KV kvs{Pb + (size_t)b * SEQ * PW + C_AKS, Pb + (size_t)b * SEQ * PW + C_AVS, (size_t)PW};
        f32x16 o[4] = {}; float m_reg = -1e30f, l_reg = 0.f;
        softmax_pass2<8, true>(lds, kvs, 0, qb + 1, qr, 0, pos, qlo, qhi, 0x80000000u, sel, C2, o, m_reg, l_reg);
        if (grp == 0) store_rows<false>(o, g1 / l_reg, wsl, dst + (size_t)TT * 512, tok0, 1, 512, r32, hi);
    }
    {
        const KV kvw{Pb + (size_t)b * SEQ * PW + C_AKW, Pb + (size_t)b * SEQ * PW + C_AVW, (size_t)PW};
        f32x16 o[4] = {}; float m_reg = -1e30f, l_reg = 0.f;
        softmax_pass2<8, false>(lds, kvw, qb - 8 < 0 ? 0 : qb - 8, qb + 1, qr, 0, pos, qlo, qhi, 512u, 0ull, C2, o, m_reg, l_reg);
        if (grp == 0) store_rows<false>(o, g2 / l_reg, wsl, dst + (size_t)2 * TT * 512, tok0, 1, 512, r32, hi);
    }
}

DEV void diff_unit2(const Params& p, int unit, char* lds) {
    using namespace fa;
    const int tid = tid_opq(), lane = tid & 63, wid = __builtin_amdgcn_readfirstlane(tid >> 6), r32 = lane & 31, hi = lane >> 5;
    const int grp = wid >> 2, wr = wid & 3;
    const int qb = 31 - (unit >> 4), map = unit & 1, h = (unit >> 1) & 3, b = (unit >> 3) & 1;
    float* wsl = (float*)(lds + S2_WS) + wid * 64;
    const bf16_t* Pb = p.P + (size_t)b * SEQ * PW;
    const int pos0 = qb * 128 + wr * 32, pos = pos0 + r32;
    bf16x8 qr[4];
    load_q<4>(qr, Pb + (size_t)pos * PW + C_CQ + (2 * h + map) * 64, hi);
    const KV kv{Pb + C_CK + h * 128, Pb + C_CV + h * 128, (size_t)PW};
    f32x16 o[4] = {}; float m_reg = -1e30f, l_reg = 0.f;
    softmax_pass2<4, false>(lds, kv, 0, qb * 2 + 2, qr, map * 128, pos, pos0, pos0 + 31, 0x80000000u, 0ull, SC64 * LOG2E, o, m_reg, l_reg);
    if (grp == 0) store_rows<false>(o, 1.f / l_reg, wsl, p.DIFO + (size_t)map * TT * 512 + h * 128, (size_t)b * SEQ + pos0, 1, 512, r32, hi);
}

DEV void ph_cmp_bias(const Params& p, float* lds, int wg, int nwg) {
    const int tid = tid_opq(), j4 = tid & 15, ks = tid >> 4;
    for (int u = wg; u < NL * 2 * 4 * 8; u += nwg) {
        const int lk = u >> 5, jb = (u >> 3) & 3, kp = u & 7, k0 = kp * 512 + ks * 16;
        const float* w1 = p.cmp_w1 + (size_t)lk * 4096 * 256 + (size_t)k0 * 256 + jb * 64 + j4 * 4; const float* pe = p.cmp_pe + (size_t)lk * 4096 + k0;
        float4 s = make_float4(0.f, 0.f, 0.f, 0.f);
#pragma unroll
        for (int k = 0; k < 16; ++k) { const float4 w = *(const float4*)(w1 + (size_t)k * 256); const float e = pe[k]; s.x += e * w.x; s.y += e * w.y; s.z += e * w.z; s.w += e * w.w; }
        __syncthreads();
        *(float4*)(lds + ks * 64 + j4 * 4) = s;
        __syncthreads();
        if (tid < 64) { float t = 0.f;
#pragma unroll
            for (int q = 0; q < 32; ++q) t += lds[q * 64 + tid];
            p.CB[(size_t)(lk * 8 + kp) * 256 + jb * 64 + tid] = t; }
    }
}
DEV void compress_unit_mfma(const Params& p, int l, int unit, char* lds) {
    using namespace fa;
    const int tid = tid_opq(), lane = tid & 63, wid = __builtin_amdgcn_readfirstlane(tid >> 6), r32 = lane & 31, hi = lane >> 5;
    const int kv = unit >> 4, b = (unit >> 3) & 1, rt = unit & 7;
    const int col = kv ? C_AVC : C_AKC;
    const bf16_t* W1T = p.W1T + ((size_t)l * 2 + kv) * 256 * 4096; const bf16_t* W2T = p.W2T + ((size_t)l * 2 + kv) * 128 * 256;
    constexpr int PITCH = 272;
    char* As = lds;
    char* Bs = lds + 32 * PITCH + wid * (32 * PITCH);
    bf16_t* hid = (bf16_t*)(lds + 9 * 32 * PITCH);
    const int arow = tid >> 4, apc = tid & 15;
    int atok0 = 16 * (rt * 32 + arow);
    const bf16_t* abase = p.P + ((size_t)b * SEQ) * PW + col + apc * 8;
    const bf16_t* bbase = W1T + (size_t)(wid * 32 + (lane >> 4)) * 4096 + (lane & 15) * 8;
    __syncthreads();
    f32x16 acc = {};
    bf16x8 ra, rb[8];
    { int tk = atok0; tk = tk > SEQ - 1 ? SEQ - 1 : tk; ra = *(const bf16x8*)(abase + (size_t)tk * PW);
#pragma unroll
      for (int i = 0; i < 8; ++i) rb[i] = *(const bf16x8*)(bbase + (size_t)(4 * i) * 4096); }
    for (int tl = 0; tl < 32; ++tl) {
        __syncthreads();
        *(bf16x8*)(As + arow * PITCH + apc * 16) = ra;
#pragma unroll
        for (int i = 0; i < 8; ++i) *(bf16x8*)(Bs + ((lane >> 4) + 4 * i) * PITCH + (lane & 15) * 16) = rb[i];
        __syncthreads();
        { const int tn = tl < 31 ? tl + 1 : 31; int tk = atok0 + tn; tk = tk > SEQ - 1 ? SEQ - 1 : tk;
          ra = *(const bf16x8*)(abase + (size_t)tk * PW);
#pragma unroll
          for (int i = 0; i < 8; ++i) rb[i] = *(const bf16x8*)(bbase + (size_t)(4 * i) * 4096 + tn * 128); }
#pragma unroll
        for (int s = 0; s < 8; ++s) {
            const bf16x8 a = *(const bf16x8*)(As + r32 * PITCH + s * 32 + hi * 16);
            const bf16x8 bb = *(const bf16x8*)(Bs + r32 * PITCH + s * 32 + hi * 16);
            acc = __builtin_amdgcn_mfma_f32_32x32x16_bf16(a, bb, acc, 0, 0, 0);
        }
    }
    {
        float bias = 0.f;
#pragma unroll
        for (int kp = 0; kp < 8; ++kp) bias += p.CB[(((size_t)l * 2 + kv) * 8 + kp) * 256 + wid * 32 + r32];
#pragma unroll
        for (int r = 0; r < 16; ++r) hid[crow(r, hi) * 264 + wid * 32 + r32] = f2bf(gelu_tanh(acc[r] + bias));
    }
    __syncthreads();
    if (wid < 4) {
        f32x16 acc2 = {};
        const bf16_t* brow = W2T + (size_t)(wid * 32 + r32) * 256 + hi * 8;
#pragma unroll
        for (int s = 0; s < 16; ++s) {
            const bf16x8 a = *(const bf16x8*)(hid + r32 * 264 + s * 16 + hi * 8);
            const bf16x8 bb = *(const bf16x8*)(brow + s * 16);
            acc2 = __builtin_amdgcn_mfma_f32_32x32x16_bf16(a, bb, acc2, 0, 0, 0);
        }
        bf16_t* dst = (kv ? p.VCB : p.KCB) + ((size_t)b * 256 + rt * 32) * 128 + wid * 32 + r32;
#pragma unroll
        for (int r = 0; r < 16; ++r) { const int row = crow(r, hi); dst[(size_t)row * 128] = (rt * 32 + row < 255) ? f2bf(acc2[r]) : (bf16_t)0; }
    }
}

DEV int next_unit_x(unsigned* ctrs, int nper, int& xq, int& tries, char* lds) {
    int* slot = (int*)(lds + LDS_SLOT_OFF);
    __syncthreads();
    if (tid_opq() < 64) {
        const int lane = tid_opq();
        int q = xq, i = -1, done = tries;
        while (!done) {
            int v = 0;
            if (lane == 0) v = (int)atomicAdd(ctrs + q * 64, 1u);
            v = __builtin_amdgcn_readfirstlane(v);
            if (v < nper) { i = v; break; }
            const int c = lane < 8 ? (int)xb_ld(ctrs + lane * 64) : nper;
            const unsigned m = (unsigned)(__ballot(c < nper) & 0xFFull);
            if (!m) { done = 1; break; }
            const unsigned rot = ((m >> q) | (m << (8 - q))) & 0xFFu;
            q = (q + __builtin_ctz(rot)) & 7;
        }
        if (lane == 0) { slot[0] = i; slot[1] = q; slot[2] = done; }
    }
    __syncthreads();
    const int i = slot[0]; xq = slot[1]; tries = slot[2];
    return i;
}
DEV int next_unit(unsigned* ctr, char* lds) {
    int* slot = (int*)(lds + LDS_SLOT_OFF);
    __syncthreads();
    if (tid_opq() == 0) *slot = (int)atomicAdd(ctr, 1u);
    __syncthreads();
    return *slot;
}

typedef float f32x2_t __attribute__((ext_vector_type(2)));
typedef _Float16 h2_t __attribute__((ext_vector_type(2)));
constexpr float U8_SCALE = 64.f, V8_SCALE = 16.f;
DEV void ph_cvt8(const float* __restrict__ src, unsigned char* __restrict__ dst, size_t n, float scale, int wg, int nwg) {
    const size_t n4 = n / 4;
    const int tid = tid_opq(), lane = tid & 63, gw = wg * 8 + (tid >> 6), nw = nwg * 8;
    for (size_t b = (size_t)gw * 256; b < n4; b += (size_t)nw * 256) {
#pragma unroll
        for (int j = 0; j < 4; ++j) { const float4 a = ((const float4*)src)[b + j * 64 + lane]; int w = 0;
            w = __builtin_amdgcn_cvt_pk_fp8_f32(a.x * scale, a.y * scale, w, false); w = __builtin_amdgcn_cvt_pk_fp8_f32(a.z * scale, a.w * scale, w, true);
            ((int*)dst)[b + j * 64 + lane] = w; }
    }
}
template <int CTRL> DEV float dpp_f(float v) { return __int_as_float(__builtin_amdgcn_update_dpp(0, __float_as_int(v), CTRL, 0xF, 0xF, false)); }
DEV float wave_sum_uniform(float v) {
    v += dpp_f<0xB1>(v); v += dpp_f<0x4E>(v); v += dpp_f<0x141>(v); v += dpp_f<0x140>(v);
    const float a = __int_as_float(__builtin_amdgcn_readlane(__float_as_int(v), 0)), b = __int_as_float(__builtin_amdgcn_readlane(__float_as_int(v), 16));
    const float c = __int_as_float(__builtin_amdgcn_readlane(__float_as_int(v), 32)), d = __int_as_float(__builtin_amdgcn_readlane(__float_as_int(v), 48));
    return (a + b) + (c + d);
}
DEV float dot16_fp8(const uint4 w, const float* x) {
    float s = 0.f;
    f32x2_t t;
    t = __builtin_amdgcn_cvt_pk_f32_fp8((int)w.x, false); s += t.x * x[0] + t.y * x[1];   t = __builtin_amdgcn_cvt_pk_f32_fp8((int)w.x, true); s += t.x * x[2] + t.y * x[3];
    t = __builtin_amdgcn_cvt_pk_f32_fp8((int)w.y, false); s += t.x * x[4] + t.y * x[5];   t = __builtin_amdgcn_cvt_pk_f32_fp8((int)w.y, true); s += t.x * x[6] + t.y * x[7];
    t = __builtin_amdgcn_cvt_pk_f32_fp8((int)w.z, false); s += t.x * x[8] + t.y * x[9];   t = __builtin_amdgcn_cvt_pk_f32_fp8((int)w.z, true); s += t.x * x[10] + t.y * x[11];
    t = __builtin_amdgcn_cvt_pk_f32_fp8((int)w.w, false); s += t.x * x[12] + t.y * x[13]; t = __builtin_amdgcn_cvt_pk_f32_fp8((int)w.w, true); s += t.x * x[14] + t.y * x[15];
    return s;
}
typedef float f32x4_t __attribute__((ext_vector_type(4)));
DEV void ph_peer_u(const Params& p, int l, unsigned char* smem, int wg, int nwg) {
    const int tid = tid_opq(), wave = __builtin_amdgcn_readfirstlane(tid_opq() >> 6), lane = tid & 63, r = lane & 15, q = lane >> 4;
    const unsigned char* U8l = p.U8 + (size_t)l * 16384 * 2048;
    unsigned char* x8 = smem;
    unsigned* sorted = (unsigned*)(smem + 65536);
    int* hist = (int*)(smem + 65536 + 16384);
    unsigned char* ring = smem + 82944 + wave * 8192;
    for (int unit = wg; unit < TT / 32; unit += nwg) {
        const int tok0 = unit * 32;
        __syncthreads();
        if (tid < 128) hist[tid] = 0;
        for (int t = wave; t < 32; t += 8) {
            const uint4* xs = (const uint4*)(p.XB + (size_t)(tok0 + t) * DM + lane * 32);
            int w[8];
#pragma unroll
            for (int i = 0; i < 4; ++i) { const uint4 a = xs[i]; int v = 0; v = __builtin_amdgcn_cvt_pk_fp8_f32(bflo(a.x), bfhi(a.x), v, false); v = __builtin_amdgcn_cvt_pk_fp8_f32(bflo(a.y), bfhi(a.y), v, true); w[2 * i] = v;
                v = 0; v = __builtin_amdgcn_cvt_pk_fp8_f32(bflo(a.z), bfhi(a.z), v, false); v = __builtin_amdgcn_cvt_pk_fp8_f32(bflo(a.w), bfhi(a.w), v, true); w[2 * i + 1] = v; }
            *(uint4*)(x8 + t * 2048 + (((lane * 2) ^ (t & 15)) << 4)) = make_uint4((unsigned)w[0], (unsigned)w[1], (unsigned)w[2], (unsigned)w[3]);
            *(uint4*)(x8 + t * 2048 + (((lane * 2 + 1) ^ (t & 15)) << 4)) = make_uint4((unsigned)w[4], (unsigned)w[5], (unsigned)w[6], (unsigned)w[7]);
        }
        int ev[8];
#pragma unroll
        for (int i = 0; i < 8; ++i) ev[i] = p.EIDX[(size_t)tok0 * 128 + i * 512 + tid];
        __syncthreads();
#pragma unroll
        for (int i = 0; i < 8; ++i) atomicAdd(&hist[ev[i] >> 7], 1);
        __syncthreads();
        if (tid < 64) {
            const int a = hist[2 * tid], b = hist[2 * tid + 1]; int s = a + b;
#pragma unroll
            for (int o = 1; o < 64; o <<= 1) { const int t2 = __shfl_up(s, o); if (tid >= o) s += t2; }
            const int ex = s - (a + b); hist[2 * tid] = ex; hist[2 * tid + 1] = ex + a;
        }
        __syncthreads();
#pragma unroll
        for (int i = 0; i < 8; ++i) { const int pos = atomicAdd(&hist[ev[i] >> 7], 1); sorted[pos] = ((unsigned)ev[i] << 12) | (unsigned)(i * 512 + tid); }
        __syncthreads();
#define PU_DMA(src_, slot_) __builtin_amdgcn_global_load_lds((const unsigned*)(src_), (LAS unsigned*)(ring + (slot_) * 1024), 16, 0, 0)
        const int lr = lane >> 2, lq = lane & 3; const unsigned ring_a = (unsigned)(uintptr_t)ring + (unsigned)((r * 4 + q) * 16), x8_a = (unsigned)(uintptr_t)x8, sorted_a = (unsigned)(uintptr_t)sorted;
        unsigned ent = sorted[wave * 16 + r];
        const unsigned char* rp = U8l + (size_t)(sorted[wave * 16 + lr] >> 12) * 2048 + lq * 16;
        asm volatile("" ::: "memory");
#pragma unroll
        for (int j = 0; j < 4; ++j) { PU_DMA(rp + (2 * j) * 64, 2 * j); PU_DMA(rp + (2 * j + 1) * 64, 2 * j + 1); }
        int rsl = 0;
        for (int g = wave; g < 256; g += 8) {
            f32x4_t acc = {0.f, 0.f, 0.f, 0.f};
            const unsigned slot = (ent >> 7) & 31u, sw = slot & 15u;
            const unsigned xrow = x8_a + slot * 2048u;
            const unsigned xo[4] = {((0u + q) ^ sw) << 4, ((4u + q) ^ sw) << 4, ((8u + q) ^ sw) << 4, ((12u + q) ^ sw) << 4};
            const int gn = g + 8 < 256 ? g + 8 : g;
            unsigned entn, rown;
            asm volatile("ds_read_b32 %0, %2\n\tds_read_b32 %1, %3\n\ts_waitcnt lgkmcnt(0)" : "=&v"(entn), "=&v"(rown) : "v"(sorted_a + (unsigned)(gn * 16 + r) * 4u), "v"(sorted_a + (unsigned)(gn * 16 + lr) * 4u) : "memory");
            const unsigned char* rpn = U8l + (size_t)(rown >> 12) * 2048 + lq * 16;
            const size_t wo = (size_t)tok0 * 128 + (ent & 4095u);
            const float gate = p.GATE[wo];
#pragma unroll 4
            for (int c2 = 0; c2 < 16; ++c2) {
                __builtin_amdgcn_s_waitcnt(0x0F76);
                asm volatile("" ::: "memory");
                typedef unsigned u32x4_t __attribute__((ext_vector_type(4)));
                u32x4_t a0, a1, x0, x1; const unsigned ra = ring_a + (unsigned)rsl * 2048u; const int fsl = rsl;
                rsl = (rsl + 1) & 3;
                const int c = 2 * c2;
                const unsigned xa0 = xrow + (unsigned)((c >> 2) << 8) + xo[c & 3], xa1 = xrow + (unsigned)(((c + 1) >> 2) << 8) + xo[(c + 1) & 3];
                asm volatile("ds_read_b128 %0, %4\n\tds_read_b128 %1, %4 offset:1024\n\tds_read_b128 %2, %5\n\tds_read_b128 %3, %6\n\ts_waitcnt lgkmcnt(0)"
                             : "=&v"(a0), "=&v"(a1), "=&v"(x0), "=&v"(x1) : "v"(ra), "v"(xa0), "v"(xa1) : "memory");
                acc = __builtin_amdgcn_mfma_f32_16x16x32_fp8_fp8((long)(((unsigned long long)a0[1] << 32) | a0[0]), (long)(((unsigned long long)x0[1] << 32) | x0[0]), acc, 0, 0, 0);
                acc = __builtin_amdgcn_mfma_f32_16x16x32_fp8_fp8((long)(((unsigned long long)a0[3] << 32) | a0[2]), (long)(((unsigned long long)x0[3] << 32) | x0[2]), acc, 0, 0, 0);
                acc = __builtin_amdgcn_mfma_f32_16x16x32_fp8_fp8((long)(((unsigned long long)a1[1] << 32) | a1[0]), (long)(((unsigned long long)x1[1] << 32) | x1[0]), acc, 0, 0, 0);
                acc = __builtin_amdgcn_mfma_f32_16x16x32_fp8_fp8((long)(((unsigned long long)a1[3] << 32) | a1[2]), (long)(((unsigned long long)x1[3] << 32) | x1[2]), acc, 0, 0, 0);
                { const int ci = c2 + 4; const unsigned char* src = ci < 16 ? rp + ci * 128 : rpn + (ci - 16) * 128;
                  asm volatile("" ::: "memory");
                  PU_DMA(src, fsl * 2); PU_DMA(src + 64, fsl * 2 + 1); }
            }
            const int sel = r & 3; const float d = sel == 0 ? acc[0] : sel == 1 ? acc[1] : sel == 2 ? acc[2] : acc[3];
            if (q == (r >> 2)) {
                const _Float16 wh = (_Float16)(gate * gelu_tanh(d * (1.f / U8_SCALE)));
                p.WPK[wo] = ((ent >> 12) << 3) | (((unsigned)__builtin_bit_cast(unsigned short, wh) << 16) & 0xFFFE0000u); }
            rp = rpn; ent = entn;
        }
        asm volatile("s_waitcnt vmcnt(0)" ::: "memory");
#undef PU_DMA
    }
}
DEV void ph_peer_v(const Params& p, int l, unsigned char* smem, int wg, int nwg) {
    const int tid = tid_opq(), lane = tid & 63, wave = tid >> 6;
    const unsigned char* V8l = p.V8 + (size_t)l * 16384 * 2048;
    for (int chunk = wg; chunk < 256; chunk += nwg) {
        const int cm = (chunk & 7) * 32 + (chunk >> 3);
        __syncthreads();
        { const float* Vl = p.peer_v + (size_t)l * 16384 * 2048 + cm * 8 + (tid & 1) * 4;
#pragma unroll 1
          for (int i0 = 0; i0 < 64; i0 += 32) { float4 va[32];
#pragma unroll
            for (int i = 0; i < 32; ++i) va[i] = *(const float4*)(Vl + (size_t)((i0 + i) * 256 + (tid >> 1)) * 2048);
#pragma unroll
            for (int i = 0; i < 32; ++i) { int w0 = 0;
                w0 = __builtin_amdgcn_cvt_pk_fp8_f32(va[i].x * V8_SCALE, va[i].y * V8_SCALE, w0, false); w0 = __builtin_amdgcn_cvt_pk_fp8_f32(va[i].z * V8_SCALE, va[i].w * V8_SCALE, w0, true);
                *(unsigned*)(smem + ((i0 + i) * 256 + (tid >> 1)) * 8 + (tid & 1) * 4) = (unsigned)w0; } } }
        __syncthreads();
        const int sub = lane & 3, tl = lane >> 2;
        const uint4* __restrict__ wpk = (const uint4*)p.WPK; const bf16_t* __restrict__ xb = p.XB; bf16_t* __restrict__ yo = (bf16_t*)p.Y;
        const float sv = 1.f / V8_SCALE;
#define PV_TOK(it_) ((((it_) * 128 + wave * 16 + (wg >> 3) * 16 + (wg & 7) * 1024) & (TT - 1)) + tl)
#define PV_LOAD(E, X0, tk_) do { _Pragma("unroll") for (int q_ = 0; q_ < 8; ++q_) E[q_] = wpk[(size_t)(tk_) * 32 + q_ * 4 + sub]; \
        X0 = *(const uint4*)(xb + (size_t)(tk_) * DM + cm * 8); } while (0)
#define PV_CVT(v_, hi_) __builtin_bit_cast(h2_t, __builtin_amdgcn_cvt_scalef32_pk_f16_fp8((int)(v_), 1.0f, hi_))
#define PV_ACC(vv, x_) do { const _Float16 wq_ = __builtin_bit_cast(_Float16, (unsigned short)((x_) >> 16)); const h2_t w_ = {wq_, wq_}; \
        a01 = __builtin_elementwise_fma(PV_CVT(vv.x, false), w_, a01); a23 = __builtin_elementwise_fma(PV_CVT(vv.x, true), w_, a23); \
        a45 = __builtin_elementwise_fma(PV_CVT(vv.y, false), w_, a45); a67 = __builtin_elementwise_fma(PV_CVT(vv.y, true), w_, a67); } while (0)
#define PV_RD(x_) (*(const uint2*)(smem + ((x_) & 0x1FFF8u)))
#define PV_ENT(E, i_) (((i_) & 3) == 0 ? E[(i_) >> 2].x : ((i_) & 3) == 1 ? E[(i_) >> 2].y : ((i_) & 3) == 2 ? E[(i_) >> 2].z : E[(i_) >> 2].w)
#define PV_RED(a_) do { unsigned u_ = __builtin_bit_cast(unsigned, a_); h2_t t_ = __builtin_bit_cast(h2_t, (unsigned)__builtin_amdgcn_update_dpp(0, (int)u_, 0xB1, 0xF, 0xF, false)); a_ = a_ + t_; \
        u_ = __builtin_bit_cast(unsigned, a_); t_ = __builtin_bit_cast(h2_t, (unsigned)__builtin_amdgcn_update_dpp(0, (int)u_, 0x4E, 0xF, 0xF, false)); a_ = a_ + t_; } while (0)
#define PV_STEP(E, R, EN, RN, X0, tk_) do { h2_t a01 = {(_Float16)0.f, (_Float16)0.f}, a23 = a01, a45 = a01, a67 = a01;     \
        uint2 T_[16]; \
        _Pragma("unroll") for (int i_ = 0; i_ < 16; ++i_) { T_[i_] = PV_RD(PV_ENT(E, 16 + i_)); PV_ACC(R[i_], PV_ENT(E, i_)); } \
        _Pragma("unroll") for (int i_ = 0; i_ < 16; ++i_) { RN[i_] = PV_RD(PV_ENT(EN, i_)); PV_ACC(T_[i_], PV_ENT(E, 16 + i_)); } \
        PV_RED(a01); PV_RED(a23); PV_RED(a45); PV_RED(a67);     \
        if (sub == 0) { const size_t o = (size_t)(tk_) * DM + cm * 8; \
            uint4 y_; y_.x = pack2(ALPHA * bflo(X0.x) + (float)a01.x * sv, ALPHA * bfhi(X0.x) + (float)a01.y * sv); y_.y = pack2(ALPHA * bflo(X0.y) + (float)a23.x * sv, ALPHA * bfhi(X0.y) + (float)a23.y * sv); \
            y_.z = pack2(ALPHA * bflo(X0.z) + (float)a45.x * sv, ALPHA * bfhi(X0.z) + (float)a45.y * sv); y_.w = pack2(ALPHA * bflo(X0.w) + (float)a67.x * sv, ALPHA * bfhi(X0.w) + (float)a67.y * sv); \
            *(uint4*)(yo + o) = y_; } } while (0)
        uint4 enA[8], enB[8], xA0, xB0; uint2 rA[16], rB[16];
        if (wave & 4) __builtin_amdgcn_s_setprio(1);
        PV_LOAD(enA, xA0, PV_TOK(0));
#pragma unroll
        for (int i = 0; i < 16; ++i) rA[i] = PV_RD(PV_ENT(enA, i));
        for (int it = 0; it < TT / 128; it += 2) {
            const int tk0 = PV_TOK(it), tk1 = PV_TOK(it + 1), tk2 = PV_TOK(it + 2);
            PV_LOAD(enB, xB0, tk1);
            PV_STEP(enA, rA, enB, rB, xA0, tk0);
            PV_LOAD(enA, xA0, tk2);
            PV_STEP(enB, rB, enA, rA, xB0, tk1);
        }
        __builtin_amdgcn_s_setprio(0);
#undef PV_ENT
#undef PV_STEP
#undef PV_CVT
#undef PV_RED
#undef PV_RD
#undef PV_ACC
#undef PV_LOAD
#undef PV_TOK
    }
}

DEV void ph_peer_v2(const Params& p, int l, unsigned char* smem, int wg, int nwg) {
    const int tid = tid_opq(), wave = tid >> 6, lane = tid & 63;
    const unsigned char* V8l = p.V8 + (size_t)l * 16384 * 2048;
    unsigned* sorted = (unsigned*)(smem + wave * 4096);
    int* hist = (int*)(smem + wave * 4096 + 2048);
    const float* lg = p.ln2_g + (size_t)l * DM; const float* lb = p.ln2_b + (size_t)l * DM;
    float* xo = (l == NL - 1) ? p.out : p.XF; bf16_t* xbo = (l == NL - 1) ? nullptr : p.XB;
    for (int unit = wg; unit < TT / 32; unit += nwg) {
        const int tokw = unit * 32 + wave * 4;
        {
            unsigned ent[8];
#pragma unroll
            for (int s = 0; s < 4; ++s) { ent[2 * s] = p.WPK[(size_t)(tokw + s) * 128 + lane]; ent[2 * s + 1] = p.WPK[(size_t)(tokw + s) * 128 + 64 + lane]; }
            hist[lane] = 0; hist[64 + lane] = 0;
            __builtin_amdgcn_s_waitcnt(0x0070);
#pragma unroll
            for (int i = 0; i < 8; ++i) atomicAdd(&hist[(ent[i] & 0x3FFFu) >> 7], 1);
            __builtin_amdgcn_s_waitcnt(0x0070);
            { int ln = lane; asm volatile("" : "+v"(ln));
              const int a = hist[2 * ln], b = hist[2 * ln + 1]; int s = a + b;
#pragma unroll
              for (int o = 1; o < 64; o <<= 1) { const int t2 = __builtin_amdgcn_ds_bpermute((ln - o) * 4, s); if (ln >= o) s += t2; }
              const int ex = s - (a + b); hist[2 * ln] = ex; hist[2 * ln + 1] = ex + a; }
            __builtin_amdgcn_s_waitcnt(0x0070);
#pragma unroll
            for (int i = 0; i < 8; ++i) { const unsigned e = ent[i] & 0x3FFFu; const int pos = atomicAdd(&hist[e >> 7], 1);
                sorted[pos] = (e << 18) | ((unsigned)(i >> 1) << 16) | (ent[i] >> 16); }
            __builtin_amdgcn_s_waitcnt(0x0070);
        }
        float s1[4] = {0.f, 0.f, 0.f, 0.f}, s2[4] = {0.f, 0.f, 0.f, 0.f};
#define PV2_ROW(e_, h_) (((const uint4*)(V8l + (size_t)(e_) * 2048))[(h_) * 64 + lane])
#define PV2_FMA(ACC, ra, w_) do { \
        ACC[0] += __builtin_amdgcn_cvt_pk_f32_fp8((int)ra.x, false) * w_; ACC[1] += __builtin_amdgcn_cvt_pk_f32_fp8((int)ra.x, true) * w_; \
        ACC[2] += __builtin_amdgcn_cvt_pk_f32_fp8((int)ra.y, false) * w_; ACC[3] += __builtin_amdgcn_cvt_pk_f32_fp8((int)ra.y, true) * w_; \
        ACC[4] += __builtin_amdgcn_cvt_pk_f32_fp8((int)ra.z, false) * w_; ACC[5] += __builtin_amdgcn_cvt_pk_f32_fp8((int)ra.z, true) * w_; \
        ACC[6] += __builtin_amdgcn_cvt_pk_f32_fp8((int)ra.w, false) * w_; ACC[7] += __builtin_amdgcn_cvt_pk_f32_fp8((int)ra.w, true) * w_; } while (0)
#define PV2_ACC(en_, ra) do { const float w_ = __uint_as_float((en_) << 16); const unsigned sl_ = ((en_) >> 16) & 3u; \
        if (sl_ == 0u) PV2_FMA(acc0, ra, w_); else if (sl_ == 1u) PV2_FMA(acc1, ra, w_); else if (sl_ == 2u) PV2_FMA(acc2, ra, w_); else PV2_FMA(acc3, ra, w_); } while (0)
#define PV2_ENT(j_) ((unsigned)__builtin_amdgcn_readfirstlane((int)sorted[(j_)]))
#define PV2_Y(ACC, s_, hf, y) do { const size_t ro = (size_t)(tokw + (s_)) * DM + (hf) * 1024 + lnE * 16; \
        _Pragma("unroll") for (int q_ = 0; q_ < 4; ++q_) { const float4 xv = *(const float4*)(p.XF + ro + q_ * 4); const f32x2_t c0 = ACC[q_ * 2], c1 = ACC[q_ * 2 + 1]; \
            y[q_ * 4 + 0] = ALPHA * xv.x + c0.x * (1.f / V8_SCALE); y[q_ * 4 + 1] = ALPHA * xv.y + c0.y * (1.f / V8_SCALE); \
            y[q_ * 4 + 2] = ALPHA * xv.z + c1.x * (1.f / V8_SCALE); y[q_ * 4 + 3] = ALPHA * xv.w + c1.y * (1.f / V8_SCALE); } \
        _Pragma("unroll") for (int i_ = 0; i_ < 16; ++i_) { s1[s_] += y[i_]; s2[s_] += y[i_] * y[i_]; } } while (0)
#define PV2_NORM(s_, hf, y, mu, rstd) do { const size_t ro = (size_t)(tokw + (s_)) * DM + (hf) * 1024 + lnE * 16; \
        _Pragma("unroll") for (int q_ = 0; q_ < 4; ++q_) { const int c_ = (hf) * 1024 + lnE * 16 + q_ * 4; const float4 g4 = *(const float4*)(lg + c_), b4 = *(const float4*)(lb + c_); float4 o; \
            o.x = (y[q_ * 4 + 0] - mu) * rstd * g4.x + b4.x; o.y = (y[q_ * 4 + 1] - mu) * rstd * g4.y + b4.y; o.z = (y[q_ * 4 + 2] - mu) * rstd * g4.z + b4.z; o.w = (y[q_ * 4 + 3] - mu) * rstd * g4.w + b4.w; \
            *(float4*)(xo + ro + q_ * 4) = o; \
            if (xbo) { uint2 w2; w2.x = pack2(o.x, o.y); w2.y = pack2(o.z, o.w); *(uint2*)(xbo + ro + q_ * 4) = w2; } } } while (0)
#pragma unroll 1
        for (int hf = 0; hf < 2; ++hf) {
            f32x2_t acc0[8], acc1[8], acc2[8], acc3[8];
#pragma unroll
            for (int i = 0; i < 8; ++i) { acc0[i] = (f32x2_t){0.f, 0.f}; acc1[i] = acc0[i]; acc2[i] = acc0[i]; acc3[i] = acc0[i]; }
            unsigned e0 = PV2_ENT(0), e1 = PV2_ENT(1), e2 = PV2_ENT(2), e3 = PV2_ENT(3), e4 = PV2_ENT(4), e5 = PV2_ENT(5), e6 = PV2_ENT(6), e7 = PV2_ENT(7);
            uint4 a0 = PV2_ROW(e0 >> 18, hf), a1 = PV2_ROW(e1 >> 18, hf), a2 = PV2_ROW(e2 >> 18, hf), a3 = PV2_ROW(e3 >> 18, hf);
            uint4 a4 = PV2_ROW(e4 >> 18, hf), a5 = PV2_ROW(e5 >> 18, hf), a6 = PV2_ROW(e6 >> 18, hf), a7 = PV2_ROW(e7 >> 18, hf);
            for (int j = 0; j < 512; j += 8) {
#define PV2_STEP(ek, ak, dj) do { const int jn = j + 8 + (dj) < 512 ? j + 8 + (dj) : 511; const unsigned en = PV2_ENT(jn); const uint4 an = PV2_ROW(en >> 18, hf); \
                PV2_ACC(ek, ak); ek = (j + 8 + (dj) < 512) ? en : (en & 0xFFFF0000u); ak = an; } while (0)
                PV2_STEP(e0, a0, 0); PV2_STEP(e1, a1, 1); PV2_STEP(e2, a2, 2); PV2_STEP(e3, a3, 3);
                PV2_STEP(e4, a4, 4); PV2_STEP(e5, a5, 5); PV2_STEP(e6, a6, 6); PV2_STEP(e7, a7, 7);
#undef PV2_STEP
            }
            int lnE = lane; asm volatile("" : "+v"(lnE));
            if (hf == 0) {
                float y[16];
                PV2_Y(acc0, 0, 0, y); { float* d = p.Y + (size_t)(tokw + 0) * DM + lnE * 16; _Pragma("unroll") for (int q_ = 0; q_ < 4; ++q_) *(float4*)(d + q_ * 4) = make_float4(y[q_ * 4], y[q_ * 4 + 1], y[q_ * 4 + 2], y[q_ * 4 + 3]); }
                asm volatile("" ::: "memory"); PV2_Y(acc1, 1, 0, y); { float* d = p.Y + (size_t)(tokw + 1) * DM + lnE * 16; _Pragma("unroll") for (int q_ = 0; q_ < 4; ++q_) *(float4*)(d + q_ * 4) = make_float4(y[q_ * 4], y[q_ * 4 + 1], y[q_ * 4 + 2], y[q_ * 4 + 3]); }
                asm volatile("" ::: "memory"); PV2_Y(acc2, 2, 0, y); { float* d = p.Y + (size_t)(tokw + 2) * DM + lnE * 16; _Pragma("unroll") for (int q_ = 0; q_ < 4; ++q_) *(float4*)(d + q_ * 4) = make_float4(y[q_ * 4], y[q_ * 4 + 1], y[q_ * 4 + 2], y[q_ * 4 + 3]); }
                asm volatile("" ::: "memory"); PV2_Y(acc3, 3, 0, y); { float* d = p.Y + (size_t)(tokw + 3) * DM + lnE * 16; _Pragma("unroll") for (int q_ = 0; q_ < 4; ++q_) *(float4*)(d + q_ * 4) = make_float4(y[q_ * 4], y[q_ * 4 + 1], y[q_ * 4 + 2], y[q_ * 4 + 3]); }
            } else {
#define PV2_FIN(ACC, s_) do { float y[16]; PV2_Y(ACC, s_, 1, y); \
                const float m1 = wave_sum(s1[s_]) * (1.f / 2048.f), m2 = wave_sum(s2[s_]) * (1.f / 2048.f); const float rstd = rsqrtf(fmaxf(m2 - m1 * m1, 0.f) + 1e-5f); \
                asm volatile("" ::: "memory"); PV2_NORM(s_, 1, y, m1, rstd); asm volatile("" ::: "memory"); \
                { const float* d = p.Y + (size_t)(tokw + (s_)) * DM + lnE * 16; _Pragma("unroll") for (int q_ = 0; q_ < 4; ++q_) { const float4 t = *(const float4*)(d + q_ * 4); y[q_ * 4] = t.x; y[q_ * 4 + 1] = t.y; y[q_ * 4 + 2] = t.z; y[q_ * 4 + 3] = t.w; } } \
                asm volatile("" ::: "memory"); PV2_NORM(s_, 0, y, m1, rstd); } while (0)
                PV2_FIN(acc0, 0); asm volatile("" ::: "memory"); PV2_FIN(acc1, 1); asm volatile("" ::: "memory"); PV2_FIN(acc2, 2); asm volatile("" ::: "memory"); PV2_FIN(acc3, 3);
#undef PV2_FIN
            }
        }
#undef PV2_NORM
#undef PV2_Y
#undef PV2_ENT
#undef PV2_ACC
#undef PV2_FMA
#undef PV2_ROW
    }
}

namespace ps {
typedef float f32x16 __attribute__((ext_vector_type(16)));
DEV unsigned f2key(float v) { const unsigned b = __float_as_uint(v); return (b & 0x80000000u) ? ~b : (b | 0x80000000u); }
DEV float key2f(unsigned k) { k &= ~0xFFu; const unsigned b = (k & 0x80000000u) ? (k & 0x7fffffffu) : ~k; return __uint_as_float(b); }
#define PS_CE(a_, b_) do { const unsigned x_ = (a_), y_ = (b_); (a_) = x_ > y_ ? x_ : y_; (b_) = x_ > y_ ? y_ : x_; } while (0)
template <int N> DEV void bitonic_sort_desc(unsigned (&k)[N]) {
#pragma unroll
    for (int sz = 2; sz <= N; sz <<= 1)
#pragma unroll
        for (int j = sz >> 1; j > 0; j >>= 1)
#pragma unroll
            for (int i = 0; i < N; ++i) { const int l = i ^ j; if (l > i) { if ((i & sz) == 0) PS_CE(k[i], k[l]); else PS_CE(k[l], k[i]); } }
}
template <int N> DEV void bitonic_merge_desc(unsigned (&k)[N]) {
#pragma unroll
    for (int j = N >> 1; j > 0; j >>= 1)
#pragma unroll
        for (int i = 0; i < N; ++i) { const int l = i ^ j; if (l > i) PS_CE(k[i], k[l]); }
}
DEV void top16_of_64(const unsigned (&k)[64], unsigned (&out)[16]) {
    unsigned a[16], b[16], c[16], d[16];
#pragma unroll
    for (int i = 0; i < 16; ++i) { a[i] = k[i]; b[i] = k[16 + i]; c[i] = k[32 + i]; d[i] = k[48 + i]; }
    bitonic_sort_desc<16>(a); bitonic_sort_desc<16>(b); bitonic_sort_desc<16>(c); bitonic_sort_desc<16>(d);
#pragma unroll
    for (int i = 0; i < 16; ++i) { a[i] = a[i] > b[15 - i] ? a[i] : b[15 - i]; c[i] = c[i] > d[15 - i] ? c[i] : d[15 - i]; }
    bitonic_merge_desc<16>(a); bitonic_merge_desc<16>(c);
#pragma unroll
    for (int i = 0; i < 16; ++i) out[i] = a[i] > c[15 - i] ? a[i] : c[15 - i];
    bitonic_merge_desc<16>(out);
}
typedef short bf16x8 __attribute__((ext_vector_type(8)));
typedef unsigned u32x4 __attribute__((ext_vector_type(4)));
DEV unsigned split_hi2(float a, float b, float& ra, float& rb) {
    const unsigned ha = f2bf(a), hb = f2bf(b); ra = a - __uint_as_float(ha << 16); rb = b - __uint_as_float(hb << 16); return ha | (hb << 16);
}
DEV void half_top16(const float* __restrict__ qrow  , const unsigned char* __restrict__ tabh  ,
                    int r32, int hi, unsigned (&top)[16]) {
    bf16x8 qh[8], ql[8];
#pragma unroll
    for (int s8 = 0; s8 < 8; ++s8) { const float4 a = *(const float4*)(qrow + s8 * 16 + hi * 8), b = *(const float4*)(qrow + s8 * 16 + hi * 8 + 4);
        float r0, r1, r2, r3, r4, r5, r6, r7, d0, d1;
        u32x4 h, l;
        h.x = split_hi2(a.x, a.y, r0, r1); h.y = split_hi2(a.z, a.w, r2, r3); h.z = split_hi2(b.x, b.y, r4, r5); h.w = split_hi2(b.z, b.w, r6, r7);
        l.x = split_hi2(r0, r1, d0, d1); l.y = split_hi2(r2, r3, d0, d1); l.z = split_hi2(r4, r5, d0, d1); l.w = split_hi2(r6, r7, d0, d1);
        qh[s8] = *reinterpret_cast<bf16x8*>(&h); ql[s8] = *reinterpret_cast<bf16x8*>(&l); }
    f32x16 a0 = {}, a1 = {}, a2 = {}, a3 = {};
    const unsigned char* ah = tabh + r32 * 272 + hi * 16;
    const unsigned char* al = ah + 128 * 272;
#pragma unroll
    for (int s8 = 0; s8 < 8; ++s8) {
#define PS_MM(ACC, NT) do { const bf16x8 xh = *(const bf16x8*)(ah + (NT) * 8704 + s8 * 32), xl = *(const bf16x8*)(al + (NT) * 8704 + s8 * 32); \
        ACC = __builtin_amdgcn_mfma_f32_32x32x16_bf16(xh, qh[s8], ACC, 0, 0, 0); ACC = __builtin_amdgcn_mfma_f32_32x32x16_bf16(xh, ql[s8], ACC, 0, 0, 0); \
        ACC = __builtin_amdgcn_mfma_f32_32x32x16_bf16(xl, qh[s8], ACC, 0, 0, 0); } while (0)
        PS_MM(a0, 0); PS_MM(a1, 1); PS_MM(a2, 2); PS_MM(a3, 3);
#undef PS_MM
    }
    unsigned k[64];
#pragma unroll
    for (int i = 0; i < 16; ++i) {
        k[i] = (f2key(a0[i]) & ~0xFFu) | (unsigned)(((0 * 16 + i) << 1) | hi);  k[16 + i] = (f2key(a1[i]) & ~0xFFu) | (unsigned)(((1 * 16 + i) << 1) | hi);
        k[32 + i] = (f2key(a2[i]) & ~0xFFu) | (unsigned)(((2 * 16 + i) << 1) | hi); k[48 + i] = (f2key(a3[i]) & ~0xFFu) | (unsigned)(((3 * 16 + i) << 1) | hi); }
    unsigned t16[16];
    top16_of_64(k, t16);
    unsigned m[16];
#pragma unroll
    for (int i = 0; i < 16; ++i) { const unsigned o = (unsigned)__shfl_xor((int)t16[15 - i], 32); m[i] = t16[i] > o ? t16[i] : o; }
    bitonic_merge_desc<16>(m);
#pragma unroll
    for (int i = 0; i < 16; ++i) top[i] = m[i];
}
DEV int key_n(unsigned k) { const int idx = (int)(k & 0x7Fu), hi = idx & 1, loc = idx >> 1, nt = loc >> 4, ii = loc & 15; return (nt << 5) | ((ii >> 2) << 3) | (hi << 2) | (ii & 3); }
}

DEV void ph_peer_select2(const Params& p, int l, unsigned char* smem, int wg, int nwg, int only_unit = -1) {
    using namespace ps;
    const int tid = tid_opq(), lane = tid & 63, wave = __builtin_amdgcn_readfirstlane(tid >> 6), r32 = lane & 31, hi = lane >> 5;
    int* tab = (int*)(smem + 69632) + wave * 2048;
    for (int unit = (only_unit >= 0 ? only_unit : wg); unit < (only_unit >= 0 ? only_unit + 1 : 8 * (TT / 256)); unit += nwg) {
        const int h = unit & 7, tok = (unit >> 3) * 256 + wave * 32 + r32;
        const float* qb = p.Q2 + (size_t)tok * DM + h * 256;
        const float* skb = p.subkeys + (((size_t)l * 8 + h) * 2) * 16384;
        unsigned t1[16], t2[16];
#pragma unroll 1
        for (int part = 0; part < 2; ++part) {
            __syncthreads();
#pragma unroll
            for (int i = 0; i < 8; ++i) { const int f4 = i * 512 + tid, row = f4 >> 5, c4 = f4 & 31;
                const float4 v = ((const float4*)(skb + (size_t)part * 16384))[f4]; float r0, r1, r2, r3, d0, d1; uint2 hw, lw;
                hw.x = split_hi2(v.x, v.y, r0, r1); hw.y = split_hi2(v.z, v.w, r2, r3); lw.x = split_hi2(r0, r1, d0, d1); lw.y = split_hi2(r2, r3, d0, d1);
                *(uint2*)(smem + row * 272 + c4 * 8) = hw; *(uint2*)(smem + 128 * 272 + row * 272 + c4 * 8) = lw; }
            __syncthreads();
            if (part == 0) half_top16(qb, smem, r32, hi, t1); else half_top16(qb + 128, smem, r32, hi, t2);
        }
        float s1[16], s2[16];
#pragma unroll
        for (int i = 0; i < 16; ++i) { s1[i] = key2f(t1[i]); s2[i] = key2f(t2[i]); tab[i * 64 + lane] = key_n(t1[i]); tab[(16 + i) * 64 + lane] = key_n(t2[i]); }
        unsigned ck[64];
        ck[0] = (f2key(s1[0] + s2[0]) & ~0xFFu) | 0u;
        ck[1] = (f2key(s1[0] + s2[1]) & ~0xFFu) | 1u;
        ck[2] = (f2key(s1[0] + s2[2]) & ~0xFFu) | 2u;
        ck[3] = (f2key(s1[0] + s2[3]) & ~0xFFu) | 3u;
        ck[4] = (f2key(s1[0] + s2[4]) & ~0xFFu) | 4u;
        ck[5] = (f2key(s1[0] + s2[5]) & ~0xFFu) | 5u;
        ck[6] = (f2key(s1[0] + s2[6]) & ~0xFFu) | 6u;
        ck[7] = (f2key(s1[0] + s2[7]) & ~0xFFu) | 7u;
        ck[8] = (f2key(s1[0] + s2[8]) & ~0xFFu) | 8u;
        ck[9] = (f2key(s1[0] + s2[9]) & ~0xFFu) | 9u;
        ck[10] = (f2key(s1[0] + s2[10]) & ~0xFFu) | 10u;
        ck[11] = (f2key(s1[0] + s2[11]) & ~0xFFu) | 11u;
        ck[12] = (f2key(s1[0] + s2[12]) & ~0xFFu) | 12u;
        ck[13] = (f2key(s1[0] + s2[13]) & ~0xFFu) | 13u;
        ck[14] = (f2key(s1[0] + s2[14]) & ~0xFFu) | 14u;
        ck[15] = (f2key(s1[0] + s2[15]) & ~0xFFu) | 15u;
        ck[16] = (f2key(s1[1] + s2[0]) & ~0xFFu) | 16u;
        ck[17] = (f2key(s1[1] + s2[1]) & ~0xFFu) | 17u;
        ck[18] = (f2key(s1[1] + s2[2]) & ~0xFFu) | 18u;
        ck[19] = (f2key(s1[1] + s2[3]) & ~0xFFu) | 19u;
        ck[20] = (f2key(s1[1] + s2[4]) & ~0xFFu) | 20u;
        ck[21] = (f2key(s1[1] + s2[5]) & ~0xFFu) | 21u;
        ck[22] = (f2key(s1[1] + s2[6]) & ~0xFFu) | 22u;
        ck[23] = (f2key(s1[1] + s2[7]) & ~0xFFu) | 23u;
        ck[24] = (f2key(s1[2] + s2[0]) & ~0xFFu) | 32u;
        ck[25] = (f2key(s1[2] + s2[1]) & ~0xFFu) | 33u;
        ck[26] = (f2key(s1[2] + s2[2]) & ~0xFFu) | 34u;
        ck[27] = (f2key(s1[2] + s2[3]) & ~0xFFu) | 35u;
        ck[28] = (f2key(s1[2] + s2[4]) & ~0xFFu) | 36u;
        ck[29] = (f2key(s1[3] + s2[0]) & ~0xFFu) | 48u;
        ck[30] = (f2key(s1[3] + s2[1]) & ~0xFFu) | 49u;
        ck[31] = (f2key(s1[3] + s2[2]) & ~0xFFu) | 50u;
        ck[32] = (f2key(s1[3] + s2[3]) & ~0xFFu) | 51u;
        ck[33] = (f2key(s1[4] + s2[0]) & ~0xFFu) | 64u;
        ck[34] = (f2key(s1[4] + s2[1]) & ~0xFFu) | 65u;
        ck[35] = (f2key(s1[4] + s2[2]) & ~0xFFu) | 66u;
        ck[36] = (f2key(s1[5] + s2[0]) & ~0xFFu) | 80u;
        ck[37] = (f2key(s1[5] + s2[1]) & ~0xFFu) | 81u;
        ck[38] = (f2key(s1[6] + s2[0]) & ~0xFFu) | 96u;
        ck[39] = (f2key(s1[6] + s2[1]) & ~0xFFu) | 97u;
        ck[40] = (f2key(s1[7] + s2[0]) & ~0xFFu) | 112u;
        ck[41] = (f2key(s1[7] + s2[1]) & ~0xFFu) | 113u;
        ck[42] = (f2key(s1[8] + s2[0]) & ~0xFFu) | 128u;
        ck[43] = (f2key(s1[9] + s2[0]) & ~0xFFu) | 144u;
        ck[44] = (f2key(s1[10] + s2[0]) & ~0xFFu) | 160u;
        ck[45] = (f2key(s1[11] + s2[0]) & ~0xFFu) | 176u;
        ck[46] = (f2key(s1[12] + s2[0]) & ~0xFFu) | 192u;
        ck[47] = (f2key(s1[13] + s2[0]) & ~0xFFu) | 208u;
        ck[48] = (f2key(s1[14] + s2[0]) & ~0xFFu) | 224u;
        ck[49] = (f2key(s1[15] + s2[0]) & ~0xFFu) | 240u;
        ck[50] = 0u;
        ck[51] = 0u;
        ck[52] = 0u;
        ck[53] = 0u;
        ck[54] = 0u;
        ck[55] = 0u;
        ck[56] = 0u;
        ck[57] = 0u;
        ck[58] = 0u;
        ck[59] = 0u;
        ck[60] = 0u;
        ck[61] = 0u;
        ck[62] = 0u;
        ck[63] = 0u;
        unsigned ct[16];
        top16_of_64(ck, ct);
        float e[16], sum = 0.f; const float mx = key2f(ct[0]);
#pragma unroll
        for (int k = 0; k < 16; ++k) { e[k] = __expf(key2f(ct[k]) - mx); sum += e[k]; }
        const float inv = 1.f / sum;
        int ei[8]; float gi[8];
#pragma unroll
        for (int k = 0; k < 8; ++k) { unsigned ca = ct[k], cb = ct[k + 8]; float ea = e[k], eb = e[k + 8];
            asm volatile("" : "+v"(ca), "+v"(cb), "+v"(ea), "+v"(eb));
            const unsigned c = hi ? cb : ca; const int ci = (int)(c >> 4) & 15, cj = (int)c & 15;
            ei[k] = tab[ci * 64 + lane] * 128 + tab[(16 + cj) * 64 + lane]; gi[k] = (hi ? eb : ea) * inv; }
        const size_t o = (size_t)tok * 128 + h * 16 + hi * 8;
        *(int4*)(p.EIDX + o) = make_int4(ei[0], ei[1], ei[2], ei[3]); *(int4*)(p.EIDX + o + 4) = make_int4(ei[4], ei[5], ei[6], ei[7]);
        *(float4*)(p.GATE + o) = make_float4(gi[0], gi[1], gi[2], gi[3]); *(float4*)(p.GATE + o + 4) = make_float4(gi[4], gi[5], gi[6], gi[7]);
    }
}

enum { PH_PRO = 0, PH_GEMM_IN, PH_ROPE, PH_ATTN_A, PH_ATTN_B, PH_AFIN, PH_GEMM_OUT, PH_LN1, PH_GEMM_Q, PH_PSEL, PH_PU, PH_PV, PH_LN2, PH_COUNT };

#ifndef PROBE_REP
#define PROBE_REP 0
#endif
template <int PH>
DEV void run_phase(const Params& p, int l, unsigned char* smem, int wg, int nwg, int rep = 0) {
    float* lds = (float*)smem;
    const float* xin = l == 0 ? p.x : p.XF;
    if constexpr (PH == PH_PRO) {
        for (int ll = 0; ll < NL; ++ll) {
            ph_transpose<1>(p.w_in + (size_t)ll * DM * INW, p.WINT + (size_t)ll * PW * DM, INW, PW, lds, wg, nwg);
            ph_transpose<0>(p.w_out + (size_t)ll * DM * DM, p.WOUTT + (size_t)ll * DM * DM, DM, DM, lds, wg, nwg);
            ph_transpose<0>(p.peer_wq + (size_t)ll * DM * DM, p.WQT + (size_t)ll * DM * DM, DM, DM, lds, wg, nwg);
        }
        ph_cvt8(p.peer_u, p.U8, (size_t)NL * 16384 * 2048, U8_SCALE, wg, nwg);
        ph_cvt(p.x, p.XB, (size_t)TT * DM, wg, nwg);
        ph_ropetab(p.ROPE, wg, nwg);
        ph_cmp_bias(p, lds, wg, nwg);
        for (int lk = 0; lk < NL * 2; ++lk) {
            ph_transpose<0, 4096>(p.cmp_w1 + (size_t)lk * 4096 * 256, p.W1T + (size_t)lk * 256 * 4096, 256, 256, lds, wg, nwg);
            ph_transpose<0, 256>(p.cmp_w2 + (size_t)lk * 256 * 128, p.W2T + (size_t)lk * 128 * 256, 128, 128, lds, wg, nwg);
        }
    }
    else if constexpr (PH == PH_GEMM_IN) ph_gemm_in(p, l, smem, wg, nwg);
    else if constexpr (PH == PH_ROPE) ph_rope(p.P, p.ROPE, wg, nwg);
    else if constexpr (PH == PH_ATTN_A) {
        unsigned* ctrs = p.bar + 4096 + ((l * 4 + 0 + 2 * rep) * 8) * 64;
        unsigned* cflag = p.bar + 14336 + (l * 2) * 64;
        int xq = (int)(xb_xcc_id() & 7u), tries = 0;
        for (;;) { const int i = next_unit_x(ctrs, 164, xq, tries, (char*)smem); if (i < 0) break;
            if (i < 4) { const int unit = xq * 4 + i; compress_unit_mfma(p, l, unit, (char*)smem);
                asm volatile("s_waitcnt vmcnt(0)" ::: "memory"); __syncthreads();
                if (tid_opq() == 0) { __builtin_amdgcn_fence(__ATOMIC_RELEASE, "agent"); asm volatile("s_waitcnt vmcnt(0)" ::: "memory"); (void)xb_add(cflag + ((unit >> 3) & 1) * 64, 1u); } }
            else if (i < 20) stick_unit_mfma(p, ((i - 4) << 3) | xq, (char*)smem);
            else if (i < 32) { const int j = i - 20; diff_unit2(p, ((j >> 1) << 4) | (xq << 1) | (j & 1), (char*)smem); }
            else if (i < 48) dil_unit_mfma(p, xq * 48 + (i - 32), (char*)smem);
            else if (i < 80) {
                if (tid_opq() == 0) { unsigned* f = cflag + (xq >> 2) * 64; XB_SPIN(xb_ld(f) < 16u, p.bar); __builtin_amdgcn_fence(__ATOMIC_ACQUIRE, "agent"); asm volatile("s_waitcnt vmcnt(0)" ::: "memory"); }
                __syncthreads();
                nsa_unit2(p, l, (xq >> 2) * 128 + 127 - (4 * (i - 48) + (xq & 3)), (char*)smem); }
            else if (i < 116) { const int j = i - 80 + 12; diff_unit2(p, ((j >> 1) << 4) | (xq << 1) | (j & 1), (char*)smem); }
            else if (i < 148) dil_unit_mfma(p, xq * 48 + 16 + (i - 116), (char*)smem);
            else { const int j = i - 148 + 48; diff_unit2(p, ((j >> 1) << 4) | (xq << 1) | (j & 1), (char*)smem); } }
    }
    else if constexpr (PH == PH_ATTN_B) { }
    else if constexpr (PH == PH_AFIN) ph_attn_final(p, l, wg, nwg);
    else if constexpr (PH == PH_GEMM_OUT) ph_gemm_out(p, l, xin, smem, wg, nwg, ((PROBE_REP >> 1) & 1) ? l * 2 + rep + 1 : l + 1);
    else if constexpr (PH == PH_LN1) ph_ln<false>(p.Y, p.ln1_g + (size_t)l * DM, p.ln1_b + (size_t)l * DM, p.XF, p.XB, wg, nwg);
    else if constexpr (PH == PH_GEMM_Q) {
        ph_gemm_q(p, l, smem, wg, nwg);
        if (nwg == 256) { pg8::StaticOrder S; S.init(TT, DM, nwg, wg); pg8::Unit u; (void)S.next(0, u);
            asm volatile("s_waitcnt vmcnt(0)" ::: "memory"); __syncthreads();
            ph_peer_select2(p, l, smem, wg, nwg, u.pm * 8 + u.pn); }
    }
    else if constexpr (PH == PH_PSEL) { if (nwg != 256) ph_peer_select2(p, l, smem, wg, nwg); }
    else if constexpr (PH == PH_PU) ph_peer_u(p, l, smem, wg, nwg);
    else if constexpr (PH == PH_PV) ph_peer_v(p, l, smem, wg, nwg);
    else if constexpr (PH == PH_LN2) ph_ln_bf((const bf16_t*)p.Y, p.ln2_g + (size_t)l * DM, p.ln2_b + (size_t)l * DM, l == NL - 1 ? p.out : (nwg != 256 ? p.XF : nullptr), l == NL - 1 ? nullptr : p.XB, wg, nwg);
}

__global__ __launch_bounds__(512, 2) void k_mega(Params p) {
    extern __shared__ __attribute__((aligned(16))) unsigned char smem[];
    const int wg = (int)blockIdx.x, nwg = (int)gridDim.x;
    uint4* xbw = (uint4*)(smem + LDS_BYTES - 16);
    if (threadIdx.x == 0) *xbw = make_uint4(0u, 0u, 0u, 0u);
    __syncthreads();
    XcdBarrier bar = xcd_barrier_post(p.bar, (volatile LAS unsigned*)xbw);
#define RUN(PH, bit, l_) do { for (int rep_ = 0; rep_ < (((PROBE_REP) >> (bit)) & 1) + 1; ++rep_) { run_phase<PH>(p, l_, smem, wg, nwg, rep_); xcd_barrier(bar); } } while (0)
    RUN(PH_PRO, 0, 0);
    for (int l = 0; l < NL; ++l) {
        RUN(PH_GEMM_IN, 1, l);
        RUN(PH_ATTN_A, 2, l);
        RUN(PH_AFIN, 4, l);
        RUN(PH_GEMM_OUT, 1, l);
        if (nwg != 256) RUN(PH_LN1, 5, l);
        RUN(PH_GEMM_Q, 1, l);
        if (nwg != 256) RUN(PH_PSEL, 6, l);
        RUN(PH_PU, 7, l);
        RUN(PH_PV, 8, l);
        RUN(PH_LN2, 5, l);
    }
#undef RUN
}

static size_t carve(size_t& off, size_t bytes) { const size_t o = off; off = (off + bytes + 255) & ~(size_t)255; return o; }

extern "C" void kernel_launch(void* const* d_in, const int* in_sizes, int n_in, void* d_out, int out_size, void* d_ws, size_t ws_size, hipStream_t stream) {
    (void)in_sizes; (void)n_in; (void)out_size; (void)ws_size;
    Params p{};
    p.x = (const float*)d_in[0]; p.w_in = (const float*)d_in[1]; p.w_out = (const float*)d_in[2]; p.cmp_pe = (const float*)d_in[3]; p.cmp_w1 = (const float*)d_in[4];
    p.cmp_w2 = (const float*)d_in[5]; p.diff_lambda = (const float*)d_in[6]; p.diff_g = (const float*)d_in[7]; p.ln1_g = (const float*)d_in[8]; p.ln1_b = (const float*)d_in[9];
    p.peer_wq = (const float*)d_in[10]; p.subkeys = (const float*)d_in[11]; p.peer_u = (const float*)d_in[12]; p.peer_v = (const float*)d_in[13]; p.ln2_g = (const float*)d_in[14]; p.ln2_b = (const float*)d_in[15];
    p.out = (float*)d_out;
    char* ws = (char*)d_ws; size_t off = 0;
    p.bar = (unsigned*)(ws + carve(off, 65536));
    p.XF = (float*)(ws + carve(off, (size_t)TT * DM * 4)); p.Y = (float*)(ws + carve(off, (size_t)TT * DM * 4));
    p.Q2 = (float*)(ws + carve(off, (size_t)TT * DM * 4)); p.OACC = (float*)(ws + carve(off, (size_t)TT * DM * 4));
    p.KC = (float*)(ws + carve(off, (size_t)NB * 256 * 128 * 4)); p.VC = (float*)(ws + carve(off, (size_t)NB * 256 * 128 * 4));
    p.ROPE = (float*)(ws + carve(off, (size_t)SEQ * 48 * 4)); p.SKT = (float*)(ws + carve(off, (size_t)NL * 16 * 16384 * 4));
    p.GATE = (float*)(ws + carve(off, (size_t)TT * 128 * 4)); p.EIDX = (int*)(ws + carve(off, (size_t)TT * 128 * 4)); p.SEL = (u64*)(ws + carve(off, (size_t)TT * 8));
    p.XB = (bf16_t*)(ws + carve(off, (size_t)TT * DM * 2)); p.OCAT = (bf16_t*)(ws + carve(off, (size_t)TT * DM * 2)); p.P = (bf16_t*)(ws + carve(off, (size_t)TT * PW * 2));
    p.WINT = (bf16_t*)(ws + carve(off, (size_t)NL * PW * DM * 2)); p.WOUTT = (bf16_t*)(ws + carve(off, (size_t)NL * DM * DM * 2)); p.WQT = (bf16_t*)(ws + carve(off, (size_t)NL * DM * DM * 2));
    p.U8 = (unsigned char*)(ws + carve(off, (size_t)NL * 16384 * 2048)); p.V8 = (unsigned char*)(ws + carve(off, (size_t)NL * 16384 * 2048)); p.WPK = (unsigned*)(ws + carve(off, (size_t)TT * 128 * 4));
    p.KCB = (bf16_t*)(ws + carve(off, (size_t)NB * 256 * 128 * 2)); p.VCB = (bf16_t*)(ws + carve(off, (size_t)NB * 256 * 128 * 2));
    p.W1T = (bf16_t*)(ws + carve(off, (size_t)NL * 2 * 256 * 4096 * 2)); p.W2T = (bf16_t*)(ws + carve(off, (size_t)NL * 2 * 128 * 256 * 2)); p.CB = (float*)(ws + carve(off, (size_t)NL * 2 * 8 * 256 * 4));
    p.NSAO = (float*)(ws + carve(off, (size_t)3 * TT * 512 * 4));
    p.LNX = (u64*)(ws + carve(off, (size_t)TT * 8 * 8));
    p.DILO = (float*)(ws + carve(off, (size_t)3 * TT * 512 * 4)); p.DILL = (float*)(ws + carve(off, (size_t)3 * TT * 4 * 4)); p.DIFO = (float*)(ws + carve(off, (size_t)2 * TT * 512 * 4));
    static int grid = 0;
    if (!grid) {
        int dev = 0, cus = 0, per_cu = 0;
        (void)hipGetDevice(&dev);
        (void)hipDeviceGetAttribute(&cus, hipDeviceAttributeMultiprocessorCount, dev);
        (void)hipFuncSetAttribute((const void*)k_mega, hipFuncAttributeMaxDynamicSharedMemorySize, LDS_BYTES);
        (void)hipOccupancyMaxActiveBlocksPerMultiprocessor(&per_cu, (const void*)k_mega, 512, LDS_BYTES);
        grid = cus * (per_cu < 1 ? per_cu : 1);
        if (grid <= 0) grid = cus > 0 ? cus : 256;
    }
    (void)hipMemsetAsync(p.bar, 0, 65536, stream);
    k_mega<<<dim3(grid), dim3(512), LDS_BYTES, stream>>>(p);
}
```
